# Optimizing an MI355X kernel written in HIP

```python
import math
import jax
import jax.numpy as jnp
from jax import lax
import numpy as np

D_MODEL = 1024
BATCH = 16
SEQ = 2048
DEPTH = 2

GRID_W = 64
CTX_LEN = 256
EPS = 1e-6
ROPE_BASE = 10000.0
QBLOCK = 128
N_MOD = 6

MLA_HEADS = 4
MLA_Q_RANK = 256
MLA_KV_RANK = 128
MLA_NOPE = 64
MLA_ROPE = 32
MLA_V = 64
MLA_SCALE = (MLA_NOPE + MLA_ROPE) ** -0.5

SWA_HEADS = 4
SWA_KV_HEADS = 2
SWA_HEAD_DIM = 64
SWA_WINDOW = 128
SWA_SCALE = SWA_HEAD_DIM ** -0.5

DIFF_HEADS = 4
DIFF_QK = 32
DIFF_V = 64
DIFF_SCALE = DIFF_QK ** -0.5

POOL_WINDOWS = (2, 4, 8, 16)
POOL_GROUP = 64

MIX_A = MLA_HEADS * MLA_V
MIX_B = SWA_HEADS * SWA_HEAD_DIM
MIX_C = DIFF_HEADS * DIFF_V
MIX_D = len(POOL_WINDOWS) * POOL_GROUP
D_MIX = MIX_A + MIX_B + MIX_C + MIX_D

IN_SIZES = (MLA_Q_RANK, MLA_KV_RANK, MLA_ROPE,
            SWA_HEADS * SWA_HEAD_DIM, SWA_KV_HEADS * SWA_HEAD_DIM, SWA_KV_HEADS * SWA_HEAD_DIM,
            2 * DIFF_HEADS * DIFF_QK, 2 * DIFF_HEADS * DIFF_QK, DIFF_HEADS * DIFF_V,
            MIX_D)
D_IN = sum(IN_SIZES)

N_EXPERT_GROUPS = 4
EXPERTS_PER_GROUP = 4
N_EXPERTS = N_EXPERT_GROUPS * EXPERTS_PER_GROUP
TOP_K_IN_GROUP = 2
D_EXPERT = 512

kernel_name = "hybrid_headgroup_dit_hmoe"


def rms_norm(x, g):
    xf = x.astype(jnp.float32)
    y = xf * lax.rsqrt(jnp.mean(xf * xf, axis=-1, keepdims=True) + EPS)
    return (y * g.astype(jnp.float32)).astype(x.dtype)


def modulate(h, shift, scale):
    return h * (1 + scale) + shift


def axial_rope_table(length, dim):
    rows = length // GRID_W
    row = jnp.repeat(jnp.arange(rows), GRID_W).astype(jnp.float32)
    col = jnp.tile(jnp.arange(GRID_W), rows).astype(jnp.float32)
    n = dim // 4
    inv = ROPE_BASE ** (-jnp.arange(n, dtype=jnp.float32) / n)
    ang = jnp.concatenate([row[:, None] * inv, col[:, None] * inv], axis=-1)
    return jnp.cos(ang), jnp.sin(ang)


def apply_rope(x, rope):
    cos, sin = rope
    xf = x.astype(jnp.float32)
    h = x.shape[-1] // 2
    x1, x2 = xf[..., :h], xf[..., h:]
    cs, sn = cos[None, :, None, :], sin[None, :, None, :]
    return jnp.concatenate([x1 * cs - x2 * sn, x1 * sn + x2 * cs], axis=-1).astype(x.dtype)


def split_in(z):
    points = np.cumsum(IN_SIZES)[:-1].tolist()
    return jnp.split(z, points, axis=-1)


def mixer_keys_values(z, kv_gain, w_ukv, ropes):
    B, L, _ = z.shape
    _, ckv, kr, _, bk, bv, _, dk, dv, _ = split_in(z)
    kva = (rms_norm(ckv, kv_gain) @ w_ukv).reshape(B, L, MLA_HEADS, MLA_NOPE + MLA_V)
    k_nope, va = kva[..., :MLA_NOPE], kva[..., MLA_NOPE:]
    k_rope = kr.reshape(B, L, 1, MLA_ROPE)
    bk = bk.reshape(B, L, SWA_KV_HEADS, SWA_HEAD_DIM)
    bv = bv.reshape(B, L, SWA_KV_HEADS, SWA_HEAD_DIM)
    dk = dk.reshape(B, L, 2 * DIFF_HEADS, DIFF_QK)
    dv = dv.reshape(B, L, DIFF_HEADS, DIFF_V)
    if ropes is not None:
        rope_a, rope_b, rope_c = ropes
        k_rope = apply_rope(k_rope, rope_a)
        bk = apply_rope(bk, rope_b)
        dk = apply_rope(dk, rope_c)
    ka = jnp.concatenate([k_nope, jnp.broadcast_to(k_rope, (B, L, MLA_HEADS, MLA_ROPE))], axis=-1)
    return (ka, va, bk, bv, dk, dv)


def mixer_queries(z, q_gain, w_uq, ropes):
    B, L, _ = z.shape
    cq, _, _, bq, _, _, dq, _, _, u = split_in(z)
    qa = (rms_norm(cq, q_gain) @ w_uq).reshape(B, L, MLA_HEADS, MLA_NOPE + MLA_ROPE)
    q_nope, q_rope = qa[..., :MLA_NOPE], qa[..., MLA_NOPE:]
    bq = bq.reshape(B, L, SWA_HEADS, SWA_HEAD_DIM)
    dq = dq.reshape(B, L, 2 * DIFF_HEADS, DIFF_QK)
    if ropes is not None:
        rope_a, rope_b, rope_c = ropes
        q_rope = apply_rope(q_rope, rope_a)
        bq = apply_rope(bq, rope_b)
        dq = apply_rope(dq, rope_c)
    qa = jnp.concatenate([q_nope, q_rope], axis=-1)
    return (qa, bq, dq, u)


def sweep_query_blocks(fn, q):
    B, L = q.shape[:2]
    nb = L // QBLOCK
    qb = jnp.moveaxis(q.reshape((B, nb, QBLOCK) + q.shape[2:]), 1, 0)
    out = lax.map(fn, qb)
    return jnp.moveaxis(out, 0, 1).reshape((B, L) + out.shape[3:])


def softmax_attend(q, k, v, scale):
    s = jnp.einsum('bqhd,bkhd->bhqk', q, k).astype(jnp.float32) * scale
    p = jax.nn.softmax(s, axis=-1)
    return jnp.einsum('bhqk,bkhd->bqhd', p.astype(v.dtype), v)


def diff_attend(q, k, v, lam):
    B, Q = q.shape[:2]
    M = k.shape[1]
    s = jnp.einsum('bqhd,bkhd->bhqk', q, k).astype(jnp.float32) * DIFF_SCALE
    p = jax.nn.softmax(s, axis=-1).reshape(B, DIFF_HEADS, 2, Q, M)
    a = p[:, :, 0] - lam * p[:, :, 1]
    return jnp.einsum('bhqk,bkhd->bqhd', a.astype(v.dtype), v)


def gqa_sink_dense(q, k, v, sink):
    B, Q, H, d = q.shape
    G = H // SWA_KV_HEADS
    qg = q.reshape(B, Q, SWA_KV_HEADS, G, d)
    s = jnp.einsum('bqkgd,bmkd->bkgqm', qg, k).astype(jnp.float32) * SWA_SCALE
    sk = jnp.broadcast_to(sink.astype(jnp.float32).reshape(1, SWA_KV_HEADS, G, 1, 1), s.shape[:-1] + (1,))
    p = jax.nn.softmax(jnp.concatenate([s, sk], axis=-1), axis=-1)[..., :-1]
    o = jnp.einsum('bkgqm,bmkd->bqkgd', p.astype(v.dtype), v)
    return o.reshape(B, Q, H, d)


def window_gqa_sink(q, k, v, kc, vc, sink):
    B, L, H, d = q.shape
    G = H // SWA_KV_HEADS
    nb = L // QBLOCK
    J = 3 * QBLOCK
    C = kc.shape[1]

    def band(a):
        ap = jnp.pad(a, ((0, 0), (QBLOCK, QBLOCK), (0, 0), (0, 0))).reshape(B, nb + 2, QBLOCK, SWA_KV_HEADS, d)
        return jnp.concatenate([ap[:, :-2], ap[:, 1:-1], ap[:, 2:]], axis=2)

    kb, vb = band(k), band(v)
    qg = q.reshape(B, nb, QBLOCK, SWA_KV_HEADS, G, d)
    s_loc = jnp.einsum('bnqkgd,bnjkd->bnkgqj', qg, kb).astype(jnp.float32) * SWA_SCALE
    qpos = jnp.arange(L).reshape(nb, QBLOCK)
    kpos = (jnp.arange(nb) * QBLOCK - QBLOCK)[:, None] + jnp.arange(J)[None, :]
    rel = kpos[:, None, :] - qpos[:, :, None]
    valid = (jnp.abs(rel) <= SWA_WINDOW) & (kpos[:, None, :] >= 0) & (kpos[:, None, :] < L)
    s_loc = jnp.where(valid[None, :, None, None], s_loc, -jnp.inf)
    s_ctx = jnp.einsum('bnqkgd,bckd->bnkgqc', qg, kc).astype(jnp.float32) * SWA_SCALE
    sk = jnp.broadcast_to(sink.astype(jnp.float32).reshape(1, 1, SWA_KV_HEADS, G, 1, 1), s_loc.shape[:-1] + (1,))
    p = jax.nn.softmax(jnp.concatenate([s_loc, s_ctx, sk], axis=-1), axis=-1)
    p_loc, p_ctx = p[..., :J], p[..., J:J + C]
    o = (jnp.einsum('bnkgqj,bnjkd->bnqkgd', p_loc.astype(v.dtype), vb)
         + jnp.einsum('bnkgqc,bckd->bnqkgd', p_ctx.astype(vc.dtype), vc))
    return o.reshape(B, L, H, d)


def multiscale_pool(u, pool_w, pool_scale):
    B, L, _ = u.shape
    ug = u.reshape(B, L, len(POOL_WINDOWS), POOL_GROUP).astype(jnp.float32)
    t = jnp.arange(L)
    diffs = []
    for gi, w in enumerate(POOL_WINDOWS):
        xg = ug[:, :, gi]
        half = w // 2
        xp = jnp.pad(xg, ((0, 0), (half, w - half), (0, 0)))
        cs = jnp.concatenate([jnp.zeros((B, 1, POOL_GROUP), jnp.float32), jnp.cumsum(xp, axis=1)], axis=1)
        win_sum = cs[:, w:w + L] - cs[:, :L]
        cnt = (jnp.minimum(t - half + w, L) - jnp.maximum(t - half, 0)).astype(jnp.float32)
        diffs.append(win_sum / cnt[None, :, None] - xg)
    dg = jnp.stack(diffs, axis=2)
    y = jnp.einsum('blgc,gcd->blgd', dg, pool_w.astype(jnp.float32)).reshape(B, L, MIX_D)
    return (y * pool_scale.astype(jnp.float32)).astype(u.dtype)


def latent_mix(qx, kvx, kvc, sink, lam, lam_init, subln_g, pool_w, pool_scale):
    qa, bq, dq, u = qx
    ka, va, bk, bv, dk, dv = kvx
    kac, vac, bkc, bvc, dkc, dvc = kvc
    B, L = u.shape[:2]
    ka_all = jnp.concatenate([ka, kac], axis=1)
    va_all = jnp.concatenate([va, vac], axis=1)
    oa = sweep_query_blocks(lambda q: softmax_attend(q, ka_all, va_all, MLA_SCALE), qa)
    ob = window_gqa_sink(bq, bk, bv, bkc, bvc, sink)
    dk_all = jnp.concatenate([dk, dkc], axis=1)
    dv_all = jnp.concatenate([dv, dvc], axis=1)
    oc = sweep_query_blocks(lambda q: diff_attend(q, dk_all, dv_all, lam), dq)
    oc = rms_norm(oc, subln_g) * (1.0 - lam_init)
    od = multiscale_pool(u, pool_w, pool_scale)
    return jnp.concatenate([oa.reshape(B, L, MIX_A), ob.reshape(B, L, MIX_B),
                            oc.reshape(B, L, MIX_C), od], axis=-1)


def context_mix(qc, kvc, sink, lam, lam_init, subln_g, pool_w, pool_scale):
    qa, bq, dq, u = qc
    kac, vac, bkc, bvc, dkc, dvc = kvc
    B, C = u.shape[:2]
    oa = softmax_attend(qa, kac, vac, MLA_SCALE)
    ob = gqa_sink_dense(bq, bkc, bvc, sink)
    oc = rms_norm(diff_attend(dq, dkc, dvc, lam), subln_g) * (1.0 - lam_init)
    od = multiscale_pool(u, pool_w, pool_scale)
    return jnp.concatenate([oa.reshape(B, C, MIX_A), ob.reshape(B, C, MIX_B),
                            oc.reshape(B, C, MIX_C), od], axis=-1)


def hier_moe(h, gw, gb, ew, eb, w_gu, w_down):
    B, L, D = h.shape
    tok = h.reshape(-1, D)
    g_logits = (tok @ gw + gb).astype(jnp.float32)
    g_prob = jax.nn.softmax(g_logits, axis=-1)
    g_sel = jnp.argmax(g_logits, axis=-1)
    p_g = jnp.take_along_axis(g_prob, g_sel[:, None], axis=-1)
    e_logits = (tok @ ew + eb).astype(jnp.float32).reshape(-1, N_EXPERT_GROUPS, EXPERTS_PER_GROUP)
    e_in = jnp.take_along_axis(e_logits, g_sel[:, None, None], axis=1)[:, 0]
    top_v, top_i = lax.top_k(e_in, TOP_K_IN_GROUP)
    w_sel = jax.nn.softmax(top_v, axis=-1) * p_g
    e_idx = g_sel[:, None] * EXPERTS_PER_GROUP + top_i
    combine = jnp.sum(jax.nn.one_hot(e_idx, N_EXPERTS, dtype=jnp.float32) * w_sel[..., None], axis=1)
    y = jnp.zeros((tok.shape[0], D), jnp.float32)
    for e in range(N_EXPERTS):
        gu = tok @ w_gu[e]
        act = jax.nn.silu(gu[:, :D_EXPERT]) * gu[:, D_EXPERT:]
        y = y + combine[:, e:e + 1] * (act @ w_down[e]).astype(jnp.float32)
    return y.reshape(B, L, D).astype(h.dtype)


def setup_inputs(seed: int = 0) -> dict:
    key = jax.random.key(seed)
    ks = jax.random.split(key, 24)
    f32 = jnp.float32

    def nrm(k, shape, scale):
        return jax.random.normal(k, shape, f32) * scale

    return {
        "x": nrm(ks[0], (BATCH, SEQ, D_MODEL), 1.0),
        "c": nrm(ks[1], (BATCH, D_MODEL), 1.0),
        "ctx": nrm(ks[2], (BATCH, CTX_LEN, D_MODEL), 1.0),
        "c_ctx": nrm(ks[3], (D_MODEL,), 1.0),
        "ada_w": nrm(ks[4], (DEPTH, D_MODEL, N_MOD * D_MODEL), 0.5 * D_MODEL ** -0.5),
        "ada_b": nrm(ks[5], (DEPTH, N_MOD * D_MODEL), 0.02),
        "norm_g": 1.0 + nrm(ks[6], (DEPTH, 4, D_MODEL), 0.05),
        "w_in": nrm(ks[7], (DEPTH, D_MODEL, D_IN), D_MODEL ** -0.5),
        "mla_q_gain": 1.0 + nrm(ks[8], (DEPTH, MLA_Q_RANK), 0.05),
        "mla_kv_gain": 1.0 + nrm(ks[9], (DEPTH, MLA_KV_RANK), 0.05),
        "mla_w_uq": nrm(ks[10], (DEPTH, MLA_Q_RANK, MLA_HEADS * (MLA_NOPE + MLA_ROPE)), MLA_Q_RANK ** -0.5),
        "mla_w_ukv": nrm(ks[11], (DEPTH, MLA_KV_RANK, MLA_HEADS * (MLA_NOPE + MLA_V)), MLA_KV_RANK ** -0.5),
        "swa_sink": nrm(ks[12], (DEPTH, SWA_HEADS), 0.5),
        "diff_lambda": nrm(ks[13], (DEPTH, 4, DIFF_QK), 0.1),
        "diff_subln": 1.0 + nrm(ks[14], (DEPTH, DIFF_V), 0.05),
        "pool_w": nrm(ks[15], (DEPTH, len(POOL_WINDOWS), POOL_GROUP, POOL_GROUP), POOL_GROUP ** -0.5),
        "pool_scale": 1.0 + nrm(ks[16], (DEPTH, MIX_D), 0.1),
        "w_out": nrm(ks[17], (DEPTH, D_MIX, D_MODEL), D_MIX ** -0.5),
        "router_gw": nrm(ks[18], (DEPTH, D_MODEL, N_EXPERT_GROUPS), D_MODEL ** -0.5),
        "router_gb": nrm(ks[19], (DEPTH, N_EXPERT_GROUPS), 0.01),
        "router_ew": nrm(ks[20], (DEPTH, D_MODEL, N_EXPERTS), D_MODEL ** -0.5),
        "router_eb": nrm(ks[21], (DEPTH, N_EXPERTS), 0.01),
        "exp_w_gu": nrm(ks[22], (DEPTH, N_EXPERTS, D_MODEL, 2 * D_EXPERT), D_MODEL ** -0.5),
        "exp_w_down": nrm(ks[23], (DEPTH, N_EXPERTS, D_EXPERT, D_MODEL), D_EXPERT ** -0.5),
    }


def reference(x, c, ctx, c_ctx, ada_w, ada_b, norm_g, w_in, mla_q_gain, mla_kv_gain, mla_w_uq, mla_w_ukv,
              swa_sink, diff_lambda, diff_subln, pool_w, pool_scale, w_out, router_gw, router_gb,
              router_ew, router_eb, exp_w_gu, exp_w_down):
    B, L, D = x.shape
    ropes = (axial_rope_table(L, MLA_ROPE), axial_rope_table(L, SWA_HEAD_DIM), axial_rope_table(L, DIFF_QK))
    silu_c = jax.nn.silu(c)
    silu_cc = jax.nn.silu(c_ctx)
    h_ctx = ctx
    for layer in range(DEPTH):
        update_ctx = layer < DEPTH - 1
        mx = jnp.split((silu_c @ ada_w[layer] + ada_b[layer])[:, None, :], N_MOD, axis=-1)
        mc = jnp.split((silu_cc @ ada_w[layer] + ada_b[layer])[None, None, :], N_MOD, axis=-1)
        lam_init = 0.8 - 0.6 * math.exp(-0.3 * layer)
        dl = diff_lambda[layer].astype(jnp.float32)
        lam = jnp.exp(jnp.sum(dl[0] * dl[1])) - jnp.exp(jnp.sum(dl[2] * dl[3])) + lam_init

        hx = modulate(rms_norm(x, norm_g[layer, 0]), mx[0], mx[1])
        hc = modulate(rms_norm(h_ctx, norm_g[layer, 0]), mc[0], mc[1])
        zx = hx @ w_in[layer]
        zc = hc @ w_in[layer]
        kvx = mixer_keys_values(zx, mla_kv_gain[layer], mla_w_ukv[layer], ropes)
        kvc = mixer_keys_values(zc, mla_kv_gain[layer], mla_w_ukv[layer], None)
        qx = mixer_queries(zx, mla_q_gain[layer], mla_w_uq[layer], ropes)
        ox = latent_mix(qx, kvx, kvc, swa_sink[layer], lam, lam_init, diff_subln[layer],
                        pool_w[layer], pool_scale[layer]) @ w_out[layer]
        x = x + mx[2] * rms_norm(ox, norm_g[layer, 1])
        if update_ctx:
            qc = mixer_queries(zc, mla_q_gain[layer], mla_w_uq[layer], None)
            oc = context_mix(qc, kvc, swa_sink[layer], lam, lam_init, diff_subln[layer],
                             pool_w[layer], pool_scale[layer]) @ w_out[layer]
            h_ctx = h_ctx + mc[2] * rms_norm(oc, norm_g[layer, 1])

        fx = hier_moe(modulate(rms_norm(x, norm_g[layer, 2]), mx[3], mx[4]), router_gw[layer], router_gb[layer],
                      router_ew[layer], router_eb[layer], exp_w_gu[layer], exp_w_down[layer])
        x = x + mx[5] * rms_norm(fx, norm_g[layer, 3])
        if update_ctx:
            fc = hier_moe(modulate(rms_norm(h_ctx, norm_g[layer, 2]), mc[3], mc[4]), router_gw[layer],
                          router_gb[layer], router_ew[layer], router_eb[layer], exp_w_gu[layer], exp_w_down[layer])
            h_ctx = h_ctx + mc[5] * rms_norm(fc, norm_g[layer, 3])
    return x
```

```cpp
#include <hip/hip_runtime.h>
#include <cstdio>
#include <cstdint>

#ifndef USE_NAIVE_ATTN
#define USE_NAIVE_ATTN 0
#endif
#ifndef USE_NAIVE_TOKB
#define USE_NAIVE_TOKB 0
#endif
#ifndef N_LAUNCH_MODE
#define N_LAUNCH_MODE 0
#endif

constexpr int D = 1024, BATCH = 16, SEQ = 2048, CTXL = 256, DEPTH = 2, GRIDW = 64;
constexpr int TL = BATCH * SEQ, TC = BATCH * CTXL, T = TL + TC;
constexpr int D_IN = 1952, NMOD = 6;
constexpr float EPS = 1e-6f;
constexpr float LOG2E = 1.4426950408889634f;
constexpr int Z_CQ = 0, Z_CKV = 256, Z_KR = 384, Z_BQ = 416, Z_BK = 672, Z_BV = 800, Z_DQ = 928, Z_DK = 1184, Z_DV = 1440, Z_U = 1696;
constexpr float SC_A = 0.10206207261596577f * LOG2E;
constexpr float SC_B = 0.125f * LOG2E;
constexpr float SC_C = 0.17677669529663687f * LOG2E;

constexpr size_t MiB = 1u << 20;
constexpr size_t WS_CTL = 0, CTL_BYTES = 1 * MiB;
constexpr size_t WS_MOD = 1 * MiB;
constexpr size_t WS_HCTX = 4 * MiB;
constexpr size_t WS_QKV = 130 * MiB;
constexpr size_t QA_OFF = 0, KA_OFF = QA_OFF + (size_t)T * 384 * 2, VA_OFF = KA_OFF + (size_t)T * 384 * 2,
                 QB_OFF = VA_OFF + (size_t)T * 256 * 2, KB_OFF = QB_OFF + (size_t)T * 256 * 2, VB_OFF = KB_OFF + (size_t)T * 128 * 2,
                 QC_OFF = VB_OFF + (size_t)T * 128 * 2, KC_OFF = QC_OFF + (size_t)T * 256 * 2, VC_OFF = KC_OFF + (size_t)T * 256 * 2,
                 U_OFF = VC_OFF + (size_t)T * 256 * 2, QKV_END = U_OFF + (size_t)T * 256 * 2;
static_assert(QKV_END <= 180 * MiB, "qkv region");
constexpr size_t WS_O = 310 * MiB;
constexpr size_t WS_WIN = 20 * MiB;
constexpr size_t WS_WOUT = 28 * MiB;
constexpr size_t WS_WUQ = 32 * MiB;
constexpr size_t WS_WUKV = 32 * MiB + 512 * 1024;
constexpr size_t WS_WGU = 34 * MiB;
constexpr size_t WS_WDN = 98 * MiB;
constexpr size_t WS_HX = 382 * MiB;
constexpr size_t WS_CQ = 454 * MiB;
constexpr size_t WS_CKVR = 472 * MiB;
constexpr size_t WS_SSQ = 490 * MiB;
constexpr size_t WS_SSK = 491 * MiB;
constexpr size_t WS_SS1 = 492 * MiB;
constexpr size_t WS_SS2 = 495 * MiB;
constexpr size_t WS_LIST = 498 * MiB;
constexpr size_t WS_TOKW = 502 * MiB;
constexpr size_t WS_END = 503 * MiB;
constexpr size_t WS_OX = WS_QKV;
constexpr size_t WS_ACT = WS_QKV;
constexpr size_t WS_HM = WS_QKV + 96 * MiB;
constexpr size_t WS_FX = WS_O;
constexpr int ACT_ROWS = 43008;
static_assert((size_t)ACT_ROWS * 2048 <= 96 * MiB && WS_HM + (size_t)T * 2048 <= WS_QKV + 180 * MiB, "aliases");
constexpr int CW_CNT = 8192;

typedef unsigned short bf16_t;
#define LAS __attribute__((address_space(3)))

__device__ __forceinline__ float bf2f(bf16_t b) { return __uint_as_float(((unsigned)b) << 16); }
__device__ __forceinline__ bf16_t f2bf(float f) { unsigned u = __float_as_uint(f); u += 0x7fffu + ((u >> 16) & 1u); return (bf16_t)(u >> 16); }

struct alignas(16) RopeTab { float c[64][24]; float s[64][24]; };
constexpr double cx_exp(double x) {
    int k = 0; while (x < -0.5) { x *= 0.5; ++k; }
    double t = 1.0, s = 1.0; for (int i = 1; i < 30; ++i) { t *= x / i; s += t; }
    for (int i = 0; i < k; ++i) s *= s; return s;
}
constexpr double cx_pi = 3.14159265358979323846264338327950288;
constexpr double cx_sin_small(double x) { double t = x, s = x; for (int i = 1; i < 14; ++i) { t *= -x * x / ((2 * i) * (2 * i + 1)); s += t; } return s; }
constexpr double cx_cos_small(double x) { double t = 1.0, s = 1.0; for (int i = 1; i < 14; ++i) { t *= -x * x / ((2 * i - 1) * (2 * i)); s += t; } return s; }
constexpr double cx_reduce(double x) { double q = x / (2 * cx_pi); long long n = (long long)q; double r = x - (double)n * 2 * cx_pi; if (r > cx_pi) r -= 2 * cx_pi; return r; }
constexpr RopeTab make_rope() {
    RopeTab t{};
    const double ln1e4 = 9.21034037197618273607196581873745683;
    double inv[24] = {};
    for (int f = 0; f < 24; ++f) inv[f] = (f < 8) ? cx_exp(-(double)f / 8.0 * ln1e4) : cx_exp(-(double)(f - 8) / 16.0 * ln1e4);
    for (int p = 0; p < 64; ++p) for (int f = 0; f < 24; ++f) {
        const double a = cx_reduce((double)p * inv[f]);
        t.c[p][f] = (float)cx_cos_small(a); t.s[p][f] = (float)cx_sin_small(a);
    }
    return t;
}
__device__ constexpr RopeTab g_rope = make_rope();
__device__ __forceinline__ void rope_cs_a(int t, int i, float& c, float& s) { const int p = (i < 8) ? (t >> 6) : (t & 63), f = i & 7; c = g_rope.c[p][f]; s = g_rope.s[p][f]; }
__device__ __forceinline__ void rope_cs_b(int t, int i, float& c, float& s) { const int p = (i < 16) ? (t >> 6) : (t & 63), f = 8 + (i & 15); c = g_rope.c[p][f]; s = g_rope.s[p][f]; }

#define XB_TMO      128
#define XB_XCNT(j)  (256  + 64 * (j))
#define XB_XSUB(j)  (1280 + 64 * (j))
#define XB_XGEN(j)  (2304 + 64 * (j))
#define XB_TOP      3328
#define XB_TOPGEN   3392
#define XCD_BAR_WORDS 3456
#define XB_SPIN_CAP (1u << 18)
__device__ __forceinline__ unsigned xb_ld(unsigned* p)              { return __hip_atomic_load(p, __ATOMIC_RELAXED, __HIP_MEMORY_SCOPE_AGENT); }
__device__ __forceinline__ unsigned xb_add(unsigned* p, unsigned v) { return __hip_atomic_fetch_add(p, v, __ATOMIC_RELAXED, __HIP_MEMORY_SCOPE_AGENT); }
__device__ __forceinline__ unsigned xb_xcc_id() { return (unsigned)__builtin_amdgcn_s_getreg((3 << 11) | 20) & 0xFu; }
#define XB_SPIN(cond, bar) do { unsigned _sp = 0; while (cond) { __builtin_amdgcn_s_sleep(1); \
    if ((++_sp & 255u) == 0u) { if (xb_ld(&(bar)[XB_TMO])) break; if (_sp > XB_SPIN_CAP) { atomicAdd(&(bar)[XB_TMO], 1u); break; } } } } while (0)
struct XcdBarrier { unsigned* bar; unsigned x; volatile LAS unsigned* st; };
__device__ __forceinline__ XcdBarrier xcd_barrier_post(unsigned* bar, volatile LAS unsigned* st) {
    XcdBarrier b; b.bar = bar; b.x = xb_xcc_id(); b.st = st;
    if (threadIdx.x == 0) (void)xb_add(&bar[XB_XCNT(b.x)], 1u);
    return b;
}
__device__ __forceinline__ void xcd_barrier_complete(unsigned* bar, unsigned x, unsigned& nloc, unsigned& nx) {
    const unsigned G = gridDim.x * gridDim.y * gridDim.z;
    unsigned sum, cnt, mine, sp = 0u;
    for (;;) {
        sum = 0u; cnt = 0u; mine = 0u;
#pragma unroll
        for (unsigned j = 0; j < 16; ++j) { const unsigned c = xb_ld(&bar[XB_XCNT(j)]); sum += c; cnt += (c > 0u) ? 1u : 0u; mine = (j == x) ? c : mine; }
        if (sum == G) break;
        __builtin_amdgcn_s_sleep(1);
        if ((++sp & 255u) == 0u) { if (xb_ld(&bar[XB_TMO])) break; if (sp > XB_SPIN_CAP) { atomicAdd(&bar[XB_TMO], 1u); break; } }
    }
    nloc = mine > 0u ? mine : 1u; nx = cnt > 0u ? cnt : 1u;
}
__device__ __forceinline__ void xcd_barrier(const XcdBarrier& b) {
    asm volatile("s_waitcnt vmcnt(0)" ::: "memory");
    __syncthreads();
    if (threadIdx.x == 0) {
        unsigned* bar = b.bar;
        __builtin_amdgcn_s_waitcnt(0);
        unsigned nloc = b.st[0], nx = b.st[1];
        if (nloc == 0u) { xcd_barrier_complete(bar, b.x, nloc, nx); b.st[0] = nloc; b.st[1] = nx; }
        const unsigned old = xb_add(&bar[XB_XSUB(b.x)], 1u);
        const unsigned gen = old / nloc;
        if (old + 1u == (gen + 1u) * nloc) {
            __builtin_amdgcn_fence(__ATOMIC_RELEASE, "agent");
            asm volatile("s_waitcnt vmcnt(0)" ::: "memory");
            const unsigned og = xb_add(&bar[XB_TOP], 1u);
            const unsigned tg = og / nx;
            if (og + 1u == (tg + 1u) * nx) xb_add(&bar[XB_TOPGEN], 1u);
            else XB_SPIN(xb_ld(&bar[XB_TOPGEN]) == tg, bar);
            __builtin_amdgcn_fence(__ATOMIC_ACQUIRE, "agent");
            xb_add(&bar[XB_XGEN(b.x)], 1u);
            asm volatile("s_waitcnt vmcnt(0)" ::: "memory");
        } else {
            XB_SPIN(xb_ld(&bar[XB_XGEN(b.x)]) == gen, bar);
            __builtin_amdgcn_fence(__ATOMIC_ACQUIRE, "agent");
            asm volatile("s_waitcnt vmcnt(0)" ::: "memory");
        }
    }
    __syncthreads();
}

constexpr int NTHREADS = 512, NWAVES = 8;
constexpr int LDS_BYTES = 147456;
constexpr int LDS_MISC = 143360;

struct Args {
    const float* in[24]; float* out; unsigned char* ws; int ph_lo, ph_hi;
};
struct Ctx {
    const float *x, *c, *ctx, *c_ctx, *ada_w, *ada_b, *norm_g, *w_in, *q_gain, *kv_gain, *w_uq, *w_ukv, *sink, *dlam, *subln, *pool_w, *pool_scale,
                *w_out, *r_gw, *r_gb, *r_ew, *r_eb, *w_gu, *w_down;
    float* out; unsigned char* ws;
    float* mod; float* hctx;
    bf16_t *QA, *KA, *VA, *QB, *KB, *VB, *QC, *KC, *VC, *U, *O;
    bf16_t *WIN, *WOUT, *WUQ, *WUKV, *WGU, *WDN, *HX, *CQ, *CKVR; float *SSQ, *SSK;
    bf16_t *OX, *ACT, *HM, *FX; float *SS1, *SS2, *TOKW; int* LIST; unsigned* CNT;
};
__device__ __forceinline__ float wave_sum(float v) {
#pragma unroll
    for (int o = 32; o >= 1; o >>= 1) v += __shfl_xor(v, o);
    return v;
}
__device__ __forceinline__ float wave_max(float v) {
#pragma unroll
    for (int o = 32; o >= 1; o >>= 1) v = fmaxf(v, __shfl_xor(v, o));
    return v;
}
__device__ __forceinline__ float block_sum(float v, float* red) {
    v = wave_sum(v);
    __syncthreads();
    if ((threadIdx.x & 63) == 0) red[threadIdx.x >> 6] = v;
    __syncthreads();
    float s = 0.f;
#pragma unroll
    for (int i = 0; i < NWAVES; ++i) s += red[i];
    return s;
}
__device__ __forceinline__ int opaque_tid() { int t = threadIdx.x; asm volatile("" : "+v"(t)); return t; }
__device__ __forceinline__ float silu_f(float v) { return v / (1.f + __expf(-v)); }
__device__ __forceinline__ float lam_init_of(int layer) { return layer == 0 ? 0.2f : (0.8f - 0.6f * 0.7408182206817179f); }

__device__ __forceinline__ const float* xrow_in(const Ctx& C, int layer, int r) {
    const float* a0 = C.x + 0; const float* a1 = C.out + 0; const float* b0 = C.ctx + 0; const float* b1 = C.hctx + 0;
    if (r < TL) return (layer == 0 ? a0 : a1) + (size_t)r * D;
    return (layer == 0 ? b0 : b1) + (size_t)(r - TL) * D;
}
__device__ __forceinline__ float* xrow_out(const Ctx& C, int r) { float* a1 = C.out + 0; float* b1 = C.hctx + 0; return (r < TL) ? a1 + (size_t)r * D : b1 + (size_t)(r - TL) * D; }

__device__ __forceinline__ void phase_mod(const Ctx& C, float* lds) {
    float* sv = lds;
    float* part = lds + 17 * 1024;
    const int tid = opaque_tid(), lane = tid & 63, wave = tid >> 6;
    for (int i = tid; i < 17 * 1024; i += NTHREADS) { const float v = (i < 16 * 1024) ? C.c[i] : C.c_ctx[i - 16 * 1024]; sv[i] = silu_f(v); }
    __syncthreads();
    const int nitems = DEPTH * (NMOD * D / 64);
    for (int item = blockIdx.x; item < nitems; item += gridDim.x) {
        const int l = item / (NMOD * D / 64), j = (item % (NMOD * D / 64)) * 64 + lane;
        const float* w = C.ada_w + (size_t)l * D * (NMOD * D) + j;
        float acc[17];
#pragma unroll
        for (int r = 0; r < 17; ++r) acc[r] = 0.f;
        for (int k = wave * 128; k < wave * 128 + 128; ++k) {
            const float wv = w[(size_t)k * (NMOD * D)];
#pragma unroll
            for (int r = 0; r < 17; ++r) acc[r] += sv[r * 1024 + k] * wv;
        }
#pragma unroll
        for (int r = 0; r < 17; ++r) part[(wave * 17 + r) * 64 + lane] = acc[r];
        __syncthreads();
        for (int i = tid; i < 17 * 64; i += NTHREADS) {
            const int r = i >> 6, jj = i & 63; float s = 0.f;
#pragma unroll
            for (int w8 = 0; w8 < 8; ++w8) s += part[(w8 * 17 + r) * 64 + jj];
            const int col = (item % (NMOD * D / 64)) * 64 + jj;
            C.mod[((size_t)l * 17 + r) * (NMOD * D) + col] = s + C.ada_b[(size_t)l * NMOD * D + col];
        }
        __syncthreads();
    }
}

constexpr int TOKA = 4;
__device__ __forceinline__ void naive_tokA(const Ctx& C, int layer, float* lds) {
    float* hx = lds;
    float* z = hx + TOKA * 1024;
    float* qn = z + TOKA * D_IN;
    float* kvn = qn + TOKA * 256;
    float* qa = kvn + TOKA * 128;
    float* kva = qa + TOKA * 384;
    float* red = kva + TOKA * 512;
    const int tid = opaque_tid();
    const float* g0 = C.norm_g + ((size_t)layer * 4 + 0) * D;
    for (int item = blockIdx.x; item < T / TOKA; item += gridDim.x) {
        const int r0 = item * TOKA;
        const bool isctx = r0 >= TL;
        const int b = isctx ? (r0 - TL) / CTXL : r0 / SEQ;
        const float* modp = C.mod + ((size_t)layer * 17 + (isctx ? 16 : b)) * (NMOD * D);
        __syncthreads();
        for (int tk = 0; tk < TOKA; ++tk) {
            const float* xr = xrow_in(C, layer, r0 + tk);
            const float v0 = xr[tid], v1 = xr[tid + 512];
            const float ss = block_sum(v0 * v0 + v1 * v1, red);
            const float rstd = rsqrtf(ss * (1.f / D) + EPS);
            hx[tk * 1024 + tid] = (v0 * rstd * g0[tid]) * (1.f + modp[D + tid]) + modp[tid];
            hx[tk * 1024 + tid + 512] = (v1 * rstd * g0[tid + 512]) * (1.f + modp[D + tid + 512]) + modp[tid + 512];
        }
        __syncthreads();
        for (int jj = 0; jj < 4; ++jj) {
            const int j = tid + 512 * jj;
            if (j < D_IN) {
                const float* w = C.w_in + (size_t)layer * D * D_IN + j;
                float a0 = 0.f, a1 = 0.f, a2 = 0.f, a3 = 0.f;
#pragma unroll 8
                for (int k = 0; k < D; ++k) { const float wv = w[(size_t)k * D_IN]; a0 += hx[k] * wv; a1 += hx[1024 + k] * wv; a2 += hx[2048 + k] * wv; a3 += hx[3072 + k] * wv; }
                z[j] = a0; z[D_IN + j] = a1; z[2 * D_IN + j] = a2; z[3 * D_IN + j] = a3;
            }
        }
        __syncthreads();
        for (int tk = 0; tk < TOKA; ++tk) {
            const float v = (tid < 256) ? z[tk * D_IN + Z_CQ + tid] : 0.f;
            const float ssq = block_sum(v * v, red);
            const float w2 = (tid < 128) ? z[tk * D_IN + Z_CKV + tid] : 0.f;
            const float ssk = block_sum(w2 * w2, red);
            if (tid < 256) qn[tk * 256 + tid] = v * rsqrtf(ssq * (1.f / 256) + EPS) * C.q_gain[layer * 256 + tid];
            if (tid < 128) kvn[tk * 128 + tid] = w2 * rsqrtf(ssk * (1.f / 128) + EPS) * C.kv_gain[layer * 128 + tid];
        }
        __syncthreads();
        if (tid < 384) {
            const float* w = C.w_uq + (size_t)layer * 256 * 384 + tid;
            float a0 = 0.f, a1 = 0.f, a2 = 0.f, a3 = 0.f;
            for (int k = 0; k < 256; ++k) { const float wv = w[k * 384]; a0 += qn[k] * wv; a1 += qn[256 + k] * wv; a2 += qn[512 + k] * wv; a3 += qn[768 + k] * wv; }
            qa[tid] = a0; qa[384 + tid] = a1; qa[768 + tid] = a2; qa[1152 + tid] = a3;
        }
        {
            const float* w = C.w_ukv + (size_t)layer * 128 * 512 + tid;
            float a0 = 0.f, a1 = 0.f, a2 = 0.f, a3 = 0.f;
            for (int k = 0; k < 128; ++k) { const float wv = w[k * 512]; a0 += kvn[k] * wv; a1 += kvn[128 + k] * wv; a2 += kvn[256 + k] * wv; a3 += kvn[384 + k] * wv; }
            kva[tid] = a0; kva[512 + tid] = a1; kva[1024 + tid] = a2; kva[1536 + tid] = a3;
        }
        __syncthreads();
        for (int tk = 0; tk < TOKA; ++tk) {
            const int r = r0 + tk; const int t = r % SEQ;
            const float* zz = z + tk * D_IN; const float* qq = qa + tk * 384; const float* kk = kva + tk * 512;
            if (tid < 384) {
                const int h = tid / 96, e = tid % 96; float v;
                if (e < 64) v = qq[h * 96 + e];
                else { const int i = (e - 64) & 15; const float x1 = qq[h * 96 + 64 + i], x2 = qq[h * 96 + 80 + i]; float c = 1.f, s = 0.f; if (!isctx) rope_cs_a(t, i, c, s);
                       v = (e - 64 < 16) ? (x1 * c - x2 * s) : (x1 * s + x2 * c); }
                C.QA[(size_t)r * 384 + tid] = f2bf(v * SC_A);
                float kv_;
                if (e < 64) kv_ = kk[h * 128 + e];
                else { const int i = (e - 64) & 15; const float x1 = zz[Z_KR + i], x2 = zz[Z_KR + 16 + i]; float c = 1.f, s = 0.f; if (!isctx) rope_cs_a(t, i, c, s);
                       kv_ = (e - 64 < 16) ? (x1 * c - x2 * s) : (x1 * s + x2 * c); }
                C.KA[(size_t)r * 384 + tid] = f2bf(kv_);
            }
            if (tid < 256) {
                const int h = tid >> 6, e = tid & 63;
                C.VA[(size_t)r * 256 + tid] = f2bf(kk[h * 128 + 64 + e]);
                { const int i = e & 31; const float x1 = zz[Z_BQ + h * 64 + i], x2 = zz[Z_BQ + h * 64 + 32 + i]; float c = 1.f, s = 0.f; if (!isctx) rope_cs_b(t, i, c, s);
                  C.QB[(size_t)r * 256 + tid] = f2bf(((e < 32) ? (x1 * c - x2 * s) : (x1 * s + x2 * c)) * SC_B); }
                { const int hh = tid >> 5, ee = tid & 31, i = ee & 15; float c = 1.f, s = 0.f; if (!isctx) rope_cs_a(t, i, c, s);
                  const float x1 = zz[Z_DQ + hh * 32 + i], x2 = zz[Z_DQ + hh * 32 + 16 + i];
                  C.QC[(size_t)r * 256 + tid] = f2bf(((ee < 16) ? (x1 * c - x2 * s) : (x1 * s + x2 * c)) * SC_C);
                  const float y1 = zz[Z_DK + hh * 32 + i], y2 = zz[Z_DK + hh * 32 + 16 + i];
                  C.KC[(size_t)r * 256 + tid] = f2bf((ee < 16) ? (y1 * c - y2 * s) : (y1 * s + y2 * c)); }
                C.VC[(size_t)r * 256 + tid] = f2bf(zz[Z_DV + tid]);
                C.U[(size_t)r * 256 + tid] = f2bf(zz[Z_U + tid]);
            }
            if (tid < 128) {
                const int h = tid >> 6, e = tid & 63, i = e & 31; const float x1 = zz[Z_BK + h * 64 + i], x2 = zz[Z_BK + h * 64 + 32 + i]; float c = 1.f, s = 0.f; if (!isctx) rope_cs_b(t, i, c, s);
                C.KB[(size_t)r * 128 + tid] = f2bf((e < 32) ? (x1 * c - x2 * s) : (x1 * s + x2 * c));
                C.VB[(size_t)r * 128 + tid] = f2bf(zz[Z_BV + tid]);
            }
        }
    }
}

template <int DQK>
__device__ __forceinline__ float dot_qk(const float* q  , const bf16_t* krow) {
    float s = 0.f;
#pragma unroll
    for (int c = 0; c < DQK / 8; ++c) {
        const uint4 kv = *(const uint4*)(krow + c * 8);
        const unsigned w[4] = {kv.x, kv.y, kv.z, kv.w};
#pragma unroll
        for (int j = 0; j < 4; ++j) { s += q[c * 8 + 2 * j] * __uint_as_float(w[j] << 16); s += q[c * 8 + 2 * j + 1] * __uint_as_float(w[j] & 0xffff0000u); }
    }
    return s;
}
template <int DQK>
__device__ __forceinline__ void naive_attend(const float* q, float* sc, const bf16_t* K, int kpitch, int koff, const bf16_t* V, int vpitch, int voff,
                                             int b, int lk0, int lk1, int lane, float& m_out, float& l_out, float& o_out) {
    const int nl = lk1 - lk0, ntot = nl + CTXL;
    const size_t lat0 = (size_t)b * SEQ + lk0, ctx0 = (size_t)TL + (size_t)b * CTXL;
    float m = -INFINITY;
    for (int kk = lane; kk < ntot; kk += 64) {
        const size_t row = kk < nl ? lat0 + kk : ctx0 + (kk - nl);
        const float s = dot_qk<DQK>(q, K + row * kpitch + koff);
        sc[kk] = s; m = fmaxf(m, s);
    }
    m = wave_max(m);
    float l = 0.f;
    for (int kk = lane; kk < ntot; kk += 64) { const float p = exp2f(sc[kk] - m); sc[kk] = p; l += p; }
    l = wave_sum(l);
    float o = 0.f;
    for (int kk = 0; kk < ntot; ++kk) {
        const size_t row = kk < nl ? lat0 + kk : ctx0 + (kk - nl);
        o += sc[kk] * bf2f(V[row * vpitch + voff + lane]);
    }
    m_out = m; l_out = l; o_out = o;
}

__device__ __forceinline__ void naive_attn(const Ctx& C, int layer, float* lds) {
    const int tid = opaque_tid(), lane = tid & 63, wave = tid >> 6;
    float* qs = lds + wave * 2560;
    float* sc = qs + 128;
    const int gw = blockIdx.x * NWAVES + wave, ngw = gridDim.x * NWAVES;
    float lam;
    { const float* dl = C.dlam + (size_t)layer * 128; float s1 = 0.f, s2 = 0.f; for (int i = 0; i < 32; ++i) { s1 += dl[i] * dl[32 + i]; s2 += dl[64 + i] * dl[96 + i]; }
      lam = expf(s1) - expf(s2) + lam_init_of(layer); }
    const float lam_init = lam_init_of(layer);
    const int nrows = (layer == DEPTH - 1) ? TL : T;
    for (long it = gw; it < (long)nrows * 16; it += ngw) {
        const int r = (int)(it >> 4), task = (int)(it & 15);
        const bool isctx = r >= TL;
        const int b = isctx ? (r - TL) / CTXL : r / SEQ;
        const int t = isctx ? (r - TL) % CTXL : r % SEQ;
        float m, l, o;
        if (task < 4) {
            const int h = task;
            for (int i = lane; i < 96; i += 64) qs[i] = bf2f(C.QA[(size_t)r * 384 + h * 96 + i]);
            naive_attend<96>(qs, sc, C.KA, 384, h * 96, C.VA, 256, h * 64, b, 0, isctx ? 0 : SEQ, lane, m, l, o);
            C.O[(size_t)r * D + h * 64 + lane] = f2bf(o / l);
        } else if (task < 8) {
            const int h = task - 4, kvh = h >> 1;
            qs[lane] = bf2f(C.QB[(size_t)r * 256 + h * 64 + lane]);
            naive_attend<64>(qs, sc, C.KB, 128, kvh * 64, C.VB, 128, kvh * 64, b, isctx ? 0 : max(t - 128, 0), isctx ? 0 : min(t + 129, SEQ), lane, m, l, o);
            const float sk = C.sink[layer * 4 + h] * LOG2E;
            const float mm = fmaxf(m, sk); const float f = exp2f(m - mm);
            const float ll = l * f + exp2f(sk - mm);
            C.O[(size_t)r * D + 256 + h * 64 + lane] = f2bf(o * f / ll);
        } else if (task < 12) {
            const int h = task - 8; float oc[2];
            for (int cpn = 0; cpn < 2; ++cpn) {
                const int j = 2 * h + cpn;
                if (lane < 32) qs[lane] = bf2f(C.QC[(size_t)r * 256 + j * 32 + lane]);
                naive_attend<32>(qs, sc, C.KC, 256, j * 32, C.VC, 256, h * 64, b, 0, isctx ? 0 : SEQ, lane, m, l, o);
                oc[cpn] = o / l;
            }
            const float a = oc[0] - lam * oc[1];
            const float ss = wave_sum(a * a);
            C.O[(size_t)r * D + 512 + h * 64 + lane] = f2bf(a * rsqrtf(ss * (1.f / 64) + EPS) * C.subln[layer * 64 + lane] * (1.f - lam_init));
        } else {
            const int g = task - 12, w = 2 << g, half = w >> 1, L = isctx ? CTXL : SEQ;
            const size_t rbase = (size_t)r - t;
            const int lo = max(t - half, 0), hi = min(t - half + w, L);
            float s = 0.f;
            for (int p = lo; p < hi; ++p) s += bf2f(C.U[(rbase + p) * 256 + g * 64 + lane]);
            const float dg = s / (float)(hi - lo) - bf2f(C.U[(size_t)r * 256 + g * 64 + lane]);
            const float* pw = C.pool_w + ((size_t)layer * 4 + g) * 64 * 64;
            float y = 0.f;
            for (int c = 0; c < 64; ++c) y += __shfl(dg, c) * pw[c * 64 + lane];
            C.O[(size_t)r * D + 768 + g * 64 + lane] = f2bf(y * C.pool_scale[layer * 256 + g * 64 + lane]);
        }
    }
}

__device__ __forceinline__ void naive_tokB(const Ctx& C, int layer, float* lds) {
    float* ov = lds;
    float* x1 = ov + 1024;
    float* hm = x1 + 1024;
    float* gu = hm + 1024;
    float* act = gu + 1024;
    float* yv = act + 512;
    float* red = yv + 1024;
    float* lg = red + 8;
    const int tid = opaque_tid(), lane = tid & 63, wave = tid >> 6;
    const float* g1 = C.norm_g + ((size_t)layer * 4 + 1) * D;
    const float* g2 = C.norm_g + ((size_t)layer * 4 + 2) * D;
    const float* g3 = C.norm_g + ((size_t)layer * 4 + 3) * D;
    const int nrows = (layer == DEPTH - 1) ? TL : T;
    for (int r = blockIdx.x; r < nrows; r += gridDim.x) {
        const bool isctx = r >= TL;
        const int b = isctx ? (r - TL) / CTXL : r / SEQ;
        const float* modp = C.mod + ((size_t)layer * 17 + (isctx ? 16 : b)) * (NMOD * D);
        __syncthreads();
        ov[tid] = bf2f(C.O[(size_t)r * D + tid]); ov[tid + 512] = bf2f(C.O[(size_t)r * D + tid + 512]);
        __syncthreads();
        float a0 = 0.f, a1 = 0.f;
        { const float* w = C.w_out + (size_t)layer * D * D + tid;
#pragma unroll 8
          for (int k = 0; k < D; ++k) { const float ok = ov[k]; a0 += ok * w[(size_t)k * D]; a1 += ok * w[(size_t)k * D + 512]; } }
        float ss = block_sum(a0 * a0 + a1 * a1, red);
        float rstd = rsqrtf(ss * (1.f / D) + EPS);
        const float* xr = xrow_in(C, layer, r);
        const float xa = xr[tid] + modp[2 * D + tid] * (a0 * rstd * g1[tid]);
        const float xb = xr[tid + 512] + modp[2 * D + tid + 512] * (a1 * rstd * g1[tid + 512]);
        ss = block_sum(xa * xa + xb * xb, red);
        rstd = rsqrtf(ss * (1.f / D) + EPS);
        hm[tid] = (xa * rstd * g2[tid]) * (1.f + modp[4 * D + tid]) + modp[3 * D + tid];
        hm[tid + 512] = (xb * rstd * g2[tid + 512]) * (1.f + modp[4 * D + tid + 512]) + modp[3 * D + tid + 512];
        __syncthreads();
        for (int q = wave; q < 20; q += NWAVES) {
            float s = 0.f;
            if (q < 4) { const float* w = C.r_gw + (size_t)layer * D * 4 + q; for (int k = lane; k < D; k += 64) s += hm[k] * w[k * 4]; }
            else { const float* w = C.r_ew + (size_t)layer * D * 16 + (q - 4); for (int k = lane; k < D; k += 64) s += hm[k] * w[k * 16]; }
            s = wave_sum(s);
            if (lane == 0) lg[q] = s + (q < 4 ? C.r_gb[layer * 4 + q] : C.r_eb[layer * 16 + (q - 4)]);
        }
        __syncthreads();
        int gsel = 0; float gmax = lg[0];
        for (int i = 1; i < 4; ++i) if (lg[i] > gmax) { gmax = lg[i]; gsel = i; }
        float gs = 0.f; for (int i = 0; i < 4; ++i) gs += expf(lg[i] - gmax);
        const float pg = 1.f / gs;
        int i1 = 0; float v1 = lg[4 + gsel * 4];
        for (int i = 1; i < 4; ++i) if (lg[4 + gsel * 4 + i] > v1) { v1 = lg[4 + gsel * 4 + i]; i1 = i; }
        int i2 = -1; float v2 = -INFINITY;
        for (int i = 0; i < 4; ++i) if (i != i1 && lg[4 + gsel * 4 + i] > v2) { v2 = lg[4 + gsel * 4 + i]; i2 = i; }
        const float e2 = expf(v2 - v1); const float w1 = pg / (1.f + e2), w2 = pg * e2 / (1.f + e2);
        float y0 = 0.f, y1 = 0.f;
        for (int s = 0; s < 2; ++s) {
            const int e = gsel * 4 + (s == 0 ? i1 : i2); const float wsel = (s == 0) ? w1 : w2;
            const float* wg = C.w_gu + ((size_t)layer * 16 + e) * D * 1024 + tid;
            float c0 = 0.f, c1 = 0.f;
#pragma unroll 8
            for (int k = 0; k < D; ++k) { const float hk = hm[k]; c0 += hk * wg[(size_t)k * 1024]; c1 += hk * wg[(size_t)k * 1024 + 512]; }
            __syncthreads();
            act[tid] = silu_f(c0) * c1;
            __syncthreads();
            const float* wd = C.w_down + ((size_t)layer * 16 + e) * 512 * D + tid;
            float d0 = 0.f, d1 = 0.f;
#pragma unroll 8
            for (int k = 0; k < 512; ++k) { const float ak = act[k]; d0 += ak * wd[(size_t)k * D]; d1 += ak * wd[(size_t)k * D + 512]; }
            y0 += wsel * d0; y1 += wsel * d1;
        }
        ss = block_sum(y0 * y0 + y1 * y1, red);
        rstd = rsqrtf(ss * (1.f / D) + EPS);
        float* xo = xrow_out(C, r);
        xo[tid] = xa + modp[5 * D + tid] * (y0 * rstd * g3[tid]);
        xo[tid + 512] = xb + modp[5 * D + tid + 512] * (y1 * rstd * g3[tid + 512]);
    }
}

namespace pg8 {
typedef short bf16x8 __attribute__((ext_vector_type(8)));
typedef float f32x4 __attribute__((ext_vector_type(4)));
typedef unsigned u32x4 __attribute__((ext_vector_type(4)));
typedef unsigned u32x2 __attribute__((ext_vector_type(2)));
constexpr int BM = 256, BK = 64, HALF = 128, HTB = HALF * BK * 2, STAGE_BYTES = 8 * HTB, NXCD = 8, WGM = 8;
__host__ __device__ __forceinline__ int lds_byte(int r, int c) { const int st = (r >> 4) * 2 + (c >> 5), rr = r & 15, cc = c & 31, ob = rr * 64 + cc * 2; return st * 1024 + (ob ^ (((ob >> 9) & 1) << 5)); }
__host__ __device__ __forceinline__ void stage_rc(int b, int& R, int& C) { const int st = b / 1024, sb = b % 1024, swz = sb ^ (((sb >> 9) & 1) << 5); R = (st >> 1) * 16 + swz / 64; C = (st & 1) * 32 + (swz % 64) / 2; }
__host__ __device__ __forceinline__ int perm32(int rho) { const int n = rho >> 4, i = rho & 15; return 8 * (i >> 2) + 4 * n + (i & 3); }
__device__ __forceinline__ unsigned cvt_pk_bf16(float lo, float hi) { unsigned r; asm volatile("v_cvt_pk_bf16_f32 %0, %1, %2" : "=v"(r) : "v"(lo), "v"(hi)); return r; }

__device__ __forceinline__ bool static_tile(int i, int G, int c, int nM, int nN, int& pm, int& pn) {
    const int nwg = nM * nN; const long L = (long)i * G + c; if (L >= nwg) return false;
    int wgid = (int)L; { const int q = nwg / NXCD, r = nwg % NXCD, xcd = wgid % NXCD, off = wgid / NXCD; wgid = (xcd < r ? xcd * (q + 1) : r * (q + 1) + (xcd - r) * q) + off; }
    const int nig = WGM * nN, gid = wgid / nig, fm = gid * WGM, gsz = (nM - fm) < WGM ? (nM - fm) : WGM;
    pm = fm + ((wgid % nig) % gsz); pn = (wgid % nig) / gsz; return true;
}
struct GUnit { const char* A; const char* B; const char* B2; int pm, pn, x0, x1; };
template <class Epi, class Sched>
__device__ __forceinline__ void gemm_phase(LAS unsigned char* lds, const int K, const int ldb  , const int ksplit  , const Sched& S, const Epi& E) {
    const int tid = opaque_tid(), wid = __builtin_amdgcn_readfirstlane(tid >> 6), lane = tid & 63, wr = wid >> 2, wc = wid & 3, fr = lane & 15, fq = lane >> 4;
    int nt = K / BK; asm volatile("" : "+s"(nt));
    unsigned voffB[2];
#pragma unroll
    for (int i = 0; i < 2; ++i) { int R_, C_; stage_rc(tid * 16 + i * 8192, R_, C_); const int Rb = Epi::PERM ? ((R_ & ~31) + perm32(R_ & 31)) : R_; voffB[i] = (unsigned)(Rb * ldb + C_) * 2u; }
    const size_t kstep = (size_t)(BK * 2);
    const size_t hstepB = (size_t)HALF * ldb * 2;
    const unsigned ldsw = (unsigned)wid * 1024u;
    const int aoff = lds_byte(wr * 64 + fr, fq * 8), boff = lds_byte(wc * 32 + fr, fq * 8);
#define PG8_SA(b, h) (((b) * 2 + (h)) * HTB)
#define PG8_SB(b, h) ((4 + (b) * 2 + (h)) * HTB)
#define PG8_STAGE(bufoff, gbase, v0, v1) do { \
        __builtin_amdgcn_global_load_lds((const unsigned*)((const char*)(gbase) + (v0)), (LAS unsigned*)(lds + (bufoff) + ldsw), 16, 0, 0); \
        __builtin_amdgcn_global_load_lds((const unsigned*)((const char*)(gbase) + (v1)), (LAS unsigned*)(lds + (bufoff) + ldsw + 8192), 16, 0, 0); } while (0)
#define PG8_STAGE_B(bufoff, gbase) PG8_STAGE(bufoff, gbase, voffB[0], voffB[1])
#define PG8_LDA(dst, b, h) do { _Pragma("unroll") for (int m = 0; m < 4; ++m) _Pragma("unroll") for (int k = 0; k < 2; ++k) dst[m][k] = *(const LAS bf16x8*)(lds + PG8_SA(b, h) + aoff + m * 2048 + k * 1024); } while (0)
#define PG8_LDB(dst, b, h) do { _Pragma("unroll") for (int n = 0; n < 2; ++n) _Pragma("unroll") for (int k = 0; k < 2; ++k) dst[n][k] = *(const LAS bf16x8*)(lds + PG8_SB(b, h) + boff + n * 2048 + k * 1024); } while (0)
#define PG8_MMA(ai, bj, At, Bt) do { __builtin_amdgcn_s_setprio(1); _Pragma("unroll") for (int m = 0; m < 4; ++m) _Pragma("unroll") for (int n = 0; n < 2; ++n) _Pragma("unroll") for (int k = 0; k < 2; ++k) \
        acc[ai][bj][m][n] = __builtin_amdgcn_mfma_f32_16x16x32_bf16(Bt[n][k], At[m][k], acc[ai][bj][m][n], 0, 0, 0); __builtin_amdgcn_s_setprio(0); } while (0)
#define PG8_WAIT_V(n) asm volatile("s_waitcnt vmcnt(" #n ")" ::: "memory")
#define PG8_WAIT_L(n) asm volatile("s_waitcnt lgkmcnt(" #n ")" ::: "memory")
#define PG8_BAR __builtin_amdgcn_s_barrier()
#define PG8_SCHED __builtin_amdgcn_sched_barrier(0)
#define PG8_BPTR(u, kt) (((kt) < ksplit) ? (u).B + (size_t)(kt) * kstep : (u).B2 + (size_t)((kt) - ksplit) * kstep)
    GUnit cur, nxt; int ui = 0;
    if (!S.next(0, cur)) return;

    f32x4 acc[2][2][4][2];
#pragma unroll
    for (int a = 0; a < 2; ++a)
#pragma unroll
        for (int b = 0; b < 2; ++b)
#pragma unroll
            for (int m = 0; m < 4; ++m)
#pragma unroll
                for (int n = 0; n < 2; ++n) acc[a][b][m][n] = (f32x4){0.f, 0.f, 0.f, 0.f};
    bf16x8 At[4][2], B0[2][2], B1[2][2];
    unsigned vc00, vc01, vc10, vc11;
#define PG8_AOFFS(u) do { int R0_, C0_, R1_, C1_; stage_rc(tid * 16, R0_, C0_); stage_rc(tid * 16 + 8192, R1_, C1_); \
        vc00 = S.arow(u, R0_) + C0_ * 2u; vc01 = S.arow(u, R1_) + C1_ * 2u; vc10 = S.arow(u, HALF + R0_) + C0_ * 2u; vc11 = S.arow(u, HALF + R1_) + C1_ * 2u; } while (0)
    PG8_AOFFS(cur);
    const char* cA = cur.A;
    {
        const char* b0 = PG8_BPTR(cur, 0); const char* b1 = PG8_BPTR(cur, 1);
        PG8_STAGE_B(PG8_SB(0, 0), b0); PG8_STAGE(PG8_SA(0, 0), cA, vc00, vc01); PG8_STAGE_B(PG8_SB(0, 1), b0 + hstepB); PG8_STAGE(PG8_SA(0, 1), cA, vc10, vc11);
        if (wr == 1) PG8_BAR;
        PG8_WAIT_V(4); PG8_BAR;
        PG8_STAGE_B(PG8_SB(1, 0), b1); PG8_STAGE(PG8_SA(1, 0), cA + kstep, vc00, vc01); PG8_STAGE_B(PG8_SB(1, 1), b1 + hstepB);
        PG8_WAIT_V(6); PG8_BAR;
    }
#pragma unroll 1
    for (;;) {
        const bool has_next = S.next(ui + 1, nxt);
        if (!has_next) nxt = cur;
        const char* nA = nxt.A;
#pragma unroll 1
        for (int t = 0; t < nt; t += 2) {
            const bool last = (t == nt - 2);
            const char* a1 = cA + (size_t)(t + 1) * kstep;
            const char* a2 = last ? nA : cA + (size_t)(t + 2) * kstep;
            const char* a3 = a2 + kstep;
            const char* b2 = last ? PG8_BPTR(nxt, 0) : PG8_BPTR(cur, t + 2);
            const char* b3 = last ? PG8_BPTR(nxt, 1) : PG8_BPTR(cur, t + 3);
            PG8_LDB(B0, 0, 0); PG8_SCHED; PG8_LDA(At, 0, 0); PG8_STAGE(PG8_SA(1, 1), a1, vc10, vc11);
            PG8_WAIT_L(8); PG8_BAR; PG8_WAIT_L(0); PG8_MMA(0, 0, At, B0); PG8_BAR; PG8_SCHED;
            if (last) PG8_AOFFS(nxt);
            PG8_LDB(B1, 0, 1); PG8_STAGE_B(PG8_SB(0, 0), b2);
            PG8_BAR; PG8_WAIT_L(0); PG8_MMA(0, 1, At, B1); PG8_BAR;
            PG8_LDA(At, 0, 1); PG8_STAGE(PG8_SA(0, 0), a2, vc00, vc01);
            PG8_BAR; PG8_WAIT_L(0); PG8_MMA(1, 0, At, B0); PG8_BAR; PG8_SCHED;
            PG8_STAGE_B(PG8_SB(0, 1), b2 + hstepB);
            PG8_WAIT_V(6); PG8_BAR; PG8_MMA(1, 1, At, B1); PG8_BAR;
            PG8_LDB(B0, 1, 0); PG8_SCHED; PG8_LDA(At, 1, 0); PG8_STAGE(PG8_SA(0, 1), a2, vc10, vc11);
            PG8_WAIT_L(8); PG8_BAR; PG8_WAIT_L(0); PG8_MMA(0, 0, At, B0); PG8_BAR; PG8_SCHED;
            PG8_LDB(B1, 1, 1); PG8_STAGE_B(PG8_SB(1, 0), b3);
            PG8_BAR; PG8_WAIT_L(0); PG8_MMA(0, 1, At, B1); PG8_BAR;
            PG8_LDA(At, 1, 1); PG8_STAGE(PG8_SA(1, 0), a3, vc00, vc01);
            PG8_BAR; PG8_WAIT_L(0); PG8_MMA(1, 0, At, B0); PG8_BAR; PG8_SCHED;
            PG8_STAGE_B(PG8_SB(1, 1), b3 + hstepB);
            PG8_WAIT_V(6); PG8_BAR; PG8_MMA(1, 1, At, B1); PG8_BAR;
        }
        E(acc, cur, wr, wc, fr, fq);
        if (!has_next) break;
#pragma unroll
        for (int a = 0; a < 2; ++a)
#pragma unroll
            for (int b = 0; b < 2; ++b)
#pragma unroll
                for (int m = 0; m < 4; ++m)
#pragma unroll
                    for (int n = 0; n < 2; ++n) acc[a][b][m][n] = (f32x4){0.f, 0.f, 0.f, 0.f};
        cur = nxt; cA = nA; ++ui;
    }
    PG8_WAIT_V(0);
    if (wr == 0) PG8_BAR;
    PG8_BAR;
#undef PG8_SA
#undef PG8_SB
#undef PG8_STAGE
#undef PG8_STAGE_B
#undef PG8_LDA
#undef PG8_LDB
#undef PG8_MMA
#undef PG8_WAIT_V
#undef PG8_WAIT_L
#undef PG8_BAR
#undef PG8_SCHED
#undef PG8_BPTR
#undef PG8_AOFFS
}
}

template <class CM>
__device__ __forceinline__ void transpose_item(const float* W, int ldw, int Ksrc, const float* rs, bf16_t* dst, int K, const CM& cm, float* scr, int kb, int nb, int lane) {
    const int k0 = 64 * kb, n0 = 32 * nb;
    const int col = cm(n0 + (lane & 31));
#pragma unroll 8
    for (int i = 0; i < 32; ++i) { const int kk = 2 * i + (lane >> 5), k = k0 + kk;
        float v = 0.f; if (col >= 0 && k < Ksrc) { v = W[(size_t)k * ldw + col]; if (rs) v *= rs[k]; }
        scr[kk * 33 + (lane & 31)] = v; }
    asm volatile("s_waitcnt lgkmcnt(0)" ::: "memory");
    const int c = lane & 7;
#pragma unroll
    for (int j = 0; j < 4; ++j) { const int n = (lane >> 3) + 8 * j; const float* sp = scr + (8 * c) * 33 + n;
        uint4 o; o.x = pg8::cvt_pk_bf16(sp[0 * 33], sp[1 * 33]); o.y = pg8::cvt_pk_bf16(sp[2 * 33], sp[3 * 33]); o.z = pg8::cvt_pk_bf16(sp[4 * 33], sp[5 * 33]); o.w = pg8::cvt_pk_bf16(sp[6 * 33], sp[7 * 33]);
        *(uint4*)(dst + (size_t)(n0 + n) * K + k0 + 8 * c) = o; }
    asm volatile("s_waitcnt lgkmcnt(0)" ::: "memory");
}
__device__ __forceinline__ int headperm64(int w) { const int gi = w >> 5, wp = w & 31; return (wp < 16) ? 16 * gi + wp : 32 + 16 * gi + (wp - 16); }
struct WinMap { __device__ __forceinline__ int operator()(int n) const {
    if (n < 416) return n;
    if (n < 512) return -1;
    if (n < 768) { const int h = (n - 512) >> 6; return Z_BQ + h * 64 + headperm64((n - 512) & 63); }
    if (n < 896) { const int h = (n - 768) >> 6; return Z_BK + h * 64 + headperm64((n - 768) & 63); }
    if (n < 1024) return Z_BV + (n - 896);
    if (n < 1280) return Z_DQ + (n - 1024);
    if (n < 1536) return Z_DK + (n - 1280);
    if (n < 1792) return Z_DV + (n - 1536);
    return Z_U + (n - 1792); } };
struct IdMap { int nvalid; __device__ __forceinline__ int operator()(int n) const { return n < nvalid ? n : -1; } };
struct GuMap { __device__ __forceinline__ int operator()(int n) const { const int q = n >> 8, c = n & 255, jj = c >> 3, t = c & 7, hid = 128 * q + 4 * jj + (t & 3); return (t < 4) ? hid : 512 + hid; } };

__device__ __forceinline__ void phase_convert(const Ctx& C, float* lds) {
    const int tid = opaque_tid(), lane = tid & 63, wave = tid >> 6;
    float* scr = lds + wave * (64 * 33);
    const int gw = blockIdx.x * NWAVES + wave, ngw = gridDim.x * NWAVES;
    constexpr int I_IN = 16 * 64, I_UQ = 4 * 16, I_UKV = 4 * 16, I_OUT = 16 * 32, I_GU = 16 * 16 * 32, I_DN = 16 * 8 * 32;
    constexpr int I_L = I_IN + I_UQ + I_UKV + I_OUT + I_GU + I_DN;
    for (int it = gw; it < DEPTH * I_L; it += ngw) {
        const int l = it / I_L; int r = it % I_L;
        if (r < I_IN) { transpose_item(C.w_in + (size_t)l * D * D_IN, D_IN, D, nullptr, C.WIN + (size_t)l * 2048 * 1024, 1024, WinMap{}, scr, r / 64, r % 64, lane); continue; } r -= I_IN;
        if (r < I_UQ) { transpose_item(C.w_uq + (size_t)l * 256 * 384, 384, 256, C.q_gain + l * 256, C.WUQ + (size_t)l * 512 * 256, 256, IdMap{384}, scr, r / 16, r % 16, lane); continue; } r -= I_UQ;
        if (r < I_UKV) { transpose_item(C.w_ukv + (size_t)l * 128 * 512, 512, 128, C.kv_gain + l * 128, C.WUKV + (size_t)l * 512 * 256, 256, IdMap{512}, scr, r / 16, r % 16, lane); continue; } r -= I_UKV;
        if (r < I_OUT) { transpose_item(C.w_out + (size_t)l * D * D, D, D, nullptr, C.WOUT + (size_t)l * 1024 * 1024, 1024, IdMap{1024}, scr, r / 32, r % 32, lane); continue; } r -= I_OUT;
        if (r < I_GU) { const int e = r / (16 * 32), q = r % (16 * 32);
            transpose_item(C.w_gu + ((size_t)l * 16 + e) * D * 1024, 1024, D, nullptr, C.WGU + ((size_t)l * 16 + e) * 1024 * 1024, 1024, GuMap{}, scr, q / 32, q % 32, lane); continue; } r -= I_GU;
        { const int e = r / (8 * 32), q = r % (8 * 32);
            transpose_item(C.w_down + ((size_t)l * 16 + e) * 512 * D, D, 512, nullptr, C.WDN + ((size_t)l * 16 + e) * 1024 * 512, 512, IdMap{1024}, scr, q / 32, q % 32, lane); }
    }
}

__device__ __forceinline__ void phase_ln0(const Ctx& C, int layer) {
    const int tid = opaque_tid(), lane = tid & 63, wave = tid >> 6;
    const int gw = blockIdx.x * NWAVES + wave, ngw = gridDim.x * NWAVES;
    const float4* g0 = (const float4*)(C.norm_g + ((size_t)layer * 4 + 0) * D);
    for (int r = gw; r < T; r += ngw) {
        const bool isctx = r >= TL; const int b = isctx ? (r - TL) / CTXL : r / SEQ;
        const float4* modp = (const float4*)(C.mod + ((size_t)layer * 17 + (isctx ? 16 : b)) * (NMOD * D));
        const float4* xr = (const float4*)xrow_in(C, layer, r);
        float4 v[4]; float ss = 0.f;
#pragma unroll
        for (int j = 0; j < 4; ++j) { v[j] = xr[lane + 64 * j]; ss += (v[j].x * v[j].x + v[j].y * v[j].y) + (v[j].z * v[j].z + v[j].w * v[j].w); }
        const float rstd = rsqrtf(wave_sum(ss) * (1.f / D) + EPS);
        uint2* o = (uint2*)(C.HX + (size_t)r * D);
#pragma unroll
        for (int j = 0; j < 4; ++j) { const float4 g = g0[lane + 64 * j], sh = modp[lane + 64 * j], sc = modp[256 + lane + 64 * j];
            uint2 w; w.x = pg8::cvt_pk_bf16((v[j].x * rstd * g.x) * (1.f + sc.x) + sh.x, (v[j].y * rstd * g.y) * (1.f + sc.y) + sh.y);
            w.y = pg8::cvt_pk_bf16((v[j].z * rstd * g.z) * (1.f + sc.z) + sh.z, (v[j].w * rstd * g.w) * (1.f + sc.w) + sh.w);
            o[lane + 64 * j] = w; }
    }
}

__device__ __forceinline__ void rope8(pg8::f32x4& v0, pg8::f32x4& v1, const float* tabrow, int fq) {
    const float4 c0 = *(const float4*)tabrow, c1 = *(const float4*)(tabrow + 4), s0 = *(const float4*)(tabrow + 64 * 24), s1 = *(const float4*)(tabrow + 64 * 24 + 4);
    const float cs[8] = {c0.x, c0.y, c0.z, c0.w, c1.x, c1.y, c1.z, c1.w}; const float sn[8] = {s0.x, s0.y, s0.z, s0.w, s1.x, s1.y, s1.z, s1.w};
    const float sg = (fq < 2) ? -1.f : 1.f;
#pragma unroll
    for (int e = 0; e < 8; ++e) {
        const float v = (e < 4) ? v0[e & 3] : v1[e & 3];
        const float pv = __shfl_xor(v, 32);
        const float o = v * cs[e] + pv * (sg * sn[e]);
        if (e < 4) v0[e & 3] = o; else v1[e & 3] = o;
    }
}
struct SchedInProj {
    int G, c, layer; const char* A; const char* W;
    __device__ __forceinline__ bool next(int i, pg8::GUnit& u) const { int pm, pn; if (!pg8::static_tile(i, G, c, T / 256, 8, pm, pn)) return false;
        u.pm = pm; u.pn = pn; u.A = A; u.B = W + (size_t)pn * 256 * 1024 * 2; u.B2 = u.B; u.x0 = 0; u.x1 = 0; return true; }
    __device__ __forceinline__ unsigned arow(const pg8::GUnit& u, int row) const { return (unsigned)(u.pm * 256 + row) * 2048u; }
};
struct EpiInProj {
    static constexpr bool PERM = true;
    bf16_t *CQ, *CKVR, *KA, *QB, *KB, *VB, *QC, *KC, *VC, *U; float *SSQ, *SSK;
    __device__ __forceinline__ void operator()(const pg8::f32x4 (&acc)[2][2][4][2], const pg8::GUnit& u, int wr, int wc, int fr, int fq) const {
        const int row0 = u.pm * 256 + wr * 64 + fr;
        if (u.pn <= 1) {
            float* SS = (u.pn == 0) ? SSQ : SSK;
#pragma unroll
            for (int ai = 0; ai < 2; ++ai)
#pragma unroll
                for (int m = 0; m < 4; ++m) {
                    float p = 0.f;
#pragma unroll
                    for (int bj = 0; bj < 2; ++bj) { if (bj == 1 && u.pn == 1) continue;
#pragma unroll
                        for (int n = 0; n < 2; ++n) { const pg8::f32x4 a = acc[ai][bj][m][n]; p += (a[0] * a[0] + a[1] * a[1]) + (a[2] * a[2] + a[3] * a[3]); } }
                    p += __shfl_xor(p, 16); p += __shfl_xor(p, 32);
                    if (fq == 0) SS[(size_t)(row0 + ai * 128 + m * 16) * 4 + wc] = p;
                }
        }
#pragma unroll
        for (int bj = 0; bj < 2; ++bj) {
            const int g = u.pn * 8 + bj * 4 + wc;
            bf16_t* dst; int pitch, col; int rope = 0  ; float scale = 1.f; bool zero = false;
            if (g < 8) { dst = CQ; pitch = 256; col = g * 32; }
            else if (g < 12) { dst = CKVR; pitch = 256; col = (g - 8) * 32; }
            else if (g < 16) { dst = CKVR; pitch = 256; col = (g - 8) * 32; zero = true; if (g == 12) rope = 1; }
            else if (g < 24) { dst = QB; pitch = 256; col = (g - 16) * 32; rope = 2 + (g & 1); scale = SC_B; }
            else if (g < 28) { dst = KB; pitch = 128; col = (g - 24) * 32; rope = 2 + (g & 1); }
            else if (g < 32) { dst = VB; pitch = 128; col = (g - 28) * 32; }
            else if (g < 40) { dst = QC; pitch = 256; col = (g - 32) * 32; rope = 1; scale = SC_C; }
            else if (g < 48) { dst = KC; pitch = 256; col = (g - 40) * 32; rope = 1; }
            else if (g < 56) { dst = VC; pitch = 256; col = (g - 48) * 32; }
            else { dst = U; pitch = 256; col = (g - 56) * 32; }
#pragma unroll
            for (int ai = 0; ai < 2; ++ai)
#pragma unroll
                for (int m = 0; m < 4; ++m) {
                    const int row = row0 + ai * 128 + m * 16;
                    pg8::f32x4 v0 = acc[ai][bj][m][0], v1 = acc[ai][bj][m][1];
                    if (rope) {
                        const int t = row & (SEQ - 1);
                        int p, f0;
                        if (rope == 1) { p = (fq & 1) ? (t & 63) : (t >> 6); f0 = 0; }
                        else { p = (rope == 3) ? (t & 63) : (t >> 6); f0 = 8 + 8 * (fq & 1); }
                        if (row >= TL) { p = 0; }
                        rope8(v0, v1, &g_rope.c[p][f0], fq);
                    }
                    if (g == 12) {
                        pg8::u32x4 w; w.x = pg8::cvt_pk_bf16(v0[0], v0[1]); w.y = pg8::cvt_pk_bf16(v0[2], v0[3]); w.z = pg8::cvt_pk_bf16(v1[0], v1[1]); w.w = pg8::cvt_pk_bf16(v1[2], v1[3]);
#pragma unroll
                        for (int h = 0; h < 4; ++h) *(pg8::u32x4*)(KA + (size_t)row * 384 + h * 96 + 64 + 8 * fq) = w;
                    }
                    if (zero) { v0 = (pg8::f32x4){0.f, 0.f, 0.f, 0.f}; v1 = v0; }
                    v0 = v0 * scale; v1 = v1 * scale;
                    pg8::u32x4 w; w.x = pg8::cvt_pk_bf16(v0[0], v0[1]); w.y = pg8::cvt_pk_bf16(v0[2], v0[3]); w.z = pg8::cvt_pk_bf16(v1[0], v1[1]); w.w = pg8::cvt_pk_bf16(v1[2], v1[3]);
                    *(pg8::u32x4*)(dst + (size_t)row * pitch + col + 8 * fq) = w;
                }
        }
    }
};

struct SchedMlaUp {
    int G, c, nQ  , nTot; const char *CQ, *CKVR, *WUQ, *WUKV;
    __device__ __forceinline__ bool next(int i, pg8::GUnit& u) const { const long L = (long)i * G + c; if (L >= nTot) return false;
        const int kind = (L >= nQ) ? 1 : 0, tl = (int)L - kind * nQ; u.pm = tl >> 1; u.pn = tl & 1; u.x0 = kind; u.x1 = 0;
        u.A = kind ? CKVR : CQ; u.B = (kind ? WUKV : WUQ) + (size_t)u.pn * 256 * 256 * 2; u.B2 = u.B; return true; }
    __device__ __forceinline__ unsigned arow(const pg8::GUnit& u, int row) const { return (unsigned)(u.pm * 256 + row) * 512u; }
};
struct EpiMlaUp {
    static constexpr bool PERM = true;
    bf16_t *QA, *KA, *VA; const float *SSQ, *SSK;
    __device__ __forceinline__ void operator()(const pg8::f32x4 (&acc)[2][2][4][2], const pg8::GUnit& u, int wr, int wc, int fr, int fq) const {
        const int row0 = u.pm * 256 + wr * 64 + fr; const bool kv = u.x0 != 0;
        const float* SS = kv ? SSK : SSQ; const float inv_n = kv ? (1.f / 128) : (1.f / 256);
#pragma unroll
        for (int bj = 0; bj < 2; ++bj) {
            const int g = u.pn * 8 + bj * 4 + wc;
            bf16_t* dst; int pitch, col; bool rope = false; float scale = 1.f;
            if (!kv) { if (g >= 12) continue; const int h = g / 3, part = g % 3; dst = QA; pitch = 384; col = h * 96 + part * 32; rope = (part == 2); scale = SC_A; }
            else { const int h = g >> 2, part = g & 3; if (part < 2) { dst = KA; pitch = 384; col = h * 96 + part * 32; } else { dst = VA; pitch = 256; col = h * 64 + (part - 2) * 32; } }
#pragma unroll
            for (int ai = 0; ai < 2; ++ai)
#pragma unroll
                for (int m = 0; m < 4; ++m) {
                    const int row = row0 + ai * 128 + m * 16; const float4 pp = *(const float4*)(SS + (size_t)row * 4);
                    const float rs = rsqrtf(((pp.x + pp.y) + (pp.z + pp.w)) * inv_n + EPS) * scale;
                    pg8::f32x4 v0 = acc[ai][bj][m][0] * rs, v1 = acc[ai][bj][m][1] * rs;
                    if (rope) { const int t = row & (SEQ - 1); int p = (fq & 1) ? (t & 63) : (t >> 6); if (row >= TL) p = 0; rope8(v0, v1, &g_rope.c[p][0], fq); }
                    pg8::u32x4 w; w.x = pg8::cvt_pk_bf16(v0[0], v0[1]); w.y = pg8::cvt_pk_bf16(v0[2], v0[3]); w.z = pg8::cvt_pk_bf16(v1[0], v1[1]); w.w = pg8::cvt_pk_bf16(v1[2], v1[3]);
                    *(pg8::u32x4*)(dst + (size_t)row * pitch + col + 8 * fq) = w;
                }
        }
    }
};

namespace att {
typedef short bf16x8 __attribute__((ext_vector_type(8)));
typedef short s16x4 __attribute__((ext_vector_type(4)));
typedef float f32x16 __attribute__((ext_vector_type(16)));
typedef unsigned u32x4 __attribute__((ext_vector_type(4)));
constexpr int L_K = 0, KBUF = 12288, L_V = 2 * KBUF, VBUF = 8192, L_WS = L_V + 2 * VBUF, L_OST = L_WS + 2048, OST_W = 8704, L_END = L_OST + 8 * OST_W;
static_assert(L_END <= 131072, "attention LDS");
constexpr float NEG_BIG = -1.0e30f;
__device__ __forceinline__ int crow(int r, int hi) { return (r & 3) + 8 * (r >> 2) + 4 * hi; }
__device__ __forceinline__ s16x4 vtr(LAS const char* p) { typedef short v4i16_t __attribute__((ext_vector_type(4))); return __builtin_bit_cast(s16x4, __builtin_amdgcn_ds_read_tr16_b64_v4i16((LAS v4i16_t*)p)); }
__device__ __forceinline__ float xhalf_max(float v) { auto rr = __builtin_amdgcn_permlane32_swap(__float_as_uint(v), __float_as_uint(v), false, false); return fmaxf(__uint_as_float(rr[0]), __uint_as_float(rr[1])); }
__device__ __forceinline__ float xhalf_sum(float v) { auto rr = __builtin_amdgcn_permlane32_swap(__float_as_uint(v), __float_as_uint(v), false, false); return __uint_as_float(rr[0]) + __uint_as_float(rr[1]); }

struct Unit {
    const bf16_t *Q, *K, *V;
    int qpitch, kpitch, vpitch;
    int qrow0, qpos0;
    int ctxrow0;
    int latrow0, latpos0, nlat;
    int window;
    bf16_t* O;
    float sink2;
    float lam, postmul; const float* subln;
};
template <int NSTEP  , int NCOMP, int MODE>
__device__ __forceinline__ void attn_unit(const Unit& U, LAS char* lds) {
    constexpr int NCH = 2 * NSTEP * NCOMP;
    const int tid = opaque_tid(), lane = tid & 63, r32 = lane & 31, hi = lane >> 5; const int wid = __builtin_amdgcn_readfirstlane(tid >> 6);
    LAS float* wsf = (LAS float*)(lds + L_WS) + wid * 64;
    bf16x8 qf[NCOMP][NSTEP];
    { const bf16_t* qp = U.Q + (size_t)(U.qrow0 + wid * 32 + r32) * U.qpitch + hi * 8;
#pragma unroll
      for (int c = 0; c < NCOMP; ++c)
#pragma unroll
        for (int d0 = 0; d0 < NSTEP; ++d0) qf[c][d0] = *(const bf16x8*)(qp + c * NSTEP * 16 + d0 * 16); }
    float mrow[NCOMP], lrow[NCOMP]; f32x16 o[NCOMP][2];
#pragma unroll
    for (int c = 0; c < NCOMP; ++c) { mrow[c] = NEG_BIG; lrow[c] = 0.f; o[c][0] = f32x16{}; o[c][1] = f32x16{}; }
    const int NT = 4 + U.nlat;
    constexpr int KPT = (NCH * 64 + NTHREADS - 1) / NTHREADS;
    u32x4 kreg[KPT], vreg;
    const int vkey = tid >> 3, vch = tid & 7;
    const int vdst = ((vch >> 2) * 4 + (vkey >> 4)) * 1024 + (vkey & 15) * 64 + (vch & 3) * 16;
#define ATT_ROW0(t) (((t) < 4) ? U.ctxrow0 + 64 * (t) : U.latrow0 + 64 * ((t) - 4))
#define ATT_LOAD(t) do { const int row0_ = ATT_ROW0(t); \
        _Pragma("unroll") for (int i_ = 0; i_ < KPT; ++i_) { const int pi_ = tid + NTHREADS * i_; if (pi_ < NCH * 64) kreg[i_] = *(const u32x4*)(U.K + (size_t)(row0_ + (pi_ & 63)) * U.kpitch + (pi_ >> 6) * 8); } \
        vreg = *(const u32x4*)(U.V + (size_t)(row0_ + vkey) * U.vpitch + vch * 8); } while (0)
#define ATT_WRITE(buf) do { \
        _Pragma("unroll") for (int i_ = 0; i_ < KPT; ++i_) { const int pi_ = tid + NTHREADS * i_; if (pi_ < NCH * 64) *(LAS u32x4*)(lds + L_K + (buf) * KBUF + (pi_ >> 6) * 1024 + (pi_ & 63) * 16) = kreg[i_]; } \
        *(LAS u32x4*)(lds + L_V + (buf) * VBUF + vdst) = vreg; } while (0)
    ATT_LOAD(0); ATT_WRITE(0);
    __syncthreads();
    const int qpos = U.qpos0 + wid * 32 + r32;
#pragma unroll 1
    for (int t = 0; t < NT; ++t) {
        const int buf = t & 1;
        if (t + 1 < NT) ATT_LOAD(t + 1);
        bool skip = false; int kpos0 = 0;
        if (MODE == 1 && t >= 4) { kpos0 = U.latpos0 + 64 * (t - 4); const int qw = U.qpos0 + wid * 32; skip = (kpos0 + 63 < qw - U.window) || (kpos0 > qw + 31 + U.window); }
        if (!skip) {
            LAS const char* kb = lds + L_K + buf * KBUF + hi * 1024 + r32 * 16;
            LAS const char* vp = lds + L_V + buf * VBUF + ((lane >> 4) & 1) * 32 + (lane & 3) * 8 + (4 * hi + ((lane & 15) >> 2)) * 64;
            bf16x8 pa[NCOMP][4];
#pragma unroll
            for (int c = 0; c < NCOMP; ++c) {
                f32x16 p0 = f32x16{}, p1 = f32x16{};
#pragma unroll
                for (int d0 = 0; d0 < NSTEP; ++d0) {
                    const bf16x8 b0 = *(LAS const bf16x8*)(kb + (c * 2 * NSTEP + 2 * d0) * 1024);
                    const bf16x8 b1 = *(LAS const bf16x8*)(kb + (c * 2 * NSTEP + 2 * d0) * 1024 + 512);
                    p0 = __builtin_amdgcn_mfma_f32_32x32x16_bf16(b0, qf[c][d0], p0, 0, 0, 0);
                    p1 = __builtin_amdgcn_mfma_f32_32x32x16_bf16(b1, qf[c][d0], p1, 0, 0, 0);
                }
                if (MODE == 1 && t >= 4) {
#pragma unroll
                    for (int r = 0; r < 16; ++r) { const int rel0 = kpos0 + crow(r, hi) - qpos;
                        if (rel0 > U.window || rel0 < -U.window) p0[r] = NEG_BIG;
                        if (rel0 + 32 > U.window || rel0 + 32 < -U.window) p1[r] = NEG_BIG; }
                }
                float mx = fmaxf(p0[0], p1[0]);
#pragma unroll
                for (int r = 1; r < 16; ++r) mx = fmaxf(mx, fmaxf(p0[r], p1[r]));
                mx = xhalf_max(mx);
                const float mnew = fmaxf(mrow[c], mx);
                const float alpha = __builtin_amdgcn_exp2f(mrow[c] - mnew);
                mrow[c] = mnew;
                float rs = 0.f;
#pragma unroll
                for (int r = 0; r < 16; ++r) { p0[r] = __builtin_amdgcn_exp2f(p0[r] - mnew); p1[r] = __builtin_amdgcn_exp2f(p1[r] - mnew); rs += p0[r] + p1[r]; }
                rs = xhalf_sum(rs);
                lrow[c] = lrow[c] * alpha + rs;
                if (hi == 0) wsf[c * 32 + r32] = alpha;
                u32x4 w0, w1, w2, w3;
                w0 = (u32x4){pg8::cvt_pk_bf16(p0[0], p0[1]), pg8::cvt_pk_bf16(p0[2], p0[3]), pg8::cvt_pk_bf16(p0[4], p0[5]), pg8::cvt_pk_bf16(p0[6], p0[7])};
                w1 = (u32x4){pg8::cvt_pk_bf16(p0[8], p0[9]), pg8::cvt_pk_bf16(p0[10], p0[11]), pg8::cvt_pk_bf16(p0[12], p0[13]), pg8::cvt_pk_bf16(p0[14], p0[15])};
                w2 = (u32x4){pg8::cvt_pk_bf16(p1[0], p1[1]), pg8::cvt_pk_bf16(p1[2], p1[3]), pg8::cvt_pk_bf16(p1[4], p1[5]), pg8::cvt_pk_bf16(p1[6], p1[7])};
                w3 = (u32x4){pg8::cvt_pk_bf16(p1[8], p1[9]), pg8::cvt_pk_bf16(p1[10], p1[11]), pg8::cvt_pk_bf16(p1[12], p1[13]), pg8::cvt_pk_bf16(p1[14], p1[15])};
                pa[c][0] = __builtin_bit_cast(bf16x8, w0); pa[c][1] = __builtin_bit_cast(bf16x8, w1); pa[c][2] = __builtin_bit_cast(bf16x8, w2); pa[c][3] = __builtin_bit_cast(bf16x8, w3);
            }
#pragma unroll
            for (int c = 0; c < NCOMP; ++c) {
#pragma unroll
                for (int g4 = 0; g4 < 4; ++g4) { const pg8::f32x4 a4 = *(LAS const pg8::f32x4*)(wsf + c * 32 + 8 * g4 + 4 * hi);
                    o[c][0][4 * g4 + 0] *= a4.x; o[c][0][4 * g4 + 1] *= a4.y; o[c][0][4 * g4 + 2] *= a4.z; o[c][0][4 * g4 + 3] *= a4.w;
                    o[c][1][4 * g4 + 0] *= a4.x; o[c][1][4 * g4 + 1] *= a4.y; o[c][1][4 * g4 + 2] *= a4.z; o[c][1][4 * g4 + 3] *= a4.w; }
            }
#pragma unroll
            for (int d0 = 0; d0 < 2; ++d0)
#pragma unroll
                for (int ks = 0; ks < 4; ++ks) {
                    const s16x4 vlo = vtr(vp + d0 * 4096 + ks * 1024), vhi = vtr(vp + d0 * 4096 + ks * 1024 + 512);
                    const bf16x8 vb = (bf16x8){vlo[0], vlo[1], vlo[2], vlo[3], vhi[0], vhi[1], vhi[2], vhi[3]};
#pragma unroll
                    for (int c = 0; c < NCOMP; ++c) o[c][d0] = __builtin_amdgcn_mfma_f32_32x32x16_bf16(pa[c][ks], vb, o[c][d0], 0, 0, 0);
                }
        }
        if (t + 1 < NT) ATT_WRITE(buf ^ 1);
        __syncthreads();
    }
#undef ATT_ROW0
#undef ATT_LOAD
#undef ATT_WRITE
    float fac[NCOMP];
#pragma unroll
    for (int c = 0; c < NCOMP; ++c) {
        if (MODE == 1) { const float mm = fmaxf(mrow[c], U.sink2); const float f = __builtin_amdgcn_exp2f(mrow[c] - mm); fac[c] = f / (lrow[c] * f + __builtin_amdgcn_exp2f(U.sink2 - mm)); }
        else fac[c] = 1.f / lrow[c];
        if (MODE == 2 && c == 1) fac[c] *= -U.lam;
        if (hi == 0) wsf[c * 32 + r32] = fac[c];
    }
    LAS float* stg = (LAS float*)(lds + L_OST + wid * OST_W);
#pragma unroll
    for (int g4 = 0; g4 < 4; ++g4) {
        const pg8::f32x4 f0 = *(LAS const pg8::f32x4*)(wsf + 8 * g4 + 4 * hi);
        pg8::f32x4 f1 = f0; if (NCOMP == 2) f1 = *(LAS const pg8::f32x4*)(wsf + 32 + 8 * g4 + 4 * hi);
        const float ff0[4] = {f0.x, f0.y, f0.z, f0.w}, ff1[4] = {f1.x, f1.y, f1.z, f1.w};
#pragma unroll
        for (int j = 0; j < 4; ++j) { const int r = 4 * g4 + j, orow = crow(r, hi);
#pragma unroll
            for (int d0 = 0; d0 < 2; ++d0) { float v = o[0][d0][r] * ff0[j]; if (NCOMP == 2) v += o[NCOMP - 1][d0][r] * ff1[j]; stg[orow * 68 + d0 * 32 + r32] = v; } }
    }
    { const int row = lane >> 1, half = lane & 1; float v[32];
#pragma unroll
      for (int k = 0; k < 8; ++k) { const pg8::f32x4 x = *(LAS const pg8::f32x4*)(stg + row * 68 + half * 32 + 4 * k); v[4 * k] = x.x; v[4 * k + 1] = x.y; v[4 * k + 2] = x.z; v[4 * k + 3] = x.w; }
      if (MODE == 2) { float ss = 0.f;
#pragma unroll
          for (int k = 0; k < 32; ++k) ss += v[k] * v[k];
          ss += __shfl_xor(ss, 1);
          const float rstd = rsqrtf(ss * (1.f / 64) + EPS) * U.postmul;
#pragma unroll
          for (int k = 0; k < 32; ++k) v[k] = v[k] * rstd * U.subln[half * 32 + k]; }
      bf16_t* op = U.O + (size_t)(U.qrow0 + wid * 32 + row) * 1024 + half * 32;
#pragma unroll
      for (int k = 0; k < 4; ++k) { u32x4 w; w.x = pg8::cvt_pk_bf16(v[8 * k], v[8 * k + 1]); w.y = pg8::cvt_pk_bf16(v[8 * k + 2], v[8 * k + 3]); w.z = pg8::cvt_pk_bf16(v[8 * k + 4], v[8 * k + 5]); w.w = pg8::cvt_pk_bf16(v[8 * k + 6], v[8 * k + 7]);
          *(u32x4*)(op + 8 * k) = w; } }
    __syncthreads();
}
}

__device__ __forceinline__ void phase_attn(const Ctx& C, int layer, LAS char* lds) {
    const int G = gridDim.x, bx = blockIdx.x;
    const int vcu = (G % 8 == 0) ? (bx % 8) * (G / 8) + bx / 8 : bx;
    float lam;
    { const float* dl = C.dlam + (size_t)layer * 128; float s1 = 0.f, s2 = 0.f; for (int i = 0; i < 32; ++i) { s1 += dl[i] * dl[32 + i]; s2 += dl[64 + i] * dl[96 + i]; }
      lam = expf(s1) - expf(s2) + lam_init_of(layer); }
    const bool has_ctx_q = layer < DEPTH - 1;
    const int NLAT = BATCH * 4 * (SEQ / 256);
    const int NCTXU = has_ctx_q ? BATCH * 4 : 0;
    const int ntot = 3 * NLAT + 3 * NCTXU;
#pragma unroll 1
    for (int uidx = vcu; uidx < ntot; uidx += G) {
        int kind, b, h, qb; bool cq;
        if (uidx < 3 * NLAT) { kind = uidx / NLAT; const int r = uidx % NLAT; b = r / 32; h = (r / 8) & 3; qb = r & 7; cq = false; }
        else { const int r2 = uidx - 3 * NLAT; kind = r2 / NCTXU; const int r = r2 % NCTXU; b = r >> 2; h = r & 3; qb = 0; cq = true; }
        att::Unit U;
        U.qrow0 = cq ? TL + b * CTXL : b * SEQ + qb * 256; U.qpos0 = cq ? 0 : qb * 256; U.ctxrow0 = TL + b * CTXL;
        U.latrow0 = b * SEQ; U.latpos0 = 0; U.nlat = cq ? 0 : SEQ / 64; U.window = -1; U.sink2 = 0.f; U.lam = 0.f; U.postmul = 1.f; U.subln = nullptr;
        if (kind == 0) {
            U.Q = C.QC + h * 64; U.K = C.KC + h * 64; U.V = C.VC + h * 64; U.qpitch = 256; U.kpitch = 256; U.vpitch = 256; U.O = C.O + 512 + h * 64;
            U.lam = lam; U.postmul = 1.f - lam_init_of(layer); U.subln = C.subln + layer * 64;
            att::attn_unit<2, 2, 2>(U, lds);
        } else if (kind == 1) {
            U.Q = C.QA + h * 96; U.K = C.KA + h * 96; U.V = C.VA + h * 64; U.qpitch = 384; U.kpitch = 384; U.vpitch = 256; U.O = C.O + h * 64;
            att::attn_unit<6, 1, 0>(U, lds);
        } else {
            const int kvh = h >> 1;
            U.Q = C.QB + h * 64; U.K = C.KB + kvh * 64; U.V = C.VB + kvh * 64; U.qpitch = 256; U.kpitch = 128; U.vpitch = 128; U.O = C.O + 256 + h * 64;
            U.sink2 = C.sink[layer * 4 + h] * LOG2E;
            if (!cq) { U.window = 128; const int p0 = max(qb * 256 - 128, 0), p1 = min(qb * 256 + 256 + 128, SEQ); U.latpos0 = p0; U.latrow0 = b * SEQ + p0; U.nlat = (p1 - p0) / 64; }
            att::attn_unit<4, 1, 1>(U, lds);
        }
    }
    {
        const int tid = opaque_tid(), lane = tid & 63, wave = tid >> 6;
        const int gw = blockIdx.x * NWAVES + wave, ngw = gridDim.x * NWAVES;
        const int nrows = has_ctx_q ? T : TL;
        for (long it = gw; it < (long)nrows * 4; it += ngw) {
            const int r = (int)(it >> 2), g = (int)(it & 3);
            const bool isctx = r >= TL; const int t = isctx ? (r - TL) % CTXL : r % SEQ;
            const int w = 2 << g, half = w >> 1, L = isctx ? CTXL : SEQ;
            const size_t rbase = (size_t)r - t;
            const int lo = max(t - half, 0), hi = min(t - half + w, L);
            float s = 0.f;
            for (int p = lo; p < hi; ++p) s += bf2f(C.U[(rbase + p) * 256 + g * 64 + lane]);
            const float dg = s / (float)(hi - lo) - bf2f(C.U[(size_t)r * 256 + g * 64 + lane]);
            const float* pw = C.pool_w + ((size_t)layer * 4 + g) * 64 * 64;
            float y = 0.f;
#pragma unroll 8
            for (int c = 0; c < 64; ++c) y += __shfl(dg, c) * pw[c * 64 + lane];
            C.O[(size_t)r * D + 768 + g * 64 + lane] = f2bf(y * C.pool_scale[layer * 256 + g * 64 + lane]);
        }
    }
}

struct SchedRows {
    int G, c, nM, nN; const char* A; const char* W; unsigned lda2  ; size_t wtile  ;
    __device__ __forceinline__ bool next(int i, pg8::GUnit& u) const { int pm, pn; if (!pg8::static_tile(i, G, c, nM, nN, pm, pn)) return false;
        u.pm = pm; u.pn = pn; u.A = A; u.B = W + (size_t)pn * wtile; u.B2 = u.B; u.x0 = 0; u.x1 = 256; return true; }
    __device__ __forceinline__ unsigned arow(const pg8::GUnit& u, int row) const { return (unsigned)(u.pm * 256 + row) * lda2; }
};
struct EpiRowsSS {
    static constexpr bool PERM = true;
    bf16_t* OUT; float* SS;
    __device__ __forceinline__ void operator()(const pg8::f32x4 (&acc)[2][2][4][2], const pg8::GUnit& u, int wr, int wc, int fr, int fq) const {
        const int row0 = u.pm * 256 + wr * 64 + fr;
#pragma unroll
        for (int ai = 0; ai < 2; ++ai)
#pragma unroll
            for (int m = 0; m < 4; ++m) {
                const int row = row0 + ai * 128 + m * 16; float p = 0.f;
#pragma unroll
                for (int bj = 0; bj < 2; ++bj) {
                    const pg8::f32x4 v0 = acc[ai][bj][m][0], v1 = acc[ai][bj][m][1];
                    p += ((v0[0] * v0[0] + v0[1] * v0[1]) + (v0[2] * v0[2] + v0[3] * v0[3])) + ((v1[0] * v1[0] + v1[1] * v1[1]) + (v1[2] * v1[2] + v1[3] * v1[3]));
                    pg8::u32x4 w; w.x = pg8::cvt_pk_bf16(v0[0], v0[1]); w.y = pg8::cvt_pk_bf16(v0[2], v0[3]); w.z = pg8::cvt_pk_bf16(v1[0], v1[1]); w.w = pg8::cvt_pk_bf16(v1[2], v1[3]);
                    *(pg8::u32x4*)(OUT + (size_t)row * 1024 + u.pn * 256 + bj * 128 + wc * 32 + 8 * fq) = w;
                }
                p += __shfl_xor(p, 16); p += __shfl_xor(p, 32);
                if (fq == 0) SS[(size_t)row * 16 + u.pn * 4 + wc] = p;
            }
    }
};

__device__ __forceinline__ float sum16(const float* p) { const float4 a = *(const float4*)p, b = *(const float4*)(p + 4), c = *(const float4*)(p + 8), d = *(const float4*)(p + 12);
    return (((a.x + a.y) + (a.z + a.w)) + ((b.x + b.y) + (b.z + b.w))) + (((c.x + c.y) + (c.z + c.w)) + ((d.x + d.y) + (d.z + d.w))); }
__device__ __forceinline__ void phase_router(const Ctx& C, int layer, float* lds) {
    const int tid = opaque_tid(), lane = tid & 63, wave = tid >> 6;
    float* RW = lds;
    for (int i = tid; i < 20 * 1024; i += NTHREADS) { const int q = i >> 10, k = i & 1023;
        RW[i] = (q < 4) ? C.r_gw[(size_t)layer * D * 4 + k * 4 + q] : C.r_ew[(size_t)layer * D * 16 + k * 16 + (q - 4)]; }
    __syncthreads();
    const int gw = blockIdx.x * NWAVES + wave, ngw = gridDim.x * NWAVES;
    const float4* g1 = (const float4*)(C.norm_g + ((size_t)layer * 4 + 1) * D);
    const float4* g2 = (const float4*)(C.norm_g + ((size_t)layer * 4 + 2) * D);
    const int nrows = (layer == DEPTH - 1) ? TL : T;
    for (int r = gw; r < nrows; r += ngw) {
        const bool isctx = r >= TL; const int b = isctx ? (r - TL) / CTXL : r / SEQ;
        const float4* modp = (const float4*)(C.mod + ((size_t)layer * 17 + (isctx ? 16 : b)) * (NMOD * D));
        const float rstd1 = rsqrtf(sum16(C.SS1 + (size_t)r * 16) * (1.f / D) + EPS);
        const float4* xr = (const float4*)xrow_in(C, layer, r); float4* xo = (float4*)xrow_out(C, r);
        const uint2* oxr = (const uint2*)(C.OX + (size_t)r * D);
        float4 xa[4]; float ss = 0.f;
#pragma unroll
        for (int j = 0; j < 4; ++j) { const int ci = lane + 64 * j; const uint2 ow = oxr[ci]; const float4 g = g1[ci], gt = modp[2 * 256 + ci], xv = xr[ci];
            xa[j].x = xv.x + gt.x * (__uint_as_float(ow.x << 16) * rstd1 * g.x); xa[j].y = xv.y + gt.y * (__uint_as_float(ow.x & 0xffff0000u) * rstd1 * g.y);
            xa[j].z = xv.z + gt.z * (__uint_as_float(ow.y << 16) * rstd1 * g.z); xa[j].w = xv.w + gt.w * (__uint_as_float(ow.y & 0xffff0000u) * rstd1 * g.w);
            xo[ci] = xa[j]; ss += (xa[j].x * xa[j].x + xa[j].y * xa[j].y) + (xa[j].z * xa[j].z + xa[j].w * xa[j].w); }
        const float rstd2 = rsqrtf(wave_sum(ss) * (1.f / D) + EPS);
        uint2* hmr = (uint2*)(C.HM + (size_t)r * D);
#pragma unroll
        for (int j = 0; j < 4; ++j) { const int ci = lane + 64 * j; const float4 g = g2[ci], sh = modp[3 * 256 + ci], sc = modp[4 * 256 + ci];
            xa[j].x = (xa[j].x * rstd2 * g.x) * (1.f + sc.x) + sh.x; xa[j].y = (xa[j].y * rstd2 * g.y) * (1.f + sc.y) + sh.y;
            xa[j].z = (xa[j].z * rstd2 * g.z) * (1.f + sc.z) + sh.z; xa[j].w = (xa[j].w * rstd2 * g.w) * (1.f + sc.w) + sh.w;
            uint2 w; w.x = pg8::cvt_pk_bf16(xa[j].x, xa[j].y); w.y = pg8::cvt_pk_bf16(xa[j].z, xa[j].w); hmr[ci] = w; }
        float lg[20];
#pragma unroll
        for (int q = 0; q < 20; ++q) { float p = 0.f;
#pragma unroll
            for (int j = 0; j < 4; ++j) { const float4 w = *(const float4*)(RW + q * 1024 + 4 * (lane + 64 * j)); p += (xa[j].x * w.x + xa[j].y * w.y) + (xa[j].z * w.z + xa[j].w * w.w); }
            lg[q] = wave_sum(p) + ((q < 4) ? C.r_gb[layer * 4 + q] : C.r_eb[layer * 16 + (q - 4)]); }
        int gsel = 0; float gmax = lg[0];
#pragma unroll
        for (int i = 1; i < 4; ++i) if (lg[i] > gmax) { gmax = lg[i]; gsel = i; }
        float gs = 0.f;
#pragma unroll
        for (int i = 0; i < 4; ++i) gs += __expf(lg[i] - gmax);
        const float pg = 1.f / gs;
        float el[4];
#pragma unroll
        for (int i = 0; i < 4; ++i) el[i] = (gsel == 0) ? lg[4 + i] : (gsel == 1) ? lg[8 + i] : (gsel == 2) ? lg[12 + i] : lg[16 + i];
        int i1 = 0; float v1 = el[0];
#pragma unroll
        for (int i = 1; i < 4; ++i) if (el[i] > v1) { v1 = el[i]; i1 = i; }
        int i2 = -1; float v2 = -INFINITY;
#pragma unroll
        for (int i = 0; i < 4; ++i) if (i != i1 && el[i] > v2) { v2 = el[i]; i2 = i; }
        const float e2 = __expf(v2 - v1); const float w1 = pg / (1.f + e2), w2 = pg * e2 / (1.f + e2);
        const int elo = min(i1, i2), ehi = max(i1, i2);
        const int pair = (elo == 0) ? (ehi - 1) : (elo == 1) ? (ehi + 1) : 5;
        const int cls = gsel * 6 + pair;
        if (lane == 0) {
            const unsigned slot = atomicAdd(C.CNT + layer * 32 + cls, 1u);
            C.LIST[(size_t)cls * T + slot] = r;
            *(float2*)(C.TOKW + (size_t)r * 2) = make_float2(i1 < i2 ? w1 : w2, i1 < i2 ? w2 : w1);
        }
    }
}

constexpr int MOE_LDS = 131072, MOE_MAXU = 8;
struct MoeSched {
    int G, c, npn, layer, mode  ; const char *A, *W; LAS const int* meta  ; LAS const int* tab  ;
    __device__ __forceinline__ bool next(int i, pg8::GUnit& u) const {
        const int ntiles = meta[32 + 24]; const long L = (long)i * G + c; if (i >= MOE_MAXU || L >= (long)ntiles * npn) return false;
        const int tile = (int)(L / npn), pn = (int)(L % npn);
        int cls = 0;
#pragma unroll 1
        for (int k = 1; k < 24; ++k) if (tile >= meta[32 + k]) cls = k;
        const int tin = tile - meta[32 + cls], cnt = meta[cls];
        const int g = cls / 6, pr = cls % 6; const int elo = (pr < 3) ? 0 : (pr < 5) ? 1 : 2, ehi = (pr < 3) ? pr + 1 : (pr < 5) ? pr - 1 : 3;
        u.pm = tile; u.pn = pn; u.x0 = i; u.x1 = min(256, cnt - tin * 256); u.A = A;
        if (mode == 0) { const int e = g * 4 + ((pn < 4) ? elo : ehi); u.B = W + (((size_t)layer * 16 + e) * 1024 + (size_t)(pn & 3) * 256) * 1024 * 2; u.B2 = u.B; }
        else { u.B = W + (((size_t)layer * 16 + g * 4 + elo) * 1024 + (size_t)pn * 256) * 512 * 2; u.B2 = W + (((size_t)layer * 16 + g * 4 + ehi) * 1024 + (size_t)pn * 256) * 512 * 2; }
        return true;
    }
    __device__ __forceinline__ unsigned arow(const pg8::GUnit& u, int row) const { return (mode == 0) ? (unsigned)tab[u.x0 * 256 + row] * 2048u : (unsigned)(u.pm * 256 + row) * 2048u; }
};
__device__ __forceinline__ void moe_setup(const Ctx& C, int layer, int npn, LAS int* meta, LAS int* tab) {
    const int tid = opaque_tid();
    if (tid < 24) meta[tid] = (int)__hip_atomic_load(C.CNT + layer * 32 + tid, __ATOMIC_RELAXED, __HIP_MEMORY_SCOPE_AGENT);
    __syncthreads();
    if (tid == 0) { int acc = 0; for (int k = 0; k < 24; ++k) { meta[32 + k] = acc; acc += (meta[k] + 255) >> 8; } meta[32 + 24] = acc; }
    __syncthreads();
    const int ntiles = meta[32 + 24];
    for (int i = 0; i < MOE_MAXU; ++i) {
        const long L = (long)i * gridDim.x + blockIdx.x; if (L >= (long)ntiles * npn) break;
        const int tile = (int)(L / npn); int cls = 0;
        for (int k = 1; k < 24; ++k) if (tile >= meta[32 + k]) cls = k;
        const int tin = tile - meta[32 + cls], cnt = meta[cls];
        if (tid < 256) { const int slot = tin * 256 + tid; tab[i * 256 + tid] = C.LIST[(size_t)cls * T + (slot < cnt ? slot : 0)]; }
    }
    __syncthreads();
}
__device__ __forceinline__ float silu_fast(float v) { return v * __builtin_amdgcn_rcpf(1.f + __expf(-v)); }
struct EpiMoeUp {
    static constexpr bool PERM = true;
    bf16_t* ACT; const float* TOKW; LAS const int* tab;
    __device__ __forceinline__ void operator()(const pg8::f32x4 (&acc)[2][2][4][2], const pg8::GUnit& u, int wr, int wc, int fr, int fq) const {
        const int hi = (u.pn >= 4) ? 1 : 0;
#pragma unroll
        for (int ai = 0; ai < 2; ++ai)
#pragma unroll
            for (int m = 0; m < 4; ++m) {
                const int rt = ai * 128 + wr * 64 + m * 16 + fr;
                if (rt < u.x1) {
                    const int token = tab[u.x0 * 256 + rt]; const float w = TOKW[(size_t)token * 2 + hi];
#pragma unroll
                    for (int bj = 0; bj < 2; ++bj) {
                        const pg8::f32x4 gt = acc[ai][bj][m][0], up = acc[ai][bj][m][1];
                        pg8::u32x2 o; o.x = pg8::cvt_pk_bf16(silu_fast(gt[0]) * up[0] * w, silu_fast(gt[1]) * up[1] * w); o.y = pg8::cvt_pk_bf16(silu_fast(gt[2]) * up[2] * w, silu_fast(gt[3]) * up[3] * w);
                        *(pg8::u32x2*)(ACT + (size_t)(u.pm * 256 + rt) * 1024 + hi * 512 + (u.pn & 3) * 128 + 4 * (16 * bj + 4 * wc + fq)) = o;
                    }
                }
            }
    }
};
struct EpiMoeDown {
    static constexpr bool PERM = true;
    bf16_t* FX; float* SS; LAS const int* tab;
    __device__ __forceinline__ void operator()(const pg8::f32x4 (&acc)[2][2][4][2], const pg8::GUnit& u, int wr, int wc, int fr, int fq) const {
#pragma unroll
        for (int ai = 0; ai < 2; ++ai)
#pragma unroll
            for (int m = 0; m < 4; ++m) {
                const int rt = ai * 128 + wr * 64 + m * 16 + fr; const bool ok = rt < u.x1;
                const int token = tab[u.x0 * 256 + rt]; float p = 0.f;
#pragma unroll
                for (int bj = 0; bj < 2; ++bj) {
                    const pg8::f32x4 v0 = acc[ai][bj][m][0], v1 = acc[ai][bj][m][1];
                    p += ((v0[0] * v0[0] + v0[1] * v0[1]) + (v0[2] * v0[2] + v0[3] * v0[3])) + ((v1[0] * v1[0] + v1[1] * v1[1]) + (v1[2] * v1[2] + v1[3] * v1[3]));
                    pg8::u32x4 w; w.x = pg8::cvt_pk_bf16(v0[0], v0[1]); w.y = pg8::cvt_pk_bf16(v0[2], v0[3]); w.z = pg8::cvt_pk_bf16(v1[0], v1[1]); w.w = pg8::cvt_pk_bf16(v1[2], v1[3]);
                    if (ok) *(pg8::u32x4*)(FX + (size_t)token * 1024 + u.pn * 256 + bj * 128 + wc * 32 + 8 * fq) = w;
                }
                p += __shfl_xor(p, 16); p += __shfl_xor(p, 32);
                if (ok && fq == 0) SS[(size_t)token * 16 + u.pn * 4 + wc] = p;
            }
    }
};

__device__ __forceinline__ void phase_final(const Ctx& C, int layer) {
    const int tid = opaque_tid(), lane = tid & 63, wave = tid >> 6;
    const int gw = blockIdx.x * NWAVES + wave, ngw = gridDim.x * NWAVES;
    const float4* g3 = (const float4*)(C.norm_g + ((size_t)layer * 4 + 3) * D);
    const int nrows = (layer == DEPTH - 1) ? TL : T;
    for (int r = gw; r < nrows; r += ngw) {
        const bool isctx = r >= TL; const int b = isctx ? (r - TL) / CTXL : r / SEQ;
        const float4* modp = (const float4*)(C.mod + ((size_t)layer * 17 + (isctx ? 16 : b)) * (NMOD * D));
        const float rstd = rsqrtf(sum16(C.SS2 + (size_t)r * 16) * (1.f / D) + EPS);
        float4* xo = (float4*)xrow_out(C, r);
        const uint2* fxr = (const uint2*)(C.FX + (size_t)r * D);
#pragma unroll
        for (int j = 0; j < 4; ++j) { const int ci = lane + 64 * j; const uint2 fw = fxr[ci]; const float4 g = g3[ci], gt = modp[5 * 256 + ci]; float4 xv = xo[ci];
            xv.x += gt.x * (__uint_as_float(fw.x << 16) * rstd * g.x); xv.y += gt.y * (__uint_as_float(fw.x & 0xffff0000u) * rstd * g.y);
            xv.z += gt.z * (__uint_as_float(fw.y << 16) * rstd * g.z); xv.w += gt.w * (__uint_as_float(fw.y & 0xffff0000u) * rstd * g.w);
            xo[ci] = xv; }
    }
}

__device__ __forceinline__ Ctx make_ctx(const Args& a) {
    Ctx C;
    C.x = a.in[0]; C.c = a.in[1]; C.ctx = a.in[2]; C.c_ctx = a.in[3]; C.ada_w = a.in[4]; C.ada_b = a.in[5]; C.norm_g = a.in[6]; C.w_in = a.in[7];
    C.q_gain = a.in[8]; C.kv_gain = a.in[9]; C.w_uq = a.in[10]; C.w_ukv = a.in[11]; C.sink = a.in[12]; C.dlam = a.in[13]; C.subln = a.in[14];
    C.pool_w = a.in[15]; C.pool_scale = a.in[16]; C.w_out = a.in[17]; C.r_gw = a.in[18]; C.r_gb = a.in[19]; C.r_ew = a.in[20]; C.r_eb = a.in[21];
    C.w_gu = a.in[22]; C.w_down = a.in[23]; C.out = a.out; C.ws = a.ws;
    C.mod = (float*)(a.ws + WS_MOD); C.hctx = (float*)(a.ws + WS_HCTX);
    unsigned char* q = a.ws + WS_QKV;
    C.QA = (bf16_t*)(q + QA_OFF); C.KA = (bf16_t*)(q + KA_OFF); C.VA = (bf16_t*)(q + VA_OFF); C.QB = (bf16_t*)(q + QB_OFF); C.KB = (bf16_t*)(q + KB_OFF);
    C.VB = (bf16_t*)(q + VB_OFF); C.QC = (bf16_t*)(q + QC_OFF); C.KC = (bf16_t*)(q + KC_OFF); C.VC = (bf16_t*)(q + VC_OFF); C.U = (bf16_t*)(q + U_OFF);
    C.O = (bf16_t*)(a.ws + WS_O);
    C.WIN = (bf16_t*)(a.ws + WS_WIN); C.WOUT = (bf16_t*)(a.ws + WS_WOUT); C.WUQ = (bf16_t*)(a.ws + WS_WUQ); C.WUKV = (bf16_t*)(a.ws + WS_WUKV);
    C.WGU = (bf16_t*)(a.ws + WS_WGU); C.WDN = (bf16_t*)(a.ws + WS_WDN); C.HX = (bf16_t*)(a.ws + WS_HX); C.CQ = (bf16_t*)(a.ws + WS_CQ); C.CKVR = (bf16_t*)(a.ws + WS_CKVR);
    C.SSQ = (float*)(a.ws + WS_SSQ); C.SSK = (float*)(a.ws + WS_SSK);
    C.OX = (bf16_t*)(a.ws + WS_OX); C.ACT = (bf16_t*)(a.ws + WS_ACT); C.HM = (bf16_t*)(a.ws + WS_HM); C.FX = (bf16_t*)(a.ws + WS_FX);
    C.SS1 = (float*)(a.ws + WS_SS1); C.SS2 = (float*)(a.ws + WS_SS2); C.TOKW = (float*)(a.ws + WS_TOKW); C.LIST = (int*)(a.ws + WS_LIST); C.CNT = (unsigned*)(a.ws + WS_CTL) + CW_CNT;
    return C;
}
constexpr int PH_PER_LAYER = 9;
constexpr int N_PHASES = 1 + PH_PER_LAYER * DEPTH;
__global__ void __launch_bounds__(NTHREADS, 2) fwd(Args a) {
    extern __shared__ __attribute__((aligned(16))) unsigned char lds_raw[];
    float* lds = (float*)lds_raw;
    LAS unsigned char* lds3 = (LAS unsigned char*)lds_raw;
    volatile LAS unsigned* MISC = (volatile LAS unsigned*)((LAS unsigned char*)lds_raw + LDS_MISC);
    for (int u = threadIdx.x; u < (LDS_BYTES - LDS_MISC) / 4; u += NTHREADS) MISC[u] = 0u;
    __syncthreads();
    const bool one = (a.ph_hi - a.ph_lo) > 1;
    XcdBarrier bar; bar.bar = (unsigned*)(a.ws + WS_CTL) + 4096; bar.x = 0; bar.st = nullptr;
    if (one) bar = xcd_barrier_post((unsigned*)(a.ws + WS_CTL) + 4096, MISC + 8);
    const int lo = a.ph_lo, hi = a.ph_hi;
    const int G = gridDim.x, bid = blockIdx.x;
#define IN(k) (lo <= (k) && (k) < hi)
#define SEAM(k) do { if (IN(k) && IN((k) + 1)) xcd_barrier(bar); } while (0)
    if (IN(0)) { const Ctx C = make_ctx(a); phase_mod(C, lds); __syncthreads(); phase_convert(C, lds); }
    SEAM(0);
#pragma unroll 1
    for (int layer = 0; layer < DEPTH; ++layer) {
        const int p = 1 + PH_PER_LAYER * layer;
        if (IN(p)) { const Ctx C = make_ctx(a); phase_ln0(C, layer); }
        SEAM(p);
        if (IN(p + 1)) {
            const Ctx C = make_ctx(a);
            SchedInProj S{G, bid, layer, (const char*)C.HX, (const char*)(C.WIN + (size_t)layer * 2048 * 1024)};
            EpiInProj E{C.CQ, C.CKVR, C.KA, C.QB, C.KB, C.VB, C.QC, C.KC, C.VC, C.U, C.SSQ, C.SSK};
            pg8::gemm_phase(lds3, 1024, 1024, 16, S, E);
        }
        SEAM(p + 1);
        if (IN(p + 2)) {
            const Ctx C = make_ctx(a);
            const int nQ = ((layer == DEPTH - 1) ? TL : T) / 256 * 2;
            SchedMlaUp S{G, bid, nQ, nQ + T / 256 * 2, (const char*)C.CQ, (const char*)C.CKVR, (const char*)(C.WUQ + (size_t)layer * 512 * 256), (const char*)(C.WUKV + (size_t)layer * 512 * 256)};
            EpiMlaUp E{C.QA, C.KA, C.VA, C.SSQ, C.SSK};
            pg8::gemm_phase(lds3, 256, 256, 4, S, E);
        }
        SEAM(p + 2);
#if USE_NAIVE_ATTN
        if (IN(p + 3)) { const Ctx C = make_ctx(a); naive_attn(C, layer, lds); }
#else
        if (IN(p + 3)) { const Ctx C = make_ctx(a); phase_attn(C, layer, (LAS char*)lds3); }
#endif
        SEAM(p + 3);
#if USE_NAIVE_TOKB
        if (IN(p + 4)) { const Ctx C = make_ctx(a); naive_tokB(C, layer, lds); }
        SEAM(p + 4);
#else
        if (IN(p + 4)) {
            const Ctx C = make_ctx(a);
            SchedRows S{G, bid, ((layer == DEPTH - 1) ? TL : T) / 256, 4, (const char*)C.O, (const char*)(C.WOUT + (size_t)layer * 1024 * 1024), 2048u, (size_t)256 * 1024 * 2};
            EpiRowsSS E{C.OX, C.SS1};
            pg8::gemm_phase(lds3, 1024, 1024, 16, S, E);
        }
        SEAM(p + 4);
        if (IN(p + 5)) { const Ctx C = make_ctx(a); phase_router(C, layer, lds); }
        SEAM(p + 5);
        if (IN(p + 6)) {
            const Ctx C = make_ctx(a);
            LAS int* meta = (LAS int*)(lds3 + MOE_LDS); LAS int* tab = (LAS int*)(lds3 + MOE_LDS + 1024);
            moe_setup(C, layer, 8, meta, tab);
            MoeSched S{G, bid, 8, layer, 0, (const char*)C.HM, (const char*)C.WGU, meta, tab};
            EpiMoeUp E{C.ACT, C.TOKW, tab};
            pg8::gemm_phase(lds3, 1024, 1024, 16, S, E);
        }
        SEAM(p + 6);
        if (IN(p + 7)) {
            const Ctx C = make_ctx(a);
            LAS int* meta = (LAS int*)(lds3 + MOE_LDS); LAS int* tab = (LAS int*)(lds3 + MOE_LDS + 1024);
            moe_setup(C, layer, 4, meta, tab);
            MoeSched S{G, bid, 4, layer, 1, (const char*)C.ACT, (const char*)C.WDN, meta, tab};
            EpiMoeDown E{C.FX, C.SS2, tab};
            pg8::gemm_phase(lds3, 1024, 512, 8, S, E);
        }
        SEAM(p + 7);
        if (IN(p + 8)) { const Ctx C = make_ctx(a); phase_final(C, layer); }
        SEAM(p + 8);
#endif
    }
#undef IN
#undef SEAM
}

extern "C" void kernel_launch(void* const* d_in, const int* in_sizes, int n_in, void* d_out, int out_size, void* d_ws, size_t ws_size, hipStream_t stream) {
    static int grid = 0;
    if (grid == 0) {
        if (n_in != 24 || out_size != TL * D || ws_size < WS_END) { fprintf(stderr, "kernel_launch: unexpected shapes (n_in %d out %d ws %zu)\n", n_in, out_size, ws_size); grid = -1; return; }
        int dev = 0, cus = 0;
        if (hipGetDevice(&dev) != hipSuccess || hipDeviceGetAttribute(&cus, hipDeviceAttributeMultiprocessorCount, dev) != hipSuccess) { grid = -1; return; }
        if (hipFuncSetAttribute((const void*)fwd, hipFuncAttributeMaxDynamicSharedMemorySize, LDS_BYTES) != hipSuccess) { fprintf(stderr, "kernel_launch: hipFuncSetAttribute failed\n"); grid = -1; return; }
        int per_cu = 0;
        if (hipOccupancyMaxActiveBlocksPerMultiprocessor(&per_cu, (const void*)fwd, NTHREADS, LDS_BYTES) != hipSuccess || per_cu < 1) { fprintf(stderr, "kernel_launch: occupancy query says %d\n", per_cu); }
        (void)hipGetLastError();
        grid = cus;
    }
    if (grid < 0) return;
    (void)hipMemsetAsync((char*)d_ws + WS_CTL, 0, CTL_BYTES, stream);
    Args a{};
    for (int i = 0; i < 24; ++i) a.in[i] = (const float*)d_in[i];
    a.out = (float*)d_out; a.ws = (unsigned char*)d_ws;
#if N_LAUNCH_MODE == 1
    a.ph_lo = 0; a.ph_hi = N_PHASES;
    hipLaunchKernelGGL(fwd, dim3(grid), dim3(NTHREADS), LDS_BYTES, stream, a);
#else
    for (int p = 0; p < N_PHASES; ++p) { a.ph_lo = p; a.ph_hi = p + 1; hipLaunchKernelGGL(fwd, dim3(grid), dim3(NTHREADS), LDS_BYTES, stream, a); }
#endif
}
```

```cpp
#include <hip/hip_runtime.h>
#include <cstdio>
#include <cstdint>

#ifndef USE_NAIVE_ATTN
#define USE_NAIVE_ATTN 0
#endif
#ifndef USE_NAIVE_TOKB
#define USE_NAIVE_TOKB 0
#endif
#ifndef N_LAUNCH_MODE
#define N_LAUNCH_MODE 1
#endif

constexpr int D = 1024, BATCH = 16, SEQ = 2048, CTXL = 256, DEPTH = 2, GRIDW = 64;
constexpr int TL = BATCH * SEQ, TC = BATCH * CTXL, T = TL + TC;
constexpr int D_IN = 1952, NMOD = 6;
constexpr float EPS = 1e-6f;
constexpr float LOG2E = 1.4426950408889634f;
constexpr int Z_CQ = 0, Z_CKV = 256, Z_KR = 384, Z_BQ = 416, Z_BK = 672, Z_BV = 800, Z_DQ = 928, Z_DK = 1184, Z_DV = 1440, Z_U = 1696;
constexpr float SC_A = 0.10206207261596577f * LOG2E;
constexpr float SC_B = 0.125f * LOG2E;
constexpr float SC_C = 0.17677669529663687f * LOG2E;

constexpr size_t MiB = 1u << 20;
constexpr size_t WS_CTL = 0, CTL_BYTES = 1 * MiB;
constexpr size_t WS_MOD = 1 * MiB;
constexpr size_t WS_HCTX = 4 * MiB;
constexpr size_t WS_QKV = 130 * MiB;
constexpr size_t QA_OFF = 0, KA_OFF = QA_OFF + (size_t)T * 384 * 2, VA_OFF = KA_OFF + (size_t)T * 384 * 2,
                 QB_OFF = VA_OFF + (size_t)T * 256 * 2, KB_OFF = QB_OFF + (size_t)T * 256 * 2, VB_OFF = KB_OFF + (size_t)T * 128 * 2,
                 QC_OFF = VB_OFF + (size_t)T * 128 * 2, KC_OFF = QC_OFF + (size_t)T * 256 * 2, VC_OFF = KC_OFF + (size_t)T * 256 * 2,
                 U_OFF = VC_OFF + (size_t)T * 256 * 2, QKV_END = U_OFF + (size_t)T * 256 * 2;
static_assert(QKV_END <= 180 * MiB, "qkv region");
constexpr size_t WS_O = 310 * MiB;
constexpr size_t WS_WIN = 20 * MiB;
constexpr size_t WS_WOUT = 28 * MiB;
constexpr size_t WS_WUQ = 32 * MiB;
constexpr size_t WS_WUKV = 32 * MiB + 512 * 1024;
constexpr size_t WS_WGU = 34 * MiB;
constexpr size_t WS_WDN = 98 * MiB;
constexpr size_t WS_HX = 382 * MiB;
constexpr size_t WS_CQ = 454 * MiB;
constexpr size_t WS_CKVR = 472 * MiB;
constexpr size_t WS_SSQ = 490 * MiB;
constexpr size_t WS_SSK = 491 * MiB;
constexpr size_t WS_SS1 = 492 * MiB;
constexpr size_t WS_SS2 = 495 * MiB;
constexpr size_t WS_LIST = 498 * MiB;
constexpr size_t WS_TOKW = 502 * MiB;
constexpr size_t WS_END = 503 * MiB;
constexpr size_t WS_OX = WS_QKV;
constexpr size_t WS_ACT = WS_QKV;
constexpr size_t WS_HM = WS_QKV + 96 * MiB;
constexpr size_t WS_FX = WS_O;
constexpr int ACT_ROWS = 43008;
static_assert((size_t)ACT_ROWS * 2048 <= 96 * MiB && WS_HM + (size_t)T * 2048 <= WS_QKV + 180 * MiB, "aliases");
constexpr int CW_CNT = 8192;

typedef unsigned short bf16_t;
#define LAS __attribute__((address_space(3)))

__device__ __forceinline__ float bf2f(bf16_t b) { return __uint_as_float(((unsigned)b) << 16); }
__device__ __forceinline__ bf16_t f2bf(float f) { unsigned u = __float_as_uint(f); u += 0x7fffu + ((u >> 16) & 1u); return (bf16_t)(u >> 16); }

struct alignas(16) RopeTab { float c[64][24]; float s[64][24]; };
constexpr double cx_exp(double x) {
    int k = 0; while (x < -0.5) { x *= 0.5; ++k; }
    double t = 1.0, s = 1.0; for (int i = 1; i < 30; ++i) { t *= x / i; s += t; }
    for (int i = 0; i < k; ++i) s *= s; return s;
}
constexpr double cx_pi = 3.14159265358979323846264338327950288;
constexpr double cx_sin_small(double x) { double t = x, s = x; for (int i = 1; i < 14; ++i) { t *= -x * x / ((2 * i) * (2 * i + 1)); s += t; } return s; }
constexpr double cx_cos_small(double x) { double t = 1.0, s = 1.0; for (int i = 1; i < 14; ++i) { t *= -x * x / ((2 * i - 1) * (2 * i)); s += t; } return s; }
constexpr double cx_reduce(double x) { double q = x / (2 * cx_pi); long long n = (long long)q; double r = x - (double)n * 2 * cx_pi; if (r > cx_pi) r -= 2 * cx_pi; return r; }
constexpr RopeTab make_rope() {
    RopeTab t{};
    const double ln1e4 = 9.21034037197618273607196581873745683;
    double inv[24] = {};
    for (int f = 0; f < 24; ++f) inv[f] = (f < 8) ? cx_exp(-(double)f / 8.0 * ln1e4) : cx_exp(-(double)(f - 8) / 16.0 * ln1e4);
    for (int p = 0; p < 64; ++p) for (int f = 0; f < 24; ++f) {
        const double a = cx_reduce((double)p * inv[f]);
        t.c[p][f] = (float)cx_cos_small(a); t.s[p][f] = (float)cx_sin_small(a);
    }
    return t;
}
__device__ constexpr RopeTab g_rope = make_rope();
__device__ __forceinline__ void rope_cs_a(int t, int i, float& c, float& s) { const int p = (i < 8) ? (t >> 6) : (t & 63), f = i & 7; c = g_rope.c[p][f]; s = g_rope.s[p][f]; }
__device__ __forceinline__ void rope_cs_b(int t, int i, float& c, float& s) { const int p = (i < 16) ? (t >> 6) : (t & 63), f = 8 + (i & 15); c = g_rope.c[p][f]; s = g_rope.s[p][f]; }

#define XB_TMO      128
#define XB_XCNT(j)  (256  + 64 * (j))
#define XB_XSUB(j)  (1280 + 64 * (j))
#define XB_XGEN(j)  (2304 + 64 * (j))
#define XB_TOP      3328
#define XB_TOPGEN   3392
#define XCD_BAR_WORDS 3456
#define XB_SPIN_CAP (1u << 18)
__device__ __forceinline__ unsigned xb_ld(unsigned* p)              { return __hip_atomic_load(p, __ATOMIC_RELAXED, __HIP_MEMORY_SCOPE_AGENT); }
__device__ __forceinline__ unsigned xb_add(unsigned* p, unsigned v) { return __hip_atomic_fetch_add(p, v, __ATOMIC_RELAXED, __HIP_MEMORY_SCOPE_AGENT); }
__device__ __forceinline__ unsigned xb_xcc_id() { return (unsigned)__builtin_amdgcn_s_getreg((3 << 11) | 20) & 0xFu; }
#define XB_SPIN(cond, bar) do { unsigned _sp = 0; while (cond) { __builtin_amdgcn_s_sleep(1); \
    if ((++_sp & 255u) == 0u) { if (xb_ld(&(bar)[XB_TMO])) break; if (_sp > XB_SPIN_CAP) { atomicAdd(&(bar)[XB_TMO], 1u); break; } } } } while (0)
struct XcdBarrier { unsigned* bar; unsigned x; volatile LAS unsigned* st; };
__device__ __forceinline__ XcdBarrier xcd_barrier_post(unsigned* bar, volatile LAS unsigned* st) {
    XcdBarrier b; b.bar = bar; b.x = xb_xcc_id(); b.st = st;
    if (threadIdx.x == 0) (void)xb_add(&bar[XB_XCNT(b.x)], 1u);
    return b;
}
__device__ __forceinline__ void xcd_barrier_complete(unsigned* bar, unsigned x, unsigned& nloc, unsigned& nx) {
    const unsigned G = gridDim.x * gridDim.y * gridDim.z;
    unsigned sum, cnt, mine, sp = 0u;
    for (;;) {
        sum = 0u; cnt = 0u; mine = 0u;
#pragma unroll
        for (unsigned j = 0; j < 16; ++j) { const unsigned c = xb_ld(&bar[XB_XCNT(j)]); sum += c; cnt += (c > 0u) ? 1u : 0u; mine = (j == x) ? c : mine; }
        if (sum == G) break;
        __builtin_amdgcn_s_sleep(1);
        if ((++sp & 255u) == 0u) { if (xb_ld(&bar[XB_TMO])) break; if (sp > XB_SPIN_CAP) { atomicAdd(&bar[XB_TMO], 1u); break; } }
    }
    nloc = mine > 0u ? mine : 1u; nx = cnt > 0u ? cnt : 1u;
}
__device__ __forceinline__ void xcd_barrier(const XcdBarrier& b) {
    asm volatile("s_waitcnt vmcnt(0)" ::: "memory");
    __syncthreads();
    if (threadIdx.x == 0) {
        unsigned* bar = b.bar;
        __builtin_amdgcn_s_waitcnt(0);
        unsigned nloc = b.st[0], nx = b.st[1];
        if (nloc == 0u) { xcd_barrier_complete(bar, b.x, nloc, nx); b.st[0] = nloc; b.st[1] = nx; }
        const unsigned old = xb_add(&bar[XB_XSUB(b.x)], 1u);
        const unsigned gen = old / nloc;
        if (old + 1u == (gen + 1u) * nloc) {
            __builtin_amdgcn_fence(__ATOMIC_RELEASE, "agent");
            asm volatile("s_waitcnt vmcnt(0)" ::: "memory");
            const unsigned og = xb_add(&bar[XB_TOP], 1u);
            const unsigned tg = og / nx;
            if (og + 1u == (tg + 1u) * nx) xb_add(&bar[XB_TOPGEN], 1u);
            else XB_SPIN(xb_ld(&bar[XB_TOPGEN]) == tg, bar);
            __builtin_amdgcn_fence(__ATOMIC_ACQUIRE, "agent");
            xb_add(&bar[XB_XGEN(b.x)], 1u);
            asm volatile("s_waitcnt vmcnt(0)" ::: "memory");
        } else {
            XB_SPIN(xb_ld(&bar[XB_XGEN(b.x)]) == gen, bar);
            __builtin_amdgcn_fence(__ATOMIC_ACQUIRE, "agent");
            asm volatile("s_waitcnt vmcnt(0)" ::: "memory");
        }
    }
    __syncthreads();
}

constexpr int NTHREADS = 512, NWAVES = 8;
constexpr int LDS_BYTES = 147456;
constexpr int LDS_MISC = 143360;

struct Args {
    const float* in[24]; float* out; unsigned char* ws; int ph_lo, ph_hi;
};
struct Ctx {
    const float *x, *c, *ctx, *c_ctx, *ada_w, *ada_b, *norm_g, *w_in, *q_gain, *kv_gain, *w_uq, *w_ukv, *sink, *dlam, *subln, *pool_w, *pool_scale,
                *w_out, *r_gw, *r_gb, *r_ew, *r_eb, *w_gu, *w_down;
    float* out; unsigned char* ws;
    float* mod; float* hctx;
    bf16_t *QA, *KA, *VA, *QB, *KB, *VB, *QC, *KC, *VC, *U, *O;
    bf16_t *WIN, *WOUT, *WUQ, *WUKV, *WGU, *WDN, *HX, *CQ, *CKVR; float *SSQ, *SSK;
    bf16_t *OX, *ACT, *HM, *FX; float *SS1, *SS2, *TOKW; int* LIST; unsigned* CNT;
};
__device__ __forceinline__ float wave_sum(float v) {
#pragma unroll
    for (int o = 32; o >= 1; o >>= 1) v += __shfl_xor(v, o);
    return v;
}
__device__ __forceinline__ float wave_max(float v) {
#pragma unroll
    for (int o = 32; o >= 1; o >>= 1) v = fmaxf(v, __shfl_xor(v, o));
    return v;
}
__device__ __forceinline__ float block_sum(float v, float* red) {
    v = wave_sum(v);
    __syncthreads();
    if ((threadIdx.x & 63) == 0) red[threadIdx.x >> 6] = v;
    __syncthreads();
    float s = 0.f;
#pragma unroll
    for (int i = 0; i < NWAVES; ++i) s += red[i];
    return s;
}
__device__ __forceinline__ int opaque_tid() { int t = threadIdx.x; asm volatile("" : "+v"(t)); return t; }
__device__ __forceinline__ float silu_f(float v) { return v / (1.f + __expf(-v)); }
__device__ __forceinline__ float lam_init_of(int layer) { return layer == 0 ? 0.2f : (0.8f - 0.6f * 0.7408182206817179f); }

__device__ __forceinline__ const float* xrow_in(const Ctx& C, int layer, int r) {
    const float* a0 = C.x + 0; const float* a1 = C.out + 0; const float* b0 = C.ctx + 0; const float* b1 = C.hctx + 0;
    if (r < TL) return (layer == 0 ? a0 : a1) + (size_t)r * D;
    return (layer == 0 ? b0 : b1) + (size_t)(r - TL) * D;
}
__device__ __forceinline__ float* xrow_out(const Ctx& C, int r) { float* a1 = C.out + 0; float* b1 = C.hctx + 0; return (r < TL) ? a1 + (size_t)r * D : b1 + (size_t)(r - TL) * D; }

__device__ __forceinline__ void phase_mod(const Ctx& C, float* lds) {
    float* sv = lds;
    float* part = lds + 17 * 1024;
    const int tid = opaque_tid(), lane = tid & 63, wave = tid >> 6;
    for (int i = tid; i < 17 * 1024; i += NTHREADS) { const float v = (i < 16 * 1024) ? C.c[i] : C.c_ctx[i - 16 * 1024]; sv[i] = silu_f(v); }
    __syncthreads();
    const int nitems = DEPTH * (NMOD * D / 64);
    for (int item = blockIdx.x; item < nitems; item += gridDim.x) {
        const int l = item / (NMOD * D / 64), j = (item % (NMOD * D / 64)) * 64 + lane;
        const float* w = C.ada_w + (size_t)l * D * (NMOD * D) + j;
        float acc[17];
#pragma unroll
        for (int r = 0; r < 17; ++r) acc[r] = 0.f;
        for (int k = wave * 128; k < wave * 128 + 128; ++k) {
            const float wv = w[(size_t)k * (NMOD * D)];
#pragma unroll
            for (int r = 0; r < 17; ++r) acc[r] += sv[r * 1024 + k] * wv;
        }
#pragma unroll
        for (int r = 0; r < 17; ++r) part[(wave * 17 + r) * 64 + lane] = acc[r];
        __syncthreads();
        for (int i = tid; i < 17 * 64; i += NTHREADS) {
            const int r = i >> 6, jj = i & 63; float s = 0.f;
#pragma unroll
            for (int w8 = 0; w8 < 8; ++w8) s += part[(w8 * 17 + r) * 64 + jj];
            const int col = (item % (NMOD * D / 64)) * 64 + jj;
            C.mod[((size_t)l * 17 + r) * (NMOD * D) + col] = s + C.ada_b[(size_t)l * NMOD * D + col];
        }
        __syncthreads();
    }
}

constexpr int TOKA = 4;
__device__ __forceinline__ void naive_tokA(const Ctx& C, int layer, float* lds) {
    float* hx = lds;
    float* z = hx + TOKA * 1024;
    float* qn = z + TOKA * D_IN;
    float* kvn = qn + TOKA * 256;
    float* qa = kvn + TOKA * 128;
    float* kva = qa + TOKA * 384;
    float* red = kva + TOKA * 512;
    const int tid = opaque_tid();
    const float* g0 = C.norm_g + ((size_t)layer * 4 + 0) * D;
    for (int item = blockIdx.x; item < T / TOKA; item += gridDim.x) {
        const int r0 = item * TOKA;
        const bool isctx = r0 >= TL;
        const int b = isctx ? (r0 - TL) / CTXL : r0 / SEQ;
        const float* modp = C.mod + ((size_t)layer * 17 + (isctx ? 16 : b)) * (NMOD * D);
        __syncthreads();
        for (int tk = 0; tk < TOKA; ++tk) {
            const float* xr = xrow_in(C, layer, r0 + tk);
            const float v0 = xr[tid], v1 = xr[tid + 512];
            const float ss = block_sum(v0 * v0 + v1 * v1, red);
            const float rstd = rsqrtf(ss * (1.f / D) + EPS);
            hx[tk * 1024 + tid] = (v0 * rstd * g0[tid]) * (1.f + modp[D + tid]) + modp[tid];
            hx[tk * 1024 + tid + 512] = (v1 * rstd * g0[tid + 512]) * (1.f + modp[D + tid + 512]) + modp[tid + 512];
        }
        __syncthreads();
        for (int jj = 0; jj < 4; ++jj) {
            const int j = tid + 512 * jj;
            if (j < D_IN) {
                const float* w = C.w_in + (size_t)layer * D * D_IN + j;
                float a0 = 0.f, a1 = 0.f, a2 = 0.f, a3 = 0.f;
#pragma unroll 8
                for (int k = 0; k < D; ++k) { const float wv = w[(size_t)k * D_IN]; a0 += hx[k] * wv; a1 += hx[1024 + k] * wv; a2 += hx[2048 + k] * wv; a3 += hx[3072 + k] * wv; }
                z[j] = a0; z[D_IN + j] = a1; z[2 * D_IN + j] = a2; z[3 * D_IN + j] = a3;
            }
        }
        __syncthreads();
        for (int tk = 0; tk < TOKA; ++tk) {
            const float v = (tid < 256) ? z[tk * D_IN + Z_CQ + tid] : 0.f;
            const float ssq = block_sum(v * v, red);
            const float w2 = (tid < 128) ? z[tk * D_IN + Z_CKV + tid] : 0.f;
            const float ssk = block_sum(w2 * w2, red);
            if (tid < 256) qn[tk * 256 + tid] = v * rsqrtf(ssq * (1.f / 256) + EPS) * C.q_gain[layer * 256 + tid];
            if (tid < 128) kvn[tk * 128 + tid] = w2 * rsqrtf(ssk * (1.f / 128) + EPS) * C.kv_gain[layer * 128 + tid];
        }
        __syncthreads();
        if (tid < 384) {
            const float* w = C.w_uq + (size_t)layer * 256 * 384 + tid;
            float a0 = 0.f, a1 = 0.f, a2 = 0.f, a3 = 0.f;
            for (int k = 0; k < 256; ++k) { const float wv = w[k * 384]; a0 += qn[k] * wv; a1 += qn[256 + k] * wv; a2 += qn[512 + k] * wv; a3 += qn[768 + k] * wv; }
            qa[tid] = a0; qa[384 + tid] = a1; qa[768 + tid] = a2; qa[1152 + tid] = a3;
        }
        {
            const float* w = C.w_ukv + (size_t)layer * 128 * 512 + tid;
            float a0 = 0.f, a1 = 0.f, a2 = 0.f, a3 = 0.f;
            for (int k = 0; k < 128; ++k) { const float wv = w[k * 512]; a0 += kvn[k] * wv; a1 += kvn[128 + k] * wv; a2 += kvn[256 + k] * wv; a3 += kvn[384 + k] * wv; }
            kva[tid] = a0; kva[512 + tid] = a1; kva[1024 + tid] = a2; kva[1536 + tid] = a3;
        }
        __syncthreads();
        for (int tk = 0; tk < TOKA; ++tk) {
            const int r = r0 + tk; const int t = r % SEQ;
            const float* zz = z + tk * D_IN; const float* qq = qa + tk * 384; const float* kk = kva + tk * 512;
            if (tid < 384) {
                const int h = tid / 96, e = tid % 96; float v;
                if (e < 64) v = qq[h * 96 + e];
                else { const int i = (e - 64) & 15; const float x1 = qq[h * 96 + 64 + i], x2 = qq[h * 96 + 80 + i]; float c = 1.f, s = 0.f; if (!isctx) rope_cs_a(t, i, c, s);
                       v = (e - 64 < 16) ? (x1 * c - x2 * s) : (x1 * s + x2 * c); }
                C.QA[(size_t)r * 384 + tid] = f2bf(v * SC_A);
                float kv_;
                if (e < 64) kv_ = kk[h * 128 + e];
                else { const int i = (e - 64) & 15; const float x1 = zz[Z_KR + i], x2 = zz[Z_KR + 16 + i]; float c = 1.f, s = 0.f; if (!isctx) rope_cs_a(t, i, c, s);
                       kv_ = (e - 64 < 16) ? (x1 * c - x2 * s) : (x1 * s + x2 * c); }
                C.KA[(size_t)r * 384 + tid] = f2bf(kv_);
            }
            if (tid < 256) {
                const int h = tid >> 6, e = tid & 63;
                C.VA[(size_t)r * 256 + tid] = f2bf(kk[h * 128 + 64 + e]);
                { const int i = e & 31; const float x1 = zz[Z_BQ + h * 64 + i], x2 = zz[Z_BQ + h * 64 + 32 + i]; float c = 1.f, s = 0.f; if (!isctx) rope_cs_b(t, i, c, s);
                  C.QB[(size_t)r * 256 + tid] = f2bf(((e < 32) ? (x1 * c - x2 * s) : (x1 * s + x2 * c)) * SC_B); }
                { const int hh = tid >> 5, ee = tid & 31, i = ee & 15; float c = 1.f, s = 0.f; if (!isctx) rope_cs_a(t, i, c, s);
                  const float x1 = zz[Z_DQ + hh * 32 + i], x2 = zz[Z_DQ + hh * 32 + 16 + i];
                  C.QC[(size_t)r * 256 + tid] = f2bf(((ee < 16) ? (x1 * c - x2 * s) : (x1 * s + x2 * c)) * SC_C);
                  const float y1 = zz[Z_DK + hh * 32 + i], y2 = zz[Z_DK + hh * 32 + 16 + i];
                  C.KC[(size_t)r * 256 + tid] = f2bf((ee < 16) ? (y1 * c - y2 * s) : (y1 * s + y2 * c)); }
                C.VC[(size_t)r * 256 + tid] = f2bf(zz[Z_DV + tid]);
                C.U[(size_t)r * 256 + tid] = f2bf(zz[Z_U + tid]);
            }
            if (tid < 128) {
                const int h = tid >> 6, e = tid & 63, i = e & 31; const float x1 = zz[Z_BK + h * 64 + i], x2 = zz[Z_BK + h * 64 + 32 + i]; float c = 1.f, s = 0.f; if (!isctx) rope_cs_b(t, i, c, s);
                C.KB[(size_t)r * 128 + tid] = f2bf((e < 32) ? (x1 * c - x2 * s) : (x1 * s + x2 * c));
                C.VB[(size_t)r * 128 + tid] = f2bf(zz[Z_BV + tid]);
            }
        }
    }
}

template <int DQK>
__device__ __forceinline__ float dot_qk(const float* q  , const bf16_t* krow) {
    float s = 0.f;
#pragma unroll
    for (int c = 0; c < DQK / 8; ++c) {
        const uint4 kv = *(const uint4*)(krow + c * 8);
        const unsigned w[4] = {kv.x, kv.y, kv.z, kv.w};
#pragma unroll
        for (int j = 0; j < 4; ++j) { s += q[c * 8 + 2 * j] * __uint_as_float(w[j] << 16); s += q[c * 8 + 2 * j + 1] * __uint_as_float(w[j] & 0xffff0000u); }
    }
    return s;
}
template <int DQK>
__device__ __forceinline__ void naive_attend(const float* q, float* sc, const bf16_t* K, int kpitch, int koff, const bf16_t* V, int vpitch, int voff,
                                             int b, int lk0, int lk1, int lane, float& m_out, float& l_out, float& o_out) {
    const int nl = lk1 - lk0, ntot = nl + CTXL;
    const size_t lat0 = (size_t)b * SEQ + lk0, ctx0 = (size_t)TL + (size_t)b * CTXL;
    float m = -INFINITY;
    for (int kk = lane; kk < ntot; kk += 64) {
        const size_t row = kk < nl ? lat0 + kk : ctx0 + (kk - nl);
        const float s = dot_qk<DQK>(q, K + row * kpitch + koff);
        sc[kk] = s; m = fmaxf(m, s);
    }
    m = wave_max(m);
    float l = 0.f;
    for (int kk = lane; kk < ntot; kk += 64) { const float p = exp2f(sc[kk] - m); sc[kk] = p; l += p; }
    l = wave_sum(l);
    float o = 0.f;
    for (int kk = 0; kk < ntot; ++kk) {
        const size_t row = kk < nl ? lat0 + kk : ctx0 + (kk - nl);
        o += sc[kk] * bf2f(V[row * vpitch + voff + lane]);
    }
    m_out = m; l_out = l; o_out = o;
}

__device__ __forceinline__ void naive_attn(const Ctx& C, int layer, float* lds) {
    const int tid = opaque_tid(), lane = tid & 63, wave = tid >> 6;
    float* qs = lds + wave * 2560;
    float* sc = qs + 128;
    const int gw = blockIdx.x * NWAVES + wave, ngw = gridDim.x * NWAVES;
    float lam;
    { const float* dl = C.dlam + (size_t)layer * 128; float s1 = 0.f, s2 = 0.f; for (int i = 0; i < 32; ++i) { s1 += dl[i] * dl[32 + i]; s2 += dl[64 + i] * dl[96 + i]; }
      lam = expf(s1) - expf(s2) + lam_init_of(layer); }
    const float lam_init = lam_init_of(layer);
    const int nrows = (layer == DEPTH - 1) ? TL : T;
    for (long it = gw; it < (long)nrows * 16; it += ngw) {
        const int r = (int)(it >> 4), task = (int)(it & 15);
        const bool isctx = r >= TL;
        const int b = isctx ? (r - TL) / CTXL : r / SEQ;
        const int t = isctx ? (r - TL) % CTXL : r % SEQ;
        float m, l, o;
        if (task < 4) {
            const int h = task;
            for (int i = lane; i < 96; i += 64) qs[i] = bf2f(C.QA[(size_t)r * 384 + h * 96 + i]);
            naive_attend<96>(qs, sc, C.KA, 384, h * 96, C.VA, 256, h * 64, b, 0, isctx ? 0 : SEQ, lane, m, l, o);
            C.O[(size_t)r * D + h * 64 + lane] = f2bf(o / l);
        } else if (task < 8) {
            const int h = task - 4, kvh = h >> 1;
            qs[lane] = bf2f(C.QB[(size_t)r * 256 + h * 64 + lane]);
            naive_attend<64>(qs, sc, C.KB, 128, kvh * 64, C.VB, 128, kvh * 64, b, isctx ? 0 : max(t - 128, 0), isctx ? 0 : min(t + 129, SEQ), lane, m, l, o);
            const float sk = C.sink[layer * 4 + h] * LOG2E;
            const float mm = fmaxf(m, sk); const float f = exp2f(m - mm);
            const float ll = l * f + exp2f(sk - mm);
            C.O[(size_t)r * D + 256 + h * 64 + lane] = f2bf(o * f / ll);
        } else if (task < 12) {
            const int h = task - 8; float oc[2];
            for (int cpn = 0; cpn < 2; ++cpn) {
                const int j = 2 * h + cpn;
                if (lane < 32) qs[lane] = bf2f(C.QC[(size_t)r * 256 + j * 32 + lane]);
                naive_attend<32>(qs, sc, C.KC, 256, j * 32, C.VC, 256, h * 64, b, 0, isctx ? 0 : SEQ, lane, m, l, o);
                oc[cpn] = o / l;
            }
            const float a = oc[0] - lam * oc[1];
            const float ss = wave_sum(a * a);
            C.O[(size_t)r * D + 512 + h * 64 + lane] = f2bf(a * rsqrtf(ss * (1.f / 64) + EPS) * C.subln[layer * 64 + lane] * (1.f - lam_init));
        } else {
            const int g = task - 12, w = 2 << g, half = w >> 1, L = isctx ? CTXL : SEQ;
            const size_t rbase = (size_t)r - t;
            const int lo = max(t - half, 0), hi = min(t - half + w, L);
            float s = 0.f;
            for (int p = lo; p < hi; ++p) s += bf2f(C.U[(rbase + p) * 256 + g * 64 + lane]);
            const float dg = s / (float)(hi - lo) - bf2f(C.U[(size_t)r * 256 + g * 64 + lane]);
            const float* pw = C.pool_w + ((size_t)layer * 4 + g) * 64 * 64;
            float y = 0.f;
            for (int c = 0; c < 64; ++c) y += __shfl(dg, c) * pw[c * 64 + lane];
            C.O[(size_t)r * D + 768 + g * 64 + lane] = f2bf(y * C.pool_scale[layer * 256 + g * 64 + lane]);
        }
    }
}

__device__ __forceinline__ void naive_tokB(const Ctx& C, int layer, float* lds) {
    float* ov = lds;
    float* x1 = ov + 1024;
    float* hm = x1 + 1024;
    float* gu = hm + 1024;
    float* act = gu + 1024;
    float* yv = act + 512;
    float* red = yv + 1024;
    float* lg = red + 8;
    const int tid = opaque_tid(), lane = tid & 63, wave = tid >> 6;
    const float* g1 = C.norm_g + ((size_t)layer * 4 + 1) * D;
    const float* g2 = C.norm_g + ((size_t)layer * 4 + 2) * D;
    const float* g3 = C.norm_g + ((size_t)layer * 4 + 3) * D;
    const int nrows = (layer == DEPTH - 1) ? TL : T;
    for (int r = blockIdx.x; r < nrows; r += gridDim.x) {
        const bool isctx = r >= TL;
        const int b = isctx ? (r - TL) / CTXL : r / SEQ;
        const float* modp = C.mod + ((size_t)layer * 17 + (isctx ? 16 : b)) * (NMOD * D);
        __syncthreads();
        ov[tid] = bf2f(C.O[(size_t)r * D + tid]); ov[tid + 512] = bf2f(C.O[(size_t)r * D + tid + 512]);
        __syncthreads();
        float a0 = 0.f, a1 = 0.f;
        { const float* w = C.w_out + (size_t)layer * D * D + tid;
#pragma unroll 8
          for (int k = 0; k < D; ++k) { const float ok = ov[k]; a0 += ok * w[(size_t)k * D]; a1 += ok * w[(size_t)k * D + 512]; } }
        float ss = block_sum(a0 * a0 + a1 * a1, red);
        float rstd = rsqrtf(ss * (1.f / D) + EPS);
        const float* xr = xrow_in(C, layer, r);
        const float xa = xr[tid] + modp[2 * D + tid] * (a0 * rstd * g1[tid]);
        const float xb = xr[tid + 512] + modp[2 * D + tid + 512] * (a1 * rstd * g1[tid + 512]);
        ss = block_sum(xa * xa + xb * xb, red);
        rstd = rsqrtf(ss * (1.f / D) + EPS);
        hm[tid] = (xa * rstd * g2[tid]) * (1.f + modp[4 * D + tid]) + modp[3 * D + tid];
        hm[tid + 512] = (xb * rstd * g2[tid + 512]) * (1.f + modp[4 * D + tid + 512]) + modp[3 * D + tid + 512];
        __syncthreads();
        for (int q = wave; q < 20; q += NWAVES) {
            float s = 0.f;
            if (q < 4) { const float* w = C.r_gw + (size_t)layer * D * 4 + q; for (int k = lane; k < D; k += 64) s += hm[k] * w[k * 4]; }
            else { const float* w = C.r_ew + (size_t)layer * D * 16 + (q - 4); for (int k = lane; k < D; k += 64) s += hm[k] * w[k * 16]; }
            s = wave_sum(s);
            if (lane == 0) lg[q] = s + (q < 4 ? C.r_gb[layer * 4 + q] : C.r_eb[layer * 16 + (q - 4)]);
        }
        __syncthreads();
        int gsel = 0; float gmax = lg[0];
        for (int i = 1; i < 4; ++i) if (lg[i] > gmax) { gmax = lg[i]; gsel = i; }
        float gs = 0.f; for (int i = 0; i < 4; ++i) gs += expf(lg[i] - gmax);
        const float pg = 1.f / gs;
        int i1 = 0; float v1 = lg[4 + gsel * 4];
        for (int i = 1; i < 4; ++i) if (lg[4 + gsel * 4 + i] > v1) { v1 = lg[4 + gsel * 4 + i]; i1 = i; }
        int i2 = -1; float v2 = -INFINITY;
        for (int i = 0; i < 4; ++i) if (i != i1 && lg[4 + gsel * 4 + i] > v2) { v2 = lg[4 + gsel * 4 + i]; i2 = i; }
        const float e2 = expf(v2 - v1); const float w1 = pg / (1.f + e2), w2 = pg * e2 / (1.f + e2);
        float y0 = 0.f, y1 = 0.f;
        for (int s = 0; s < 2; ++s) {
            const int e = gsel * 4 + (s == 0 ? i1 : i2); const float wsel = (s == 0) ? w1 : w2;
            const float* wg = C.w_gu + ((size_t)layer * 16 + e) * D * 1024 + tid;
            float c0 = 0.f, c1 = 0.f;
#pragma unroll 8
            for (int k = 0; k < D; ++k) { const float hk = hm[k]; c0 += hk * wg[(size_t)k * 1024]; c1 += hk * wg[(size_t)k * 1024 + 512]; }
            __syncthreads();
            act[tid] = silu_f(c0) * c1;
            __syncthreads();
            const float* wd = C.w_down + ((size_t)layer * 16 + e) * 512 * D + tid;
            float d0 = 0.f, d1 = 0.f;
#pragma unroll 8
            for (int k = 0; k < 512; ++k) { const float ak = act[k]; d0 += ak * wd[(size_t)k * D]; d1 += ak * wd[(size_t)k * D + 512]; }
            y0 += wsel * d0; y1 += wsel * d1;
        }
        ss = block_sum(y0 * y0 + y1 * y1, red);
        rstd = rsqrtf(ss * (1.f / D) + EPS);
        float* xo = xrow_out(C, r);
        xo[tid] = xa + modp[5 * D + tid] * (y0 * rstd * g3[tid]);
        xo[tid + 512] = xb + modp[5 * D + tid + 512] * (y1 * rstd * g3[tid + 512]);
    }
}

namespace pg8 {
typedef short bf16x8 __attribute__((ext_vector_type(8)));
typedef float f32x4 __attribute__((ext_vector_type(4)));
typedef unsigned u32x4 __attribute__((ext_vector_type(4)));
typedef unsigned u32x2 __attribute__((ext_vector_type(2)));
constexpr int BM = 256, BK = 64, HALF = 128, HTB = HALF * BK * 2, STAGE_BYTES = 8 * HTB, NXCD = 8, WGM = 8;
__host__ __device__ __forceinline__ int lds_byte(int r, int c) { const int st = (r >> 4) * 2 + (c >> 5), rr = r & 15, cc = c & 31, ob = rr * 64 + cc * 2; return st * 1024 + (ob ^ (((ob >> 9) & 1) << 5)); }
__host__ __device__ __forceinline__ void stage_rc(int b, int& R, int& C) { const int st = b / 1024, sb = b % 1024, swz = sb ^ (((sb >> 9) & 1) << 5); R = (st >> 1) * 16 + swz / 64; C = (st & 1) * 32 + (swz % 64) / 2; }
__host__ __device__ __forceinline__ int perm32(int rho) { const int n = rho >> 4, i = rho & 15; return 8 * (i >> 2) + 4 * n + (i & 3); }
__device__ __forceinline__ unsigned cvt_pk_bf16(float lo, float hi) { unsigned r; asm volatile("v_cvt_pk_bf16_f32 %0, %1, %2" : "=v"(r) : "v"(lo), "v"(hi)); return r; }

__device__ __forceinline__ bool static_tile(int i, int G, int c, int nM, int nN, int& pm, int& pn) {
    const int nwg = nM * nN; const long L = (long)i * G + c; if (L >= nwg) return false;
    int wgid = (int)L; { const int q = nwg / NXCD, r = nwg % NXCD, xcd = wgid % NXCD, off = wgid / NXCD; wgid = (xcd < r ? xcd * (q + 1) : r * (q + 1) + (xcd - r) * q) + off; }
    const int nig = WGM * nN, gid = wgid / nig, fm = gid * WGM, gsz = (nM - fm) < WGM ? (nM - fm) : WGM;
    pm = fm + ((wgid % nig) % gsz); pn = (wgid % nig) / gsz; return true;
}
struct GUnit { const char* A; const char* B; const char* B2; int pm, pn, x0, x1; };
template <class Epi, class Sched>
__device__ __forceinline__ void gemm_phase(LAS unsigned char* lds, const int K, const int ldb  , const int ksplit  , const Sched& S, const Epi& E) {
    const int tid = opaque_tid(), wid = __builtin_amdgcn_readfirstlane(tid >> 6), lane = tid & 63, wr = wid >> 2, wc = wid & 3, fr = lane & 15, fq = lane >> 4;
    int nt = K / BK; asm volatile("" : "+s"(nt));
    unsigned voffB[2];
#pragma unroll
    for (int i = 0; i < 2; ++i) { int R_, C_; stage_rc(tid * 16 + i * 8192, R_, C_); const int Rb = Epi::PERM ? ((R_ & ~31) + perm32(R_ & 31)) : R_; voffB[i] = (unsigned)(Rb * ldb + C_) * 2u; }
    const size_t kstep = (size_t)(BK * 2);
    const size_t hstepB = (size_t)HALF * ldb * 2;
    const unsigned ldsw = (unsigned)wid * 1024u;
    const int aoff = lds_byte(wr * 64 + fr, fq * 8), boff = lds_byte(wc * 32 + fr, fq * 8);
#define PG8_SA(b, h) (((b) * 2 + (h)) * HTB)
#define PG8_SB(b, h) ((4 + (b) * 2 + (h)) * HTB)
#define PG8_STAGE(bufoff, gbase, v0, v1) do { \
        __builtin_amdgcn_global_load_lds((const unsigned*)((const char*)(gbase) + (v0)), (LAS unsigned*)(lds + (bufoff) + ldsw), 16, 0, 0); \
        __builtin_amdgcn_global_load_lds((const unsigned*)((const char*)(gbase) + (v1)), (LAS unsigned*)(lds + (bufoff) + ldsw + 8192), 16, 0, 0); } while (0)
#define PG8_STAGE_B(bufoff, gbase) PG8_STAGE(bufoff, gbase, voffB[0], voffB[1])
#define PG8_LDA(dst, b, h) do { _Pragma("unroll") for (int m = 0; m < 4; ++m) _Pragma("unroll") for (int k = 0; k < 2; ++k) dst[m][k] = *(const LAS bf16x8*)(lds + PG8_SA(b, h) + aoff + m * 2048 + k * 1024); } while (0)
#define PG8_LDB(dst, b, h) do { _Pragma("unroll") for (int n = 0; n < 2; ++n) _Pragma("unroll") for (int k = 0; k < 2; ++k) dst[n][k] = *(const LAS bf16x8*)(lds + PG8_SB(b, h) + boff + n * 2048 + k * 1024); } while (0)
#define PG8_MMA(ai, bj, At, Bt) do { __builtin_amdgcn_s_setprio(1); _Pragma("unroll") for (int m = 0; m < 4; ++m) _Pragma("unroll") for (int n = 0; n < 2; ++n) _Pragma("unroll") for (int k = 0; k < 2; ++k) \
        acc[ai][bj][m][n] = __builtin_amdgcn_mfma_f32_16x16x32_bf16(Bt[n][k], At[m][k], acc[ai][bj][m][n], 0, 0, 0); __builtin_amdgcn_s_setprio(0); } while (0)
#define PG8_WAIT_V(n) asm volatile("s_waitcnt vmcnt(" #n ")" ::: "memory")
#define PG8_WAIT_L(n) asm volatile("s_waitcnt lgkmcnt(" #n ")" ::: "memory")
#define PG8_BAR __builtin_amdgcn_s_barrier()
#define PG8_SCHED __builtin_amdgcn_sched_barrier(0)
#define PG8_BPTR(u, kt) (((kt) < ksplit) ? (u).B + (size_t)(kt) * kstep : (u).B2 + (size_t)((kt) - ksplit) * kstep)
    GUnit cur, nxt; int ui = 0;
    if (!S.next(0, cur)) return;

    f32x4 acc[2][2][4][2];
#pragma unroll
    for (int a = 0; a < 2; ++a)
#pragma unroll
        for (int b = 0; b < 2; ++b)
#pragma unroll
            for (int m = 0; m < 4; ++m)
#pragma unroll
                for (int n = 0; n < 2; ++n) acc[a][b][m][n] = (f32x4){0.f, 0.f, 0.f, 0.f};
    bf16x8 At[4][2], B0[2][2], B1[2][2];
    unsigned vc00, vc01, vc10, vc11;
#define PG8_AOFFS(u) do { int R0_, C0_, R1_, C1_; stage_rc(tid * 16, R0_, C0_); stage_rc(tid * 16 + 8192, R1_, C1_); \
        vc00 = S.arow(u, R0_) + C0_ * 2u; vc01 = S.arow(u, R1_) + C1_ * 2u; vc10 = S.arow(u, HALF + R0_) + C0_ * 2u; vc11 = S.arow(u, HALF + R1_) + C1_ * 2u; } while (0)
    PG8_AOFFS(cur);
    const char* cA = cur.A;
    {
        const char* b0 = PG8_BPTR(cur, 0); const char* b1 = PG8_BPTR(cur, 1);
        PG8_STAGE_B(PG8_SB(0, 0), b0); PG8_STAGE(PG8_SA(0, 0), cA, vc00, vc01); PG8_STAGE_B(PG8_SB(0, 1), b0 + hstepB); PG8_STAGE(PG8_SA(0, 1), cA, vc10, vc11);
        if (wr == 1) PG8_BAR;
        PG8_WAIT_V(4); PG8_BAR;
        PG8_STAGE_B(PG8_SB(1, 0), b1); PG8_STAGE(PG8_SA(1, 0), cA + kstep, vc00, vc01); PG8_STAGE_B(PG8_SB(1, 1), b1 + hstepB);
        PG8_WAIT_V(6); PG8_BAR;
    }
#pragma unroll 1
    for (;;) {
        const bool has_next = S.next(ui + 1, nxt);
        if (!has_next) nxt = cur;
        const char* nA = nxt.A;
#pragma unroll 1
        for (int t = 0; t < nt; t += 2) {
            const bool last = (t == nt - 2);
            const char* a1 = cA + (size_t)(t + 1) * kstep;
            const char* a2 = last ? nA : cA + (size_t)(t + 2) * kstep;
            const char* a3 = a2 + kstep;
            const char* b2 = last ? PG8_BPTR(nxt, 0) : PG8_BPTR(cur, t + 2);
            const char* b3 = last ? PG8_BPTR(nxt, 1) : PG8_BPTR(cur, t + 3);
            PG8_LDB(B0, 0, 0); PG8_SCHED; PG8_LDA(At, 0, 0); PG8_STAGE(PG8_SA(1, 1), a1, vc10, vc11);
            PG8_WAIT_L(8); PG8_BAR; PG8_WAIT_L(0); PG8_MMA(0, 0, At, B0); PG8_BAR; PG8_SCHED;
            if (last) PG8_AOFFS(nxt);
            PG8_LDB(B1, 0, 1); PG8_STAGE_B(PG8_SB(0, 0), b2);
            PG8_BAR; PG8_WAIT_L(0); PG8_MMA(0, 1, At, B1); PG8_BAR;
            PG8_LDA(At, 0, 1); PG8_STAGE(PG8_SA(0, 0), a2, vc00, vc01);
            PG8_BAR; PG8_WAIT_L(0); PG8_MMA(1, 0, At, B0); PG8_BAR; PG8_SCHED;
            PG8_STAGE_B(PG8_SB(0, 1), b2 + hstepB);
            PG8_WAIT_V(6); PG8_BAR; PG8_MMA(1, 1, At, B1); PG8_BAR;
            PG8_LDB(B0, 1, 0); PG8_SCHED; PG8_LDA(At, 1, 0); PG8_STAGE(PG8_SA(0, 1), a2, vc10, vc11);
            PG8_WAIT_L(8); PG8_BAR; PG8_WAIT_L(0); PG8_MMA(0, 0, At, B0); PG8_BAR; PG8_SCHED;
            PG8_LDB(B1, 1, 1); PG8_STAGE_B(PG8_SB(1, 0), b3);
            PG8_BAR; PG8_WAIT_L(0); PG8_MMA(0, 1, At, B1); PG8_BAR;
            PG8_LDA(At, 1, 1); PG8_STAGE(PG8_SA(1, 0), a3, vc00, vc01);
            PG8_BAR; PG8_WAIT_L(0); PG8_MMA(1, 0, At, B0); PG8_BAR; PG8_SCHED;
            PG8_STAGE_B(PG8_SB(1, 1), b3 + hstepB);
            PG8_WAIT_V(6); PG8_BAR; PG8_MMA(1, 1, At, B1); PG8_BAR;
        }
        E(acc, cur, wr, wc, fr, fq);
        if (!has_next) break;
#pragma unroll
        for (int a = 0; a < 2; ++a)
#pragma unroll
            for (int b = 0; b < 2; ++b)
#pragma unroll
                for (int m = 0; m < 4; ++m)
#pragma unroll
                    for (int n = 0; n < 2; ++n) acc[a][b][m][n] = (f32x4){0.f, 0.f, 0.f, 0.f};
        cur = nxt; cA = nA; ++ui;
    }
    PG8_WAIT_V(0);
    if (wr == 0) PG8_BAR;
    PG8_BAR;
#undef PG8_SA
#undef PG8_SB
#undef PG8_STAGE
#undef PG8_STAGE_B
#undef PG8_LDA
#undef PG8_LDB
#undef PG8_MMA
#undef PG8_WAIT_V
#undef PG8_WAIT_L
#undef PG8_BAR
#undef PG8_SCHED
#undef PG8_BPTR
#undef PG8_AOFFS
}
}

template <class CM>
__device__ __forceinline__ void transpose_item(const float* W, int ldw, int Ksrc, const float* rs, bf16_t* dst, int K, const CM& cm, float* scr, int kb, int nb, int lane) {
    const int k0 = 64 * kb, n0 = 32 * nb;
    const int col = cm(n0 + (lane & 31));
#pragma unroll 8
    for (int i = 0; i < 32; ++i) { const int kk = 2 * i + (lane >> 5), k = k0 + kk;
        float v = 0.f; if (col >= 0 && k < Ksrc) { v = W[(size_t)k * ldw + col]; if (rs) v *= rs[k]; }
        scr[kk * 33 + (lane & 31)] = v; }
    asm volatile("s_waitcnt lgkmcnt(0)" ::: "memory");
    const int c = lane & 7;
#pragma unroll
    for (int j = 0; j < 4; ++j) { const int n = (lane >> 3) + 8 * j; const float* sp = scr + (8 * c) * 33 + n;
        uint4 o; o.x = pg8::cvt_pk_bf16(sp[0 * 33], sp[1 * 33]); o.y = pg8::cvt_pk_bf16(sp[2 * 33], sp[3 * 33]); o.z = pg8::cvt_pk_bf16(sp[4 * 33], sp[5 * 33]); o.w = pg8::cvt_pk_bf16(sp[6 * 33], sp[7 * 33]);
        *(uint4*)(dst + (size_t)(n0 + n) * K + k0 + 8 * c) = o; }
    asm volatile("s_waitcnt lgkmcnt(0)" ::: "memory");
}
__device__ __forceinline__ int headperm64(int w) { const int gi = w >> 5, wp = w & 31; return (wp < 16) ? 16 * gi + wp : 32 + 16 * gi + (wp - 16); }
struct WinMap { __device__ __forceinline__ int operator()(int n) const {
    if (n < 416) return n;
    if (n < 512) return -1;
    if (n < 768) { const int h = (n - 512) >> 6; return Z_BQ + h * 64 + headperm64((n - 512) & 63); }
    if (n < 896) { const int h = (n - 768) >> 6; return Z_BK + h * 64 + headperm64((n - 768) & 63); }
    if (n < 1024) return Z_BV + (n - 896);
    if (n < 1280) return Z_DQ + (n - 1024);
    if (n < 1536) return Z_DK + (n - 1280);
    if (n < 1792) return Z_DV + (n - 1536);
    return Z_U + (n - 1792); } };
struct IdMap { int nvalid; __device__ __forceinline__ int operator()(int n) const { return n < nvalid ? n : -1; } };
struct GuMap { __device__ __forceinline__ int operator()(int n) const { const int q = n >> 8, c = n & 255, jj = c >> 3, t = c & 7, hid = 128 * q + 4 * jj + (t & 3); return (t < 4) ? hid : 512 + hid; } };

__device__ __forceinline__ void phase_convert(const Ctx& C, float* lds) {
    const int tid = opaque_tid(), lane = tid & 63, wave = tid >> 6;
    float* scr = lds + wave * (64 * 33);
    const int gw = blockIdx.x * NWAVES + wave, ngw = gridDim.x * NWAVES;
    constexpr int I_IN = 16 * 64, I_UQ = 4 * 16, I_UKV = 4 * 16, I_OUT = 16 * 32, I_GU = 16 * 16 * 32, I_DN = 16 * 8 * 32;
    constexpr int I_L = I_IN + I_UQ + I_UKV + I_OUT + I_GU + I_DN;
    for (int it = gw; it < DEPTH * I_L; it += ngw) {
        const int l = it / I_L; int r = it % I_L;
        if (r < I_IN) { transpose_item(C.w_in + (size_t)l * D * D_IN, D_IN, D, nullptr, C.WIN + (size_t)l * 2048 * 1024, 1024, WinMap{}, scr, r / 64, r % 64, lane); continue; } r -= I_IN;
        if (r < I_UQ) { transpose_item(C.w_uq + (size_t)l * 256 * 384, 384, 256, C.q_gain + l * 256, C.WUQ + (size_t)l * 512 * 256, 256, IdMap{384}, scr, r / 16, r % 16, lane); continue; } r -= I_UQ;
        if (r < I_UKV) { transpose_item(C.w_ukv + (size_t)l * 128 * 512, 512, 128, C.kv_gain + l * 128, C.WUKV + (size_t)l * 512 * 256, 256, IdMap{512}, scr, r / 16, r % 16, lane); continue; } r -= I_UKV;
        if (r < I_OUT) { transpose_item(C.w_out + (size_t)l * D * D, D, D, nullptr, C.WOUT + (size_t)l * 1024 * 1024, 1024, IdMap{1024}, scr, r / 32, r % 32, lane); continue; } r -= I_OUT;
        if (r < I_GU) { const int e = r / (16 * 32), q = r % (16 * 32);
            transpose_item(C.w_gu + ((size_t)l * 16 + e) * D * 1024, 1024, D, nullptr, C.WGU + ((size_t)l * 16 + e) * 1024 * 1024, 1024, GuMap{}, scr, q / 32, q % 32, lane); continue; } r -= I_GU;
        { const int e = r / (8 * 32), q = r % (8 * 32);
            transpose_item(C.w_down + ((size_t)l * 16 + e) * 512 * D, D, 512, nullptr, C.WDN + ((size_t)l * 16 + e) * 1024 * 512, 512, IdMap{1024}, scr, q / 32, q % 32, lane); }
    }
}

__device__ __forceinline__ void phase_ln0(const Ctx& C, int layer) {
    const int tid = opaque_tid(), lane = tid & 63, wave = tid >> 6;
    const int gw = blockIdx.x * NWAVES + wave, ngw = gridDim.x * NWAVES;
    const float4* g0 = (const float4*)(C.norm_g + ((size_t)layer * 4 + 0) * D);
    for (int r = gw; r < T; r += ngw) {
        const bool isctx = r >= TL; const int b = isctx ? (r - TL) / CTXL : r / SEQ;
        const float4* modp = (const float4*)(C.mod + ((size_t)layer * 17 + (isctx ? 16 : b)) * (NMOD * D));
        const float4* xr = (const float4*)xrow_in(C, layer, r);
        float4 v[4]; float ss = 0.f;
#pragma unroll
        for (int j = 0; j < 4; ++j) { v[j] = xr[lane + 64 * j]; ss += (v[j].x * v[j].x + v[j].y * v[j].y) + (v[j].z * v[j].z + v[j].w * v[j].w); }
        const float rstd = rsqrtf(wave_sum(ss) * (1.f / D) + EPS);
        uint2* o = (uint2*)(C.HX + (size_t)r * D);
#pragma unroll
        for (int j = 0; j < 4; ++j) { const float4 g = g0[lane + 64 * j], sh = modp[lane + 64 * j], sc = modp[256 + lane + 64 * j];
            uint2 w; w.x = pg8::cvt_pk_bf16((v[j].x * rstd * g.x) * (1.f + sc.x) + sh.x, (v[j].y * rstd * g.y) * (1.f + sc.y) + sh.y);
            w.y = pg8::cvt_pk_bf16((v[j].z * rstd * g.z) * (1.f + sc.z) + sh.z, (v[j].w * rstd * g.w) * (1.f + sc.w) + sh.w);
            o[lane + 64 * j] = w; }
    }
}

__device__ __forceinline__ void rope8(pg8::f32x4& v0, pg8::f32x4& v1, const float* tabrow, int fq) {
    const float4 c0 = *(const float4*)tabrow, c1 = *(const float4*)(tabrow + 4), s0 = *(const float4*)(tabrow + 64 * 24), s1 = *(const float4*)(tabrow + 64 * 24 + 4);
    const float cs[8] = {c0.x, c0.y, c0.z, c0.w, c1.x, c1.y, c1.z, c1.w}; const float sn[8] = {s0.x, s0.y, s0.z, s0.w, s1.x, s1.y, s1.z, s1.w};
    const float sg = (fq < 2) ? -1.f : 1.f;
#pragma unroll
    for (int e = 0; e < 8; ++e) {
        const float v = (e < 4) ? v0[e & 3] : v1[e & 3];
        const float pv = __shfl_xor(v, 32);
        const float o = v * cs[e] + pv * (sg * sn[e]);
        if (e < 4) v0[e & 3] = o; else v1[e & 3] = o;
    }
}
struct SchedInProj {
    int G, c, layer; const char* A; const char* W;
    __device__ __forceinline__ bool next(int i, pg8::GUnit& u) const { int pm, pn; if (!pg8::static_tile(i, G, c, T / 256, 8, pm, pn)) return false;
        u.pm = pm; u.pn = pn; u.A = A; u.B = W + (size_t)pn * 256 * 1024 * 2; u.B2 = u.B; u.x0 = 0; u.x1 = 0; return true; }
    __device__ __forceinline__ unsigned arow(const pg8::GUnit& u, int row) const { return (unsigned)(u.pm * 256 + row) * 2048u; }
};
struct EpiInProj {
    static constexpr bool PERM = true;
    bf16_t *CQ, *CKVR, *KA, *QB, *KB, *VB, *QC, *KC, *VC, *U; float *SSQ, *SSK;
    __device__ __forceinline__ void operator()(const pg8::f32x4 (&acc)[2][2][4][2], const pg8::GUnit& u, int wr, int wc, int fr, int fq) const {
        const int row0 = u.pm * 256 + wr * 64 + fr;
        if (u.pn <= 1) {
            float* SS = (u.pn == 0) ? SSQ : SSK;
#pragma unroll
            for (int ai = 0; ai < 2; ++ai)
#pragma unroll
                for (int m = 0; m < 4; ++m) {
                    float p = 0.f;
#pragma unroll
                    for (int bj = 0; bj < 2; ++bj) { if (bj == 1 && u.pn == 1) continue;
#pragma unroll
                        for (int n = 0; n < 2; ++n) { const pg8::f32x4 a = acc[ai][bj][m][n]; p += (a[0] * a[0] + a[1] * a[1]) + (a[2] * a[2] + a[3] * a[3]); } }
                    p += __shfl_xor(p, 16); p += __shfl_xor(p, 32);
                    if (fq == 0) SS[(size_t)(row0 + ai * 128 + m * 16) * 4 + wc] = p;
                }
        }
#pragma unroll
        for (int bj = 0; bj < 2; ++bj) {
            const int g = u.pn * 8 + bj * 4 + wc;
            bf16_t* dst; int pitch, col; int rope = 0  ; float scale = 1.f; bool zero = false;
            if (g < 8) { dst = CQ; pitch = 256; col = g * 32; }
            else if (g < 12) { dst = CKVR; pitch = 256; col = (g - 8) * 32; }
            else if (g < 16) { dst = CKVR; pitch = 256; col = (g - 8) * 32; zero = true; if (g == 12) rope = 1; }
            else if (g < 24) { dst = QB; pitch = 256; col = (g - 16) * 32; rope = 2 + (g & 1); scale = SC_B; }
            else if (g < 28) { dst = KB; pitch = 128; col = (g - 24) * 32; rope = 2 + (g & 1); }
            else if (g < 32) { dst = VB; pitch = 128; col = (g - 28) * 32; }
            else if (g < 40) { dst = QC; pitch = 256; col = (g - 32) * 32; rope = 1; scale = SC_C; }
            else if (g < 48) { dst = KC; pitch = 256; col = (g - 40) * 32; rope = 1; }
            else if (g < 56) { dst = VC; pitch = 256; col = (g - 48) * 32; }
            else { dst = U; pitch = 256; col = (g - 56) * 32; }
#pragma unroll
            for (int ai = 0; ai < 2; ++ai)
#pragma unroll
                for (int m = 0; m < 4; ++m) {
                    const int row = row0 + ai * 128 + m * 16;
                    pg8::f32x4 v0 = acc[ai][bj][m][0], v1 = acc[ai][bj][m][1];
                    if (rope) {
                        const int t = row & (SEQ - 1);
                        int p, f0;
                        if (rope == 1) { p = (fq & 1) ? (t & 63) : (t >> 6); f0 = 0; }
                        else { p = (rope == 3) ? (t & 63) : (t >> 6); f0 = 8 + 8 * (fq & 1); }
                        if (row >= TL) { p = 0; }
                        rope8(v0, v1, &g_rope.c[p][f0], fq);
                    }
                    if (g == 12) {
                        pg8::u32x4 w; w.x = pg8::cvt_pk_bf16(v0[0], v0[1]); w.y = pg8::cvt_pk_bf16(v0[2], v0[3]); w.z = pg8::cvt_pk_bf16(v1[0], v1[1]); w.w = pg8::cvt_pk_bf16(v1[2], v1[3]);
#pragma unroll
                        for (int h = 0; h < 4; ++h) *(pg8::u32x4*)(KA + (size_t)row * 384 + h * 96 + 64 + 8 * fq) = w;
                    }
                    if (zero) { v0 = (pg8::f32x4){0.f, 0.f, 0.f, 0.f}; v1 = v0; }
                    v0 = v0 * scale; v1 = v1 * scale;
                    pg8::u32x4 w; w.x = pg8::cvt_pk_bf16(v0[0], v0[1]); w.y = pg8::cvt_pk_bf16(v0[2], v0[3]); w.z = pg8::cvt_pk_bf16(v1[0], v1[1]); w.w = pg8::cvt_pk_bf16(v1[2], v1[3]);
                    *(pg8::u32x4*)(dst + (size_t)row * pitch + col + 8 * fq) = w;
                }
        }
    }
};

struct SchedMlaUp {
    int G, c, nQ  , nTot; const char *CQ, *CKVR, *WUQ, *WUKV;
    __device__ __forceinline__ bool next(int i, pg8::GUnit& u) const { const long L = (long)i * G + c; if (L >= nTot) return false;
        const int kind = (L >= nQ) ? 1 : 0, tl = (int)L - kind * nQ; u.pm = tl >> 1; u.pn = tl & 1; u.x0 = kind; u.x1 = 0;
        u.A = kind ? CKVR : CQ; u.B = (kind ? WUKV : WUQ) + (size_t)u.pn * 256 * 256 * 2; u.B2 = u.B; return true; }
    __device__ __forceinline__ unsigned arow(const pg8::GUnit& u, int row) const { return (unsigned)(u.pm * 256 + row) * 512u; }
};
struct EpiMlaUp {
    static constexpr bool PERM = true;
    bf16_t *QA, *KA, *VA; const float *SSQ, *SSK;
    __device__ __forceinline__ void operator()(const pg8::f32x4 (&acc)[2][2][4][2], const pg8::GUnit& u, int wr, int wc, int fr, int fq) const {
        const int row0 = u.pm * 256 + wr * 64 + fr; const bool kv = u.x0 != 0;
        const float* SS = kv ? SSK : SSQ; const float inv_n = kv ? (1.f / 128) : (1.f / 256);
#pragma unroll
        for (int bj = 0; bj < 2; ++bj) {
            const int g = u.pn * 8 + bj * 4 + wc;
            bf16_t* dst; int pitch, col; bool rope = false; float scale = 1.f;
            if (!kv) { if (g >= 12) continue; const int h = g / 3, part = g % 3; dst = QA; pitch = 384; col = h * 96 + part * 32; rope = (part == 2); scale = SC_A; }
            else { const int h = g >> 2, part = g & 3; if (part < 2) { dst = KA; pitch = 384; col = h * 96 + part * 32; } else { dst = VA; pitch = 256; col = h * 64 + (part - 2) * 32; } }
#pragma unroll
            for (int ai = 0; ai < 2; ++ai)
#pragma unroll
                for (int m = 0; m < 4; ++m) {
                    const int row = row0 + ai * 128 + m * 16; const float4 pp = *(const float4*)(SS + (size_t)row * 4);
                    const float rs = rsqrtf(((pp.x + pp.y) + (pp.z + pp.w)) * inv_n + EPS) * scale;
                    pg8::f32x4 v0 = acc[ai][bj][m][0] * rs, v1 = acc[ai][bj][m][1] * rs;
                    if (rope) { const int t = row & (SEQ - 1); int p = (fq & 1) ? (t & 63) : (t >> 6); if (row >= TL) p = 0; rope8(v0, v1, &g_rope.c[p][0], fq); }
                    pg8::u32x4 w; w.x = pg8::cvt_pk_bf16(v0[0], v0[1]); w.y = pg8::cvt_pk_bf16(v0[2], v0[3]); w.z = pg8::cvt_pk_bf16(v1[0], v1[1]); w.w = pg8::cvt_pk_bf16(v1[2], v1[3]);
                    *(pg8::u32x4*)(dst + (size_t)row * pitch + col + 8 * fq) = w;
                }
        }
    }
};

namespace att {
typedef short bf16x8 __attribute__((ext_vector_type(8)));
typedef short s16x4 __attribute__((ext_vector_type(4)));
typedef float f32x16 __attribute__((ext_vector_type(16)));
typedef unsigned u32x4 __attribute__((ext_vector_type(4)));
constexpr int L_K = 0, KBUF = 12288, L_V = 2 * KBUF, VBUF = 8192, L_WS = L_V + 2 * VBUF, L_OST = L_WS + 2048, OST_W = 8704, L_END = L_OST + 8 * OST_W;
static_assert(L_END <= 131072, "attention LDS");
constexpr float NEG_BIG = -1.0e30f;
__device__ __forceinline__ int crow(int r, int hi) { return (r & 3) + 8 * (r >> 2) + 4 * hi; }
__device__ __forceinline__ s16x4 vtr(LAS const char* p) { typedef short v4i16_t __attribute__((ext_vector_type(4))); return __builtin_bit_cast(s16x4, __builtin_amdgcn_ds_read_tr16_b64_v4i16((LAS v4i16_t*)p)); }
__device__ __forceinline__ float xhalf_max(float v) { auto rr = __builtin_amdgcn_permlane32_swap(__float_as_uint(v), __float_as_uint(v), false, false); return fmaxf(__uint_as_float(rr[0]), __uint_as_float(rr[1])); }
__device__ __forceinline__ float xhalf_sum(float v) { auto rr = __builtin_amdgcn_permlane32_swap(__float_as_uint(v), __float_as_uint(v), false, false); return __uint_as_float(rr[0]) + __uint_as_float(rr[1]); }

struct Unit {
    const bf16_t *Q, *K, *V;
    int qpitch, kpitch, vpitch;
    int qrow0, qpos0;
    int ctxrow0;
    int latrow0, latpos0, nlat;
    int window;
    bf16_t* O;
    float sink2;
    float lam, postmul; const float* subln;
};
template <int NSTEP  , int NCOMP, int MODE>
__device__ __forceinline__ void attn_unit(const Unit& U, LAS char* lds) {
    constexpr int NCH = 2 * NSTEP * NCOMP;
    const int tid = opaque_tid(), lane = tid & 63, r32 = lane & 31, hi = lane >> 5; const int wid = __builtin_amdgcn_readfirstlane(tid >> 6);
    LAS float* wsf = (LAS float*)(lds + L_WS) + wid * 64;
    bf16x8 qf[NCOMP][NSTEP];
    { const bf16_t* qp = U.Q + (size_t)(U.qrow0 + wid * 32 + r32) * U.qpitch + hi * 8;
#pragma unroll
      for (int c = 0; c < NCOMP; ++c)
#pragma unroll
        for (int d0 = 0; d0 < NSTEP; ++d0) qf[c][d0] = *(const bf16x8*)(qp + c * NSTEP * 16 + d0 * 16); }
    float mrow[NCOMP], lrow[NCOMP]; f32x16 o[NCOMP][2];
#pragma unroll
    for (int c = 0; c < NCOMP; ++c) { mrow[c] = NEG_BIG; lrow[c] = 0.f; o[c][0] = f32x16{}; o[c][1] = f32x16{}; }
    const int NT = 4 + U.nlat;
    constexpr int KPT = (NCH * 64 + NTHREADS - 1) / NTHREADS;
    u32x4 kreg[KPT], vreg;
    const int vkey = tid >> 3, vch = tid & 7;
    const int vdst = ((vch >> 2) * 4 + (vkey >> 4)) * 1024 + (vkey & 15) * 64 + (vch & 3) * 16;
#define ATT_ROW0(t) (((t) < 4) ? U.ctxrow0 + 64 * (t) : U.latrow0 + 64 * ((t) - 4))
#define ATT_LOAD(t) do { const int row0_ = ATT_ROW0(t); \
        _Pragma("unroll") for (int i_ = 0; i_ < KPT; ++i_) { const int pi_ = tid + NTHREADS * i_; if (pi_ < NCH * 64) kreg[i_] = *(const u32x4*)(U.K + (size_t)(row0_ + (pi_ & 63)) * U.kpitch + (pi_ >> 6) * 8); } \
        vreg = *(const u32x4*)(U.V + (size_t)(row0_ + vkey) * U.vpitch + vch * 8); } while (0)
#define ATT_WRITE(buf) do { \
        _Pragma("unroll") for (int i_ = 0; i_ < KPT; ++i_) { const int pi_ = tid + NTHREADS * i_; if (pi_ < NCH * 64) *(LAS u32x4*)(lds + L_K + (buf) * KBUF + (pi_ >> 6) * 1024 + (pi_ & 63) * 16) = kreg[i_]; } \
        *(LAS u32x4*)(lds + L_V + (buf) * VBUF + vdst) = vreg; } while (0)
    ATT_LOAD(0); ATT_WRITE(0);
    __syncthreads();
    const int qpos = U.qpos0 + wid * 32 + r32;
#pragma unroll 1
    for (int t = 0; t < NT; ++t) {
        const int buf = t & 1;
        if (t + 1 < NT) ATT_LOAD(t + 1);
        bool skip = false; int kpos0 = 0;
        if (MODE == 1 && t >= 4) { kpos0 = U.latpos0 + 64 * (t - 4); const int qw = U.qpos0 + wid * 32; skip = (kpos0 + 63 < qw - U.window) || (kpos0 > qw + 31 + U.window); }
        if (!skip) {
            LAS const char* kb = lds + L_K + buf * KBUF + hi * 1024 + r32 * 16;
            LAS const char* vp = lds + L_V + buf * VBUF + ((lane >> 4) & 1) * 32 + (lane & 3) * 8 + (4 * hi + ((lane & 15) >> 2)) * 64;
            bf16x8 pa[NCOMP][4];
#pragma unroll
            for (int c = 0; c < NCOMP; ++c) {
                f32x16 p0 = f32x16{}, p1 = f32x16{};
#pragma unroll
                for (int d0 = 0; d0 < NSTEP; ++d0) {
                    const bf16x8 b0 = *(LAS const bf16x8*)(kb + (c * 2 * NSTEP + 2 * d0) * 1024);
                    const bf16x8 b1 = *(LAS const bf16x8*)(kb + (c * 2 * NSTEP + 2 * d0) * 1024 + 512);
                    p0 = __builtin_amdgcn_mfma_f32_32x32x16_bf16(b0, qf[c][d0], p0, 0, 0, 0);
                    p1 = __builtin_amdgcn_mfma_f32_32x32x16_bf16(b1, qf[c][d0], p1, 0, 0, 0);
                }
                if (MODE == 1 && t >= 4) {
#pragma unroll
                    for (int r = 0; r < 16; ++r) { const int rel0 = kpos0 + crow(r, hi) - qpos;
                        if (rel0 > U.window || rel0 < -U.window) p0[r] = NEG_BIG;
                        if (rel0 + 32 > U.window || rel0 + 32 < -U.window) p1[r] = NEG_BIG; }
                }
                float mx = fmaxf(p0[0], p1[0]);
#pragma unroll
                for (int r = 1; r < 16; ++r) mx = fmaxf(mx, fmaxf(p0[r], p1[r]));
                mx = xhalf_max(mx);
                const float mnew = fmaxf(mrow[c], mx);
                const float alpha = __builtin_amdgcn_exp2f(mrow[c] - mnew);
                mrow[c] = mnew;
                float rs = 0.f;
#pragma unroll
                for (int r = 0; r < 16; ++r) { p0[r] = __builtin_amdgcn_exp2f(p0[r] - mnew); p1[r] = __builtin_amdgcn_exp2f(p1[r] - mnew); rs += p0[r] + p1[r]; }
                rs = xhalf_sum(rs);
                lrow[c] = lrow[c] * alpha + rs;
                if (hi == 0) wsf[c * 32 + r32] = alpha;
                u32x4 w0, w1, w2, w3;
                w0 = (u32x4){pg8::cvt_pk_bf16(p0[0], p0[1]), pg8::cvt_pk_bf16(p0[2], p0[3]), pg8::cvt_pk_bf16(p0[4], p0[5]), pg8::cvt_pk_bf16(p0[6], p0[7])};
                w1 = (u32x4){pg8::cvt_pk_bf16(p0[8], p0[9]), pg8::cvt_pk_bf16(p0[10], p0[11]), pg8::cvt_pk_bf16(p0[12], p0[13]), pg8::cvt_pk_bf16(p0[14], p0[15])};
                w2 = (u32x4){pg8::cvt_pk_bf16(p1[0], p1[1]), pg8::cvt_pk_bf16(p1[2], p1[3]), pg8::cvt_pk_bf16(p1[4], p1[5]), pg8::cvt_pk_bf16(p1[6], p1[7])};
                w3 = (u32x4){pg8::cvt_pk_bf16(p1[8], p1[9]), pg8::cvt_pk_bf16(p1[10], p1[11]), pg8::cvt_pk_bf16(p1[12], p1[13]), pg8::cvt_pk_bf16(p1[14], p1[15])};
                pa[c][0] = __builtin_bit_cast(bf16x8, w0); pa[c][1] = __builtin_bit_cast(bf16x8, w1); pa[c][2] = __builtin_bit_cast(bf16x8, w2); pa[c][3] = __builtin_bit_cast(bf16x8, w3);
            }
#pragma unroll
            for (int c = 0; c < NCOMP; ++c) {
#pragma unroll
                for (int g4 = 0; g4 < 4; ++g4) { const pg8::f32x4 a4 = *(LAS const pg8::f32x4*)(wsf + c * 32 + 8 * g4 + 4 * hi);
                    o[c][0][4 * g4 + 0] *= a4.x; o[c][0][4 * g4 + 1] *= a4.y; o[c][0][4 * g4 + 2] *= a4.z; o[c][0][4 * g4 + 3] *= a4.w;
                    o[c][1][4 * g4 + 0] *= a4.x; o[c][1][4 * g4 + 1] *= a4.y; o[c][1][4 * g4 + 2] *= a4.z; o[c][1][4 * g4 + 3] *= a4.w; }
            }
#pragma unroll
            for (int d0 = 0; d0 < 2; ++d0)
#pragma unroll
                for (int ks = 0; ks < 4; ++ks) {
                    const s16x4 vlo = vtr(vp + d0 * 4096 + ks * 1024), vhi = vtr(vp + d0 * 4096 + ks * 1024 + 512);
                    const bf16x8 vb = (bf16x8){vlo[0], vlo[1], vlo[2], vlo[3], vhi[0], vhi[1], vhi[2], vhi[3]};
#pragma unroll
                    for (int c = 0; c < NCOMP; ++c) o[c][d0] = __builtin_amdgcn_mfma_f32_32x32x16_bf16(pa[c][ks], vb, o[c][d0], 0, 0, 0);
                }
        }
        if (t + 1 < NT) ATT_WRITE(buf ^ 1);
        __syncthreads();
    }
#undef ATT_ROW0
#undef ATT_LOAD
#undef ATT_WRITE
    float fac[NCOMP];
#pragma unroll
    for (int c = 0; c < NCOMP; ++c) {
        if (MODE == 1) { const float mm = fmaxf(mrow[c], U.sink2); const float f = __builtin_amdgcn_exp2f(mrow[c] - mm); fac[c] = f / (lrow[c] * f + __builtin_amdgcn_exp2f(U.sink2 - mm)); }
        else fac[c] = 1.f / lrow[c];
        if (MODE == 2 && c == 1) fac[c] *= -U.lam;
        if (hi == 0) wsf[c * 32 + r32] = fac[c];
    }
    LAS float* stg = (LAS float*)(lds + L_OST + wid * OST_W);
#pragma unroll
    for (int g4 = 0; g4 < 4; ++g4) {
        const pg8::f32x4 f0 = *(LAS const pg8::f32x4*)(wsf + 8 * g4 + 4 * hi);
        pg8::f32x4 f1 = f0; if (NCOMP == 2) f1 = *(LAS const pg8::f32x4*)(wsf + 32 + 8 * g4 + 4 * hi);
        const float ff0[4] = {f0.x, f0.y, f0.z, f0.w}, ff1[4] = {f1.x, f1.y, f1.z, f1.w};
#pragma unroll
        for (int j = 0; j < 4; ++j) { const int r = 4 * g4 + j, orow = crow(r, hi);
#pragma unroll
            for (int d0 = 0; d0 < 2; ++d0) { float v = o[0][d0][r] * ff0[j]; if (NCOMP == 2) v += o[NCOMP - 1][d0][r] * ff1[j]; stg[orow * 68 + d0 * 32 + r32] = v; } }
    }
    { const int row = lane >> 1, half = lane & 1; float v[32];
#pragma unroll
      for (int k = 0; k < 8; ++k) { const pg8::f32x4 x = *(LAS const pg8::f32x4*)(stg + row * 68 + half * 32 + 4 * k); v[4 * k] = x.x; v[4 * k + 1] = x.y; v[4 * k + 2] = x.z; v[4 * k + 3] = x.w; }
      if (MODE == 2) { float ss = 0.f;
#pragma unroll
          for (int k = 0; k < 32; ++k) ss += v[k] * v[k];
          ss += __shfl_xor(ss, 1);
          const float rstd = rsqrtf(ss * (1.f / 64) + EPS) * U.postmul;
#pragma unroll
          for (int k = 0; k < 32; ++k) v[k] = v[k] * rstd * U.subln[half * 32 + k]; }
      bf16_t* op = U.O + (size_t)(U.qrow0 + wid * 32 + row) * 1024 + half * 32;
#pragma unroll
      for (int k = 0; k < 4; ++k) { u32x4 w; w.x = pg8::cvt_pk_bf16(v[8 * k], v[8 * k + 1]); w.y = pg8::cvt_pk_bf16(v[8 * k + 2], v[8 * k + 3]); w.z = pg8::cvt_pk_bf16(v[8 * k + 4], v[8 * k + 5]); w.w = pg8::cvt_pk_bf16(v[8 * k + 6], v[8 * k + 7]);
          *(u32x4*)(op + 8 * k) = w; } }
    __syncthreads();
}
}

__device__ __forceinline__ void phase_attn(const Ctx& C, int layer, LAS char* lds) {
    const int G = gridDim.x, bx = blockIdx.x;
    const int vcu = (G % 8 == 0) ? (bx % 8) * (G / 8) + bx / 8 : bx;
    float lam;
    { const float* dl = C.dlam + (size_t)layer * 128; float s1 = 0.f, s2 = 0.f; for (int i = 0; i < 32; ++i) { s1 += dl[i] * dl[32 + i]; s2 += dl[64 + i] * dl[96 + i]; }
      lam = expf(s1) - expf(s2) + lam_init_of(layer); }
    const bool has_ctx_q = layer < DEPTH - 1;
    const int NLAT = BATCH * 4 * (SEQ / 256);
    const int NCTXU = has_ctx_q ? BATCH * 4 : 0;
    const int ntot = 3 * NLAT + 3 * NCTXU;
#pragma unroll 1
    for (int uidx = vcu; uidx < ntot; uidx += G) {
        int kind, b, h, qb; bool cq;
        if (uidx < 3 * NLAT) { kind = uidx / NLAT; const int r = uidx % NLAT; b = r / 32; h = (r / 8) & 3; qb = r & 7; cq = false; }
        else { const int r2 = uidx - 3 * NLAT; kind = r2 / NCTXU; const int r = r2 % NCTXU; b = r >> 2; h = r & 3; qb = 0; cq = true; }
        att::Unit U;
        U.qrow0 = cq ? TL + b * CTXL : b * SEQ + qb * 256; U.qpos0 = cq ? 0 : qb * 256; U.ctxrow0 = TL + b * CTXL;
        U.latrow0 = b * SEQ; U.latpos0 = 0; U.nlat = cq ? 0 : SEQ / 64; U.window = -1; U.sink2 = 0.f; U.lam = 0.f; U.postmul = 1.f; U.subln = nullptr;
        if (kind == 0) {
            U.Q = C.QC + h * 64; U.K = C.KC + h * 64; U.V = C.VC + h * 64; U.qpitch = 256; U.kpitch = 256; U.vpitch = 256; U.O = C.O + 512 + h * 64;
            U.lam = lam; U.postmul = 1.f - lam_init_of(layer); U.subln = C.subln + layer * 64;
            att::attn_unit<2, 2, 2>(U, lds);
        } else if (kind == 1) {
            U.Q = C.QA + h * 96; U.K = C.KA + h * 96; U.V = C.VA + h * 64; U.qpitch = 384; U.kpitch = 384; U.vpitch = 256; U.O = C.O + h * 64;
            att::attn_unit<6, 1, 0>(U, lds);
        } else {
            const int kvh = h >> 1;
            U.Q = C.QB + h * 64; U.K = C.KB + kvh * 64; U.V = C.VB + kvh * 64; U.qpitch = 256; U.kpitch = 128; U.vpitch = 128; U.O = C.O + 256 + h * 64;
            U.sink2 = C.sink[layer * 4 + h] * LOG2E;
            if (!cq) { U.window = 128; const int p0 = max(qb * 256 - 128, 0), p1 = min(qb * 256 + 256 + 128, SEQ); U.latpos0 = p0; U.latrow0 = b * SEQ + p0; U.nlat = (p1 - p0) / 64; }
            att::attn_unit<4, 1, 1>(U, lds);
        }
    }
    {
        const int tid = opaque_tid(), lane = tid & 63, wave = tid >> 6;
        const int gw = blockIdx.x * NWAVES + wave, ngw = gridDim.x * NWAVES;
        const int nrows = has_ctx_q ? T : TL;
        for (long it = gw; it < (long)nrows * 4; it += ngw) {
            const int r = (int)(it >> 2), g = (int)(it & 3);
            const bool isctx = r >= TL; const int t = isctx ? (r - TL) % CTXL : r % SEQ;
            const int w = 2 << g, half = w >> 1, L = isctx ? CTXL : SEQ;
            const size_t rbase = (size_t)r - t;
            const int lo = max(t - half, 0), hi = min(t - half + w, L);
            float s = 0.f;
            for (int p = lo; p < hi; ++p) s += bf2f(C.U[(rbase + p) * 256 + g * 64 + lane]);
            const float dg = s / (float)(hi - lo) - bf2f(C.U[(size_t)r * 256 + g * 64 + lane]);
            const float* pw = C.pool_w + ((size_t)layer * 4 + g) * 64 * 64;
            float y = 0.f;
#pragma unroll 8
            for (int c = 0; c < 64; ++c) y += __shfl(dg, c) * pw[c * 64 + lane];
            C.O[(size_t)r * D + 768 + g * 64 + lane] = f2bf(y * C.pool_scale[layer * 256 + g * 64 + lane]);
        }
    }
}

struct SchedRows {
    int G, c, nM, nN; const char* A; const char* W; unsigned lda2  ; size_t wtile  ;
    __device__ __forceinline__ bool next(int i, pg8::GUnit& u) const { int pm, pn; if (!pg8::static_tile(i, G, c, nM, nN, pm, pn)) return false;
        u.pm = pm; u.pn = pn; u.A = A; u.B = W + (size_t)pn * wtile; u.B2 = u.B; u.x0 = 0; u.x1 = 256; return true; }
    __device__ __forceinline__ unsigned arow(const pg8::GUnit& u, int row) const { return (unsigned)(u.pm * 256 + row) * lda2; }
};
struct EpiRowsSS {
    static constexpr bool PERM = true;
    bf16_t* OUT; float* SS;
    __device__ __forceinline__ void operator()(const pg8::f32x4 (&acc)[2][2][4][2], const pg8::GUnit& u, int wr, int wc, int fr, int fq) const {
        const int row0 = u.pm * 256 + wr * 64 + fr;
#pragma unroll
        for (int ai = 0; ai < 2; ++ai)
#pragma unroll
            for (int m = 0; m < 4; ++m) {
                const int row = row0 + ai * 128 + m * 16; float p = 0.f;
#pragma unroll
                for (int bj = 0; bj < 2; ++bj) {
                    const pg8::f32x4 v0 = acc[ai][bj][m][0], v1 = acc[ai][bj][m][1];
                    p += ((v0[0] * v0[0] + v0[1] * v0[1]) + (v0[2] * v0[2] + v0[3] * v0[3])) + ((v1[0] * v1[0] + v1[1] * v1[1]) + (v1[2] * v1[2] + v1[3] * v1[3]));
                    pg8::u32x4 w; w.x = pg8::cvt_pk_bf16(v0[0], v0[1]); w.y = pg8::cvt_pk_bf16(v0[2], v0[3]); w.z = pg8::cvt_pk_bf16(v1[0], v1[1]); w.w = pg8::cvt_pk_bf16(v1[2], v1[3]);
                    *(pg8::u32x4*)(OUT + (size_t)row * 1024 + u.pn * 256 + bj * 128 + wc * 32 + 8 * fq) = w;
                }
                p += __shfl_xor(p, 16); p += __shfl_xor(p, 32);
                if (fq == 0) SS[(size_t)row * 16 + u.pn * 4 + wc] = p;
            }
    }
};

__device__ __forceinline__ float sum16(const float* p) { const float4 a = *(const float4*)p, b = *(const float4*)(p + 4), c = *(const float4*)(p + 8), d = *(const float4*)(p + 12);
    return (((a.x + a.y) + (a.z + a.w)) + ((b.x + b.y) + (b.z + b.w))) + (((c.x + c.y) + (c.z + c.w)) + ((d.x + d.y) + (d.z + d.w))); }
__device__ __forceinline__ void phase_router(const Ctx& C, int layer, float* lds) {
    const int tid = opaque_tid(), lane = tid & 63, wave = tid >> 6;
    float* RW = lds;
    for (int i = tid; i < 20 * 1024; i += NTHREADS) { const int q = i >> 10, k = i & 1023;
        RW[i] = (q < 4) ? C.r_gw[(size_t)layer * D * 4 + k * 4 + q] : C.r_ew[(size_t)layer * D * 16 + k * 16 + (q - 4)]; }
    __syncthreads();
    const int gw = blockIdx.x * NWAVES + wave, ngw = gridDim.x * NWAVES;
    const float4* g1 = (const float4*)(C.norm_g + ((size_t)layer * 4 + 1) * D);
    const float4* g2 = (const float4*)(C.norm_g + ((size_t)layer * 4 + 2) * D);
    const int nrows = (layer == DEPTH - 1) ? TL : T;
    for (int r = gw; r < nrows; r += ngw) {
        const bool isctx = r >= TL; const int b = isctx ? (r - TL) / CTXL : r / SEQ;
        const float4* modp = (const float4*)(C.mod + ((size_t)layer * 17 + (isctx ? 16 : b)) * (NMOD * D));
        const float rstd1 = rsqrtf(sum16(C.SS1 + (size_t)r * 16) * (1.f / D) + EPS);
        const float4* xr = (const float4*)xrow_in(C, layer, r); float4* xo = (float4*)xrow_out(C, r);
        const uint2* oxr = (const uint2*)(C.OX + (size_t)r * D);
        float4 xa[4]; float ss = 0.f;
#pragma unroll
        for (int j = 0; j < 4; ++j) { const int ci = lane + 64 * j; const uint2 ow = oxr[ci]; const float4 g = g1[ci], gt = modp[2 * 256 + ci], xv = xr[ci];
            xa[j].x = xv.x + gt.x * (__uint_as_float(ow.x << 16) * rstd1 * g.x); xa[j].y = xv.y + gt.y * (__uint_as_float(ow.x & 0xffff0000u) * rstd1 * g.y);
            xa[j].z = xv.z + gt.z * (__uint_as_float(ow.y << 16) * rstd1 * g.z); xa[j].w = xv.w + gt.w * (__uint_as_float(ow.y & 0xffff0000u) * rstd1 * g.w);
            xo[ci] = xa[j]; ss += (xa[j].x * xa[j].x + xa[j].y * xa[j].y) + (xa[j].z * xa[j].z + xa[j].w * xa[j].w); }
        const float rstd2 = rsqrtf(wave_sum(ss) * (1.f / D) + EPS);
        uint2* hmr = (uint2*)(C.HM + (size_t)r * D);
#pragma unroll
        for (int j = 0; j < 4; ++j) { const int ci = lane + 64 * j; const float4 g = g2[ci], sh = modp[3 * 256 + ci], sc = modp[4 * 256 + ci];
            xa[j].x = (xa[j].x * rstd2 * g.x) * (1.f + sc.x) + sh.x; xa[j].y = (xa[j].y * rstd2 * g.y) * (1.f + sc.y) + sh.y;
            xa[j].z = (xa[j].z * rstd2 * g.z) * (1.f + sc.z) + sh.z; xa[j].w = (xa[j].w * rstd2 * g.w) * (1.f + sc.w) + sh.w;
            uint2 w; w.x = pg8::cvt_pk_bf16(xa[j].x, xa[j].y); w.y = pg8::cvt_pk_bf16(xa[j].z, xa[j].w); hmr[ci] = w; }
        float lg[20];
#pragma unroll
        for (int q = 0; q < 20; ++q) { float p = 0.f;
#pragma unroll
            for (int j = 0; j < 4; ++j) { const float4 w = *(const float4*)(RW + q * 1024 + 4 * (lane + 64 * j)); p += (xa[j].x * w.x + xa[j].y * w.y) + (xa[j].z * w.z + xa[j].w * w.w); }
            lg[q] = wave_sum(p) + ((q < 4) ? C.r_gb[layer * 4 + q] : C.r_eb[layer * 16 + (q - 4)]); }
        int gsel = 0; float gmax = lg[0];
#pragma unroll
        for (int i = 1; i < 4; ++i) if (lg[i] > gmax) { gmax = lg[i]; gsel = i; }
        float gs = 0.f;
#pragma unroll
        for (int i = 0; i < 4; ++i) gs += __expf(lg[i] - gmax);
        const float pg = 1.f / gs;
        float el[4];
#pragma unroll
        for (int i = 0; i < 4; ++i) el[i] = (gsel == 0) ? lg[4 + i] : (gsel == 1) ? lg[8 + i] : (gsel == 2) ? lg[12 + i] : lg[16 + i];
        int i1 = 0; float v1 = el[0];
#pragma unroll
        for (int i = 1; i < 4; ++i) if (el[i] > v1) { v1 = el[i]; i1 = i; }
        int i2 = -1; float v2 = -INFINITY;
#pragma unroll
        for (int i = 0; i < 4; ++i) if (i != i1 && el[i] > v2) { v2 = el[i]; i2 = i; }
        const float e2 = __expf(v2 - v1); const float w1 = pg / (1.f + e2), w2 = pg * e2 / (1.f + e2);
        const int elo = min(i1, i2), ehi = max(i1, i2);
        const int pair = (elo == 0) ? (ehi - 1) : (elo == 1) ? (ehi + 1) : 5;
        const int cls = gsel * 6 + pair;
        if (lane == 0) {
            const unsigned slot = atomicAdd(C.CNT + layer * 32 + cls, 1u);
            C.LIST[(size_t)cls * T + slot] = r;
            *(float2*)(C.TOKW + (size_t)r * 2) = make_float2(i1 < i2 ? w1 : w2, i1 < i2 ? w2 : w1);
        }
    }
}

constexpr int MOE_LDS = 131072, MOE_MAXU = 8;
struct MoeSched {
    int G, c, npn, layer, mode  ; const char *A, *W; LAS const int* meta  ; LAS const int* tab  ;
    __device__ __forceinline__ bool next(int i, pg8::GUnit& u) const {
        const int ntiles = meta[32 + 24]; const long L = (long)i * G + c; if (i >= MOE_MAXU || L >= (long)ntiles * npn) return false;
        const int tile = (int)(L / npn), pn = (int)(L % npn);
        int cls = 0;
#pragma unroll 1
        for (int k = 1; k < 24; ++k) if (tile >= meta[32 + k]) cls = k;
        const int tin = tile - meta[32 + cls], cnt = meta[cls];
        const int g = cls / 6, pr = cls % 6; const int elo = (pr < 3) ? 0 : (pr < 5) ? 1 : 2, ehi = (pr < 3) ? pr + 1 : (pr < 5) ? pr - 1 : 3;
        u.pm = tile; u.pn = pn; u.x0 = i; u.x1 = min(256, cnt - tin * 256); u.A = A;
        if (mode == 0) { const int e = g * 4 + ((pn < 4) ? elo : ehi); u.B = W + (((size_t)layer * 16 + e) * 1024 + (size_t)(pn & 3) * 256) * 1024 * 2; u.B2 = u.B; }
        else { u.B = W + (((size_t)layer * 16 + g * 4 + elo) * 1024 + (size_t)pn * 256) * 512 * 2; u.B2 = W + (((size_t)layer * 16 + g * 4 + ehi) * 1024 + (size_t)pn * 256) * 512 * 2; }
        return true;
    }
    __device__ __forceinline__ unsigned arow(const pg8::GUnit& u, int row) const { return (mode == 0) ? (unsigned)tab[u.x0 * 256 + row] * 2048u : (unsigned)(u.pm * 256 + row) * 2048u; }
};
__device__ __forceinline__ void moe_setup(const Ctx& C, int layer, int npn, LAS int* meta, LAS int* tab) {
    const int tid = opaque_tid();
    if (tid < 24) meta[tid] = (int)__hip_atomic_load(C.CNT + layer * 32 + tid, __ATOMIC_RELAXED, __HIP_MEMORY_SCOPE_AGENT);
    __syncthreads();
    if (tid == 0) { int acc = 0; for (int k = 0; k < 24; ++k) { meta[32 + k] = acc; acc += (meta[k] + 255) >> 8; } meta[32 + 24] = acc; }
    __syncthreads();
    const int ntiles = meta[32 + 24];
    for (int i = 0; i < MOE_MAXU; ++i) {
        const long L = (long)i * gridDim.x + blockIdx.x; if (L >= (long)ntiles * npn) break;
        const int tile = (int)(L / npn); int cls = 0;
        for (int k = 1; k < 24; ++k) if (tile >= meta[32 + k]) cls = k;
        const int tin = tile - meta[32 + cls], cnt = meta[cls];
        if (tid < 256) { const int slot = tin * 256 + tid; tab[i * 256 + tid] = C.LIST[(size_t)cls * T + (slot < cnt ? slot : 0)]; }
    }
    __syncthreads();
}
__device__ __forceinline__ float silu_fast(float v) { return v * __builtin_amdgcn_rcpf(1.f + __expf(-v)); }
struct EpiMoeUp {
    static constexpr bool PERM = true;
    bf16_t* ACT; const float* TOKW; LAS const int* tab;
    __device__ __forceinline__ void operator()(const pg8::f32x4 (&acc)[2][2][4][2], const pg8::GUnit& u, int wr, int wc, int fr, int fq) const {
        const int hi = (u.pn >= 4) ? 1 : 0;
#pragma unroll
        for (int ai = 0; ai < 2; ++ai)
#pragma unroll
            for (int m = 0; m < 4; ++m) {
                const int rt = ai * 128 + wr * 64 + m * 16 + fr;
                if (rt < u.x1) {
                    const int token = tab[u.x0 * 256 + rt]; const float w = TOKW[(size_t)token * 2 + hi];
#pragma unroll
                    for (int bj = 0; bj < 2; ++bj) {
                        const pg8::f32x4 gt = acc[ai][bj][m][0], up = acc[ai][bj][m][1];
                        pg8::u32x2 o; o.x = pg8::cvt_pk_bf16(silu_fast(gt[0]) * up[0] * w, silu_fast(gt[1]) * up[1] * w); o.y = pg8::cvt_pk_bf16(silu_fast(gt[2]) * up[2] * w, silu_fast(gt[3]) * up[3] * w);
                        *(pg8::u32x2*)(ACT + (size_t)(u.pm * 256 + rt) * 1024 + hi * 512 + (u.pn & 3) * 128 + 4 * (16 * bj + 4 * wc + fq)) = o;
                    }
                }
            }
    }
};
struct EpiMoeDown {
    static constexpr bool PERM = true;
    bf16_t* FX; float* SS; LAS const int* tab;
    __device__ __forceinline__ void operator()(const pg8::f32x4 (&acc)[2][2][4][2], const pg8::GUnit& u, int wr, int wc, int fr, int fq) const {
#pragma unroll
        for (int ai = 0; ai < 2; ++ai)
#pragma unroll
            for (int m = 0; m < 4; ++m) {
                const int rt = ai * 128 + wr * 64 + m * 16 + fr; const bool ok = rt < u.x1;
                const int token = tab[u.x0 * 256 + rt]; float p = 0.f;
#pragma unroll
                for (int bj = 0; bj < 2; ++bj) {
                    const pg8::f32x4 v0 = acc[ai][bj][m][0], v1 = acc[ai][bj][m][1];
                    p += ((v0[0] * v0[0] + v0[1] * v0[1]) + (v0[2] * v0[2] + v0[3] * v0[3])) + ((v1[0] * v1[0] + v1[1] * v1[1]) + (v1[2] * v1[2] + v1[3] * v1[3]));
                    pg8::u32x4 w; w.x = pg8::cvt_pk_bf16(v0[0], v0[1]); w.y = pg8::cvt_pk_bf16(v0[2], v0[3]); w.z = pg8::cvt_pk_bf16(v1[0], v1[1]); w.w = pg8::cvt_pk_bf16(v1[2], v1[3]);
                    if (ok) *(pg8::u32x4*)(FX + (size_t)token * 1024 + u.pn * 256 + bj * 128 + wc * 32 + 8 * fq) = w;
                }
                p += __shfl_xor(p, 16); p += __shfl_xor(p, 32);
                if (ok && fq == 0) SS[(size_t)token * 16 + u.pn * 4 + wc] = p;
            }
    }
};

__device__ __forceinline__ void phase_final(const Ctx& C, int layer) {
    const int tid = opaque_tid(), lane = tid & 63, wave = tid >> 6;
    const int gw = blockIdx.x * NWAVES + wave, ngw = gridDim.x * NWAVES;
    const float4* g3 = (const float4*)(C.norm_g + ((size_t)layer * 4 + 3) * D);
    const int nrows = (layer == DEPTH - 1) ? TL : T;
    for (int r = gw; r < nrows; r += ngw) {
        const bool isctx = r >= TL; const int b = isctx ? (r - TL) / CTXL : r / SEQ;
        const float4* modp = (const float4*)(C.mod + ((size_t)layer * 17 + (isctx ? 16 : b)) * (NMOD * D));
        const float rstd = rsqrtf(sum16(C.SS2 + (size_t)r * 16) * (1.f / D) + EPS);
        float4* xo = (float4*)xrow_out(C, r);
        const uint2* fxr = (const uint2*)(C.FX + (size_t)r * D);
#pragma unroll
        for (int j = 0; j < 4; ++j) { const int ci = lane + 64 * j; const uint2 fw = fxr[ci]; const float4 g = g3[ci], gt = modp[5 * 256 + ci]; float4 xv = xo[ci];
            xv.x += gt.x * (__uint_as_float(fw.x << 16) * rstd * g.x); xv.y += gt.y * (__uint_as_float(fw.x & 0xffff0000u) * rstd * g.y);
            xv.z += gt.z * (__uint_as_float(fw.y << 16) * rstd * g.z); xv.w += gt.w * (__uint_as_float(fw.y & 0xffff0000u) * rstd * g.w);
            xo[ci] = xv; }
    }
}

__device__ __forceinline__ Ctx make_ctx(const Args& a) {
    Ctx C;
    C.x = a.in[0]; C.c = a.in[1]; C.ctx = a.in[2]; C.c_ctx = a.in[3]; C.ada_w = a.in[4]; C.ada_b = a.in[5]; C.norm_g = a.in[6]; C.w_in = a.in[7];
    C.q_gain = a.in[8]; C.kv_gain = a.in[9]; C.w_uq = a.in[10]; C.w_ukv = a.in[11]; C.sink = a.in[12]; C.dlam = a.in[13]; C.subln = a.in[14];
    C.pool_w = a.in[15]; C.pool_scale = a.in[16]; C.w_out = a.in[17]; C.r_gw = a.in[18]; C.r_gb = a.in[19]; C.r_ew = a.in[20]; C.r_eb = a.in[21];
    C.w_gu = a.in[22]; C.w_down = a.in[23]; C.out = a.out; C.ws = a.ws;
    C.mod = (float*)(a.ws + WS_MOD); C.hctx = (float*)(a.ws + WS_HCTX);
    unsigned char* q = a.ws + WS_QKV;
    C.QA = (bf16_t*)(q + QA_OFF); C.KA = (bf16_t*)(q + KA_OFF); C.VA = (bf16_t*)(q + VA_OFF); C.QB = (bf16_t*)(q + QB_OFF); C.KB = (bf16_t*)(q + KB_OFF);
    C.VB = (bf16_t*)(q + VB_OFF); C.QC = (bf16_t*)(q + QC_OFF); C.KC = (bf16_t*)(q + KC_OFF); C.VC = (bf16_t*)(q + VC_OFF); C.U = (bf16_t*)(q + U_OFF);
    C.O = (bf16_t*)(a.ws + WS_O);
    C.WIN = (bf16_t*)(a.ws + WS_WIN); C.WOUT = (bf16_t*)(a.ws + WS_WOUT); C.WUQ = (bf16_t*)(a.ws + WS_WUQ); C.WUKV = (bf16_t*)(a.ws + WS_WUKV);
    C.WGU = (bf16_t*)(a.ws + WS_WGU); C.WDN = (bf16_t*)(a.ws + WS_WDN); C.HX = (bf16_t*)(a.ws + WS_HX); C.CQ = (bf16_t*)(a.ws + WS_CQ); C.CKVR = (bf16_t*)(a.ws + WS_CKVR);
    C.SSQ = (float*)(a.ws + WS_SSQ); C.SSK = (float*)(a.ws + WS_SSK);
    C.OX = (bf16_t*)(a.ws + WS_OX); C.ACT = (bf16_t*)(a.ws + WS_ACT); C.HM = (bf16_t*)(a.ws + WS_HM); C.FX = (bf16_t*)(a.ws + WS_FX);
    C.SS1 = (float*)(a.ws + WS_SS1); C.SS2 = (float*)(a.ws + WS_SS2); C.TOKW = (float*)(a.ws + WS_TOKW); C.LIST = (int*)(a.ws + WS_LIST); C.CNT = (unsigned*)(a.ws + WS_CTL) + CW_CNT;
    return C;
}
constexpr int PH_PER_LAYER = 9;
constexpr int N_PHASES = 1 + PH_PER_LAYER * DEPTH;
__global__ void __launch_bounds__(NTHREADS, 2) fwd(Args a) {
    extern __shared__ __attribute__((aligned(16))) unsigned char lds_raw[];
    float* lds = (float*)lds_raw;
    LAS unsigned char* lds3 = (LAS unsigned char*)lds_raw;
    volatile LAS unsigned* MISC = (volatile LAS unsigned*)((LAS unsigned char*)lds_raw + LDS_MISC);
    for (int u = threadIdx.x; u < (LDS_BYTES - LDS_MISC) / 4; u += NTHREADS) MISC[u] = 0u;
    __syncthreads();
    const bool one = (a.ph_hi - a.ph_lo) > 1;
    XcdBarrier bar; bar.bar = (unsigned*)(a.ws + WS_CTL) + 4096; bar.x = 0; bar.st = nullptr;
    if (one) bar = xcd_barrier_post((unsigned*)(a.ws + WS_CTL) + 4096, MISC + 8);
    const int lo = a.ph_lo, hi = a.ph_hi;
    const int G = gridDim.x, bid = blockIdx.x;
#define IN(k) (lo <= (k) && (k) < hi)
#define SEAM(k) do { if (IN(k) && IN((k) + 1)) xcd_barrier(bar); } while (0)
    if (IN(0)) { const Ctx C = make_ctx(a); phase_mod(C, lds); __syncthreads(); phase_convert(C, lds); }
    SEAM(0);
#pragma unroll 1
    for (int layer = 0; layer < DEPTH; ++layer) {
        const int p = 1 + PH_PER_LAYER * layer;
        if (IN(p)) { const Ctx C = make_ctx(a); phase_ln0(C, layer); }
        SEAM(p);
        if (IN(p + 1)) {
            const Ctx C = make_ctx(a);
            SchedInProj S{G, bid, layer, (const char*)C.HX, (const char*)(C.WIN + (size_t)layer * 2048 * 1024)};
            EpiInProj E{C.CQ, C.CKVR, C.KA, C.QB, C.KB, C.VB, C.QC, C.KC, C.VC, C.U, C.SSQ, C.SSK};
            pg8::gemm_phase(lds3, 1024, 1024, 16, S, E);
        }
        SEAM(p + 1);
        if (IN(p + 2)) {
            const Ctx C = make_ctx(a);
            const int nQ = ((layer == DEPTH - 1) ? TL : T) / 256 * 2;
            SchedMlaUp S{G, bid, nQ, nQ + T / 256 * 2, (const char*)C.CQ, (const char*)C.CKVR, (const char*)(C.WUQ + (size_t)layer * 512 * 256), (const char*)(C.WUKV + (size_t)layer * 512 * 256)};
            EpiMlaUp E{C.QA, C.KA, C.VA, C.SSQ, C.SSK};
            pg8::gemm_phase(lds3, 256, 256, 4, S, E);
        }
        SEAM(p + 2);
#if USE_NAIVE_ATTN
        if (IN(p + 3)) { const Ctx C = make_ctx(a); naive_attn(C, layer, lds); }
#else
        if (IN(p + 3)) { const Ctx C = make_ctx(a); phase_attn(C, layer, (LAS char*)lds3); }
#endif
        SEAM(p + 3);
#if USE_NAIVE_TOKB
        if (IN(p + 4)) { const Ctx C = make_ctx(a); naive_tokB(C, layer, lds); }
        SEAM(p + 4);
#else
        if (IN(p + 4)) {
            const Ctx C = make_ctx(a);
            SchedRows S{G, bid, ((layer == DEPTH - 1) ? TL : T) / 256, 4, (const char*)C.O, (const char*)(C.WOUT + (size_t)layer * 1024 * 1024), 2048u, (size_t)256 * 1024 * 2};
            EpiRowsSS E{C.OX, C.SS1};
            pg8::gemm_phase(lds3, 1024, 1024, 16, S, E);
        }
        SEAM(p + 4);
        if (IN(p + 5)) { const Ctx C = make_ctx(a); phase_router(C, layer, lds); }
        SEAM(p + 5);
        if (IN(p + 6)) {
            const Ctx C = make_ctx(a);
            LAS int* meta = (LAS int*)(lds3 + MOE_LDS); LAS int* tab = (LAS int*)(lds3 + MOE_LDS + 1024);
            moe_setup(C, layer, 8, meta, tab);
            MoeSched S{G, bid, 8, layer, 0, (const char*)C.HM, (const char*)C.WGU, meta, tab};
            EpiMoeUp E{C.ACT, C.TOKW, tab};
            pg8::gemm_phase(lds3, 1024, 1024, 16, S, E);
        }
        SEAM(p + 6);
        if (IN(p + 7)) {
            const Ctx C = make_ctx(a);
            LAS int* meta = (LAS int*)(lds3 + MOE_LDS); LAS int* tab = (LAS int*)(lds3 + MOE_LDS + 1024);
            moe_setup(C, layer, 4, meta, tab);
            MoeSched S{G, bid, 4, layer, 1, (const char*)C.ACT, (const char*)C.WDN, meta, tab};
            EpiMoeDown E{C.FX, C.SS2, tab};
            pg8::gemm_phase(lds3, 1024, 512, 8, S, E);
        }
        SEAM(p + 7);
        if (IN(p + 8)) { const Ctx C = make_ctx(a); phase_final(C, layer); }
        SEAM(p + 8);
#endif
    }
#undef IN
#undef SEAM
}

extern "C" void kernel_launch(void* const* d_in, const int* in_sizes, int n_in, void* d_out, int out_size, void* d_ws, size_t ws_size, hipStream_t stream) {
    static int grid = 0;
    if (grid == 0) {
        if (n_in != 24 || out_size != TL * D || ws_size < WS_END) { fprintf(stderr, "kernel_launch: unexpected shapes (n_in %d out %d ws %zu)\n", n_in, out_size, ws_size); grid = -1; return; }
        int dev = 0, cus = 0;
        if (hipGetDevice(&dev) != hipSuccess || hipDeviceGetAttribute(&cus, hipDeviceAttributeMultiprocessorCount, dev) != hipSuccess) { grid = -1; return; }
        if (hipFuncSetAttribute((const void*)fwd, hipFuncAttributeMaxDynamicSharedMemorySize, LDS_BYTES) != hipSuccess) { fprintf(stderr, "kernel_launch: hipFuncSetAttribute failed\n"); grid = -1; return; }
        int per_cu = 0;
        if (hipOccupancyMaxActiveBlocksPerMultiprocessor(&per_cu, (const void*)fwd, NTHREADS, LDS_BYTES) != hipSuccess || per_cu < 1) { fprintf(stderr, "kernel_launch: occupancy query says %d\n", per_cu); }
        (void)hipGetLastError();
        grid = cus;
    }
    if (grid < 0) return;
    (void)hipMemsetAsync((char*)d_ws + WS_CTL, 0, CTL_BYTES, stream);
    Args a{};
    for (int i = 0; i < 24; ++i) a.in[i] = (const float*)d_in[i];
    a.out = (float*)d_out; a.ws = (unsigned char*)d_ws;
#if N_LAUNCH_MODE == 1
    a.ph_lo = 0; a.ph_hi = N_PHASES;
    hipLaunchKernelGGL(fwd, dim3(grid), dim3(NTHREADS), LDS_BYTES, stream, a);
#else
    for (int p = 0; p < N_PHASES; ++p) { a.ph_lo = p; a.ph_hi = p + 1; hipLaunchKernelGGL(fwd, dim3(grid), dim3(NTHREADS), LDS_BYTES, stream, a); }
#endif
}
```

```cpp
#include <hip/hip_runtime.h>
#include <cstdio>
#include <cstdint>

#ifndef REP_PRO
#define REP_PRO 1
#endif
#ifndef REP_LN0
#define REP_LN0 1
#endif
#ifndef REP_INP
#define REP_INP 1
#endif
#ifndef REP_MLA
#define REP_MLA 1
#endif
#ifndef REP_ATT
#define REP_ATT 1
#endif
#ifndef REP_OUT
#define REP_OUT 1
#endif
#ifndef REP_MUP
#define REP_MUP 1
#endif
#ifndef REP_MDN
#define REP_MDN 1
#endif
#define REPEAT(n) _Pragma("unroll 1") for (int rep_ = 0; rep_ < (n); ++rep_)
#define REP_SYNC() do { if (rep_ > 0) { if (one) xcd_barrier(bar, wv); else __syncthreads(); } } while (0)
#ifndef PROBE_SEL
#define PROBE_SEL -1
#endif
#define PROBE_MULT 4
#if PROBE_SEL >= 0
#define STAMP_BEGIN() do { if (blockIdx.x == 0 && wv == 0 && lane_id() == 0) *(volatile LAS unsigned long long*)(MISC + 18) = wall_clock64(); } while (0)
#define STAMP_END(kind) do { if (blockIdx.x == 0 && wv == 0 && lane_id() == 0 && (kind) == PROBE_SEL) *(volatile LAS unsigned long long*)(MISC + 16) += wall_clock64() - *(volatile LAS unsigned long long*)(MISC + 18); } while (0)
#else
#define STAMP_BEGIN() do {} while (0)
#define STAMP_END(kind) do {} while (0)
#endif
#ifndef BG_INP
#define BG_INP 4
#endif
#ifndef BG_OUT
#define BG_OUT 3
#endif
#ifndef BG_MUP
#define BG_MUP 0
#endif
#ifndef BG_MDN
#define BG_MDN 0
#endif
#ifndef ATT_DEFER
#define ATT_DEFER 1
#endif
#ifndef ATT_LACC_MAX
#define ATT_LACC_MAX 0
#endif
#ifndef ATT_DEEP_MAX
#define ATT_DEEP_MAX 0
#endif
#ifndef ATT_PIPE
#define ATT_PIPE 1
#endif
#ifndef USE_NAIVE_ATTN
#define USE_NAIVE_ATTN 0
#endif
#ifndef USE_NAIVE_TOKB
#define USE_NAIVE_TOKB 0
#endif
#ifndef N_LAUNCH_MODE
#define N_LAUNCH_MODE 1
#endif

constexpr int D = 1024, BATCH = 16, SEQ = 2048, CTXL = 256, DEPTH = 2, GRIDW = 64;
constexpr int TL = BATCH * SEQ, TC = BATCH * CTXL, T = TL + TC;
constexpr int D_IN = 1952, NMOD = 6;
constexpr float EPS = 1e-6f;
constexpr float LOG2E = 1.4426950408889634f;
constexpr int Z_CQ = 0, Z_CKV = 256, Z_KR = 384, Z_BQ = 416, Z_BK = 672, Z_BV = 800, Z_DQ = 928, Z_DK = 1184, Z_DV = 1440, Z_U = 1696;
constexpr float SC_A = 0.10206207261596577f * LOG2E;
constexpr float SC_B = 0.125f * LOG2E;
constexpr float SC_C = 0.17677669529663687f * LOG2E;

constexpr size_t MiB = 1u << 20;
constexpr size_t WS_CTL = 0, CTL_BYTES = 1 * MiB;
constexpr size_t WS_MOD = 1 * MiB;
constexpr size_t WS_HCTX = 4 * MiB;
constexpr size_t WS_QKV = 130 * MiB;
constexpr size_t QA_OFF = 0, KA_OFF = QA_OFF + (size_t)T * 384 * 2, VA_OFF = KA_OFF + (size_t)T * 384 * 2,
                 QB_OFF = VA_OFF + (size_t)T * 256 * 2, KB_OFF = QB_OFF + (size_t)T * 256 * 2, VB_OFF = KB_OFF + (size_t)T * 128 * 2,
                 QC_OFF = VB_OFF + (size_t)T * 128 * 2, KC_OFF = QC_OFF + (size_t)T * 256 * 2, VC_OFF = KC_OFF + (size_t)T * 256 * 2,
                 U_OFF = VC_OFF + (size_t)T * 256 * 2, QKV_END = U_OFF + (size_t)T * 256 * 2;
static_assert(QKV_END <= 180 * MiB, "qkv region");
constexpr size_t WS_O = 310 * MiB;
constexpr size_t WS_WIN = 20 * MiB;
constexpr size_t WS_WOUT = 28 * MiB;
constexpr size_t WS_WUQ = 32 * MiB;
constexpr size_t WS_WUKV = 32 * MiB + 512 * 1024;
constexpr size_t WS_WGU = 34 * MiB;
constexpr size_t WS_WDN = 98 * MiB;
constexpr size_t WS_HX = 382 * MiB;
constexpr size_t WS_CQ = 454 * MiB;
constexpr size_t WS_CKVR = 472 * MiB;
constexpr size_t WS_SSQ = 490 * MiB;
constexpr size_t WS_SSK = 491 * MiB;
constexpr size_t WS_SS1 = 492 * MiB;
constexpr size_t WS_SS2 = 495 * MiB;
constexpr size_t WS_LIST = 498 * MiB;
constexpr int LIST_CAP = 160;
constexpr size_t WS_CNTW = 502 * MiB + 512 * 1024;
constexpr size_t WS_TOKW = 502 * MiB;
constexpr size_t WS_END = 503 * MiB;
constexpr size_t WS_OX = WS_QKV;
constexpr size_t WS_ACT = WS_QKV;
constexpr size_t WS_HM = WS_QKV + 96 * MiB;
constexpr size_t WS_FX = WS_O;
constexpr int ACT_ROWS = 43008;
static_assert((size_t)ACT_ROWS * 2048 <= 96 * MiB && WS_HM + (size_t)T * 2048 <= WS_QKV + 180 * MiB, "aliases");
constexpr int CW_CNT = 8192;

typedef unsigned short bf16_t;
#define LAS __attribute__((address_space(3)))

__device__ __forceinline__ float bf2f(bf16_t b) { return __uint_as_float(((unsigned)b) << 16); }
__device__ __forceinline__ bf16_t f2bf(float f) { unsigned u = __float_as_uint(f); u += 0x7fffu + ((u >> 16) & 1u); return (bf16_t)(u >> 16); }

struct alignas(16) RopeTab { float c[64][24]; float s[64][24]; };
constexpr double cx_exp(double x) {
    int k = 0; while (x < -0.5) { x *= 0.5; ++k; }
    double t = 1.0, s = 1.0; for (int i = 1; i < 30; ++i) { t *= x / i; s += t; }
    for (int i = 0; i < k; ++i) s *= s; return s;
}
constexpr double cx_pi = 3.14159265358979323846264338327950288;
constexpr double cx_sin_small(double x) { double t = x, s = x; for (int i = 1; i < 14; ++i) { t *= -x * x / ((2 * i) * (2 * i + 1)); s += t; } return s; }
constexpr double cx_cos_small(double x) { double t = 1.0, s = 1.0; for (int i = 1; i < 14; ++i) { t *= -x * x / ((2 * i - 1) * (2 * i)); s += t; } return s; }
constexpr double cx_reduce(double x) { double q = x / (2 * cx_pi); long long n = (long long)q; double r = x - (double)n * 2 * cx_pi; if (r > cx_pi) r -= 2 * cx_pi; return r; }
constexpr RopeTab make_rope() {
    RopeTab t{};
    const double ln1e4 = 9.21034037197618273607196581873745683;
    double inv[24] = {};
    for (int f = 0; f < 24; ++f) inv[f] = (f < 8) ? cx_exp(-(double)f / 8.0 * ln1e4) : cx_exp(-(double)(f - 8) / 16.0 * ln1e4);
    for (int p = 0; p < 64; ++p) for (int f = 0; f < 24; ++f) {
        const double a = cx_reduce((double)p * inv[f]);
        t.c[p][f] = (float)cx_cos_small(a); t.s[p][f] = (float)cx_sin_small(a);
    }
    return t;
}
__device__ constexpr RopeTab g_rope = make_rope();
__device__ __forceinline__ void rope_cs_a(int t, int i, float& c, float& s) { const int p = (i < 8) ? (t >> 6) : (t & 63), f = i & 7; c = g_rope.c[p][f]; s = g_rope.s[p][f]; }
__device__ __forceinline__ void rope_cs_b(int t, int i, float& c, float& s) { const int p = (i < 16) ? (t >> 6) : (t & 63), f = 8 + (i & 15); c = g_rope.c[p][f]; s = g_rope.s[p][f]; }

#define XB_TMO      128
#define XB_XCNT(j)  (256  + 64 * (j))
#define XB_XSUB(j)  (1280 + 64 * (j))
#define XB_XGEN(j)  (2304 + 64 * (j))
#define XB_TOP      3328
#define XB_TOPGEN   3392
#define XCD_BAR_WORDS 3456
#define XB_SPIN_CAP (1u << 18)
__device__ __forceinline__ unsigned xb_ld(unsigned* p)              { return __hip_atomic_load(p, __ATOMIC_RELAXED, __HIP_MEMORY_SCOPE_AGENT); }
__device__ __forceinline__ unsigned xb_add(unsigned* p, unsigned v) { return __hip_atomic_fetch_add(p, v, __ATOMIC_RELAXED, __HIP_MEMORY_SCOPE_AGENT); }
__device__ __forceinline__ unsigned xb_xcc_id() { return (unsigned)__builtin_amdgcn_s_getreg((3 << 11) | 20) & 0xFu; }
#define XB_SPIN(cond, bar) do { unsigned _sp = 0; while (cond) { __builtin_amdgcn_s_sleep(1); \
    if ((++_sp & 255u) == 0u) { if (xb_ld(&(bar)[XB_TMO])) break; if (_sp > XB_SPIN_CAP) { atomicAdd(&(bar)[XB_TMO], 1u); break; } } } } while (0)
__device__ __forceinline__ int lane_id();
struct XcdBarrier { unsigned* bar; unsigned x; volatile LAS unsigned* st; };
__device__ __forceinline__ XcdBarrier xcd_barrier_post(unsigned* bar, volatile LAS unsigned* st, int wv) {
    XcdBarrier b; b.bar = bar; b.x = xb_xcc_id(); b.st = st;
    if (wv == 0 && lane_id() == 0) (void)xb_add(&bar[XB_XCNT(b.x)], 1u);
    return b;
}
__device__ __forceinline__ void xcd_barrier_complete(unsigned* bar, unsigned x, unsigned& nloc, unsigned& nx) {
    const unsigned G = gridDim.x * gridDim.y * gridDim.z;
    unsigned sum, cnt, mine, sp = 0u;
    for (;;) {
        sum = 0u; cnt = 0u; mine = 0u;
#pragma unroll
        for (unsigned j = 0; j < 16; ++j) { const unsigned c = xb_ld(&bar[XB_XCNT(j)]); sum += c; cnt += (c > 0u) ? 1u : 0u; mine = (j == x) ? c : mine; }
        if (sum == G) break;
        __builtin_amdgcn_s_sleep(1);
        if ((++sp & 255u) == 0u) { if (xb_ld(&bar[XB_TMO])) break; if (sp > XB_SPIN_CAP) { atomicAdd(&bar[XB_TMO], 1u); break; } }
    }
    nloc = mine > 0u ? mine : 1u; nx = cnt > 0u ? cnt : 1u;
}
__device__ __forceinline__ void xcd_barrier(const XcdBarrier& b, int wv) {
    asm volatile("s_waitcnt vmcnt(0)" ::: "memory");
    __syncthreads();
    if (wv == 0 && lane_id() == 0) {
        unsigned* bar = b.bar;
        __builtin_amdgcn_s_waitcnt(0);
        unsigned nloc = b.st[0], nx = b.st[1];
        if (nloc == 0u) { xcd_barrier_complete(bar, b.x, nloc, nx); b.st[0] = nloc; b.st[1] = nx; }
        const unsigned old = xb_add(&bar[XB_XSUB(b.x)], 1u);
        const unsigned gen = old / nloc;
        if (old + 1u == (gen + 1u) * nloc) {
            __builtin_amdgcn_fence(__ATOMIC_RELEASE, "agent");
            asm volatile("s_waitcnt vmcnt(0)" ::: "memory");
            const unsigned og = xb_add(&bar[XB_TOP], 1u);
            const unsigned tg = og / nx;
            if (og + 1u == (tg + 1u) * nx) xb_add(&bar[XB_TOPGEN], 1u);
            else XB_SPIN(xb_ld(&bar[XB_TOPGEN]) == tg, bar);
            __builtin_amdgcn_fence(__ATOMIC_ACQUIRE, "agent");
            xb_add(&bar[XB_XGEN(b.x)], 1u);
            asm volatile("s_waitcnt vmcnt(0)" ::: "memory");
        } else {
            XB_SPIN(xb_ld(&bar[XB_XGEN(b.x)]) == gen, bar);
            __builtin_amdgcn_fence(__ATOMIC_ACQUIRE, "agent");
            asm volatile("s_waitcnt vmcnt(0)" ::: "memory");
        }
    }
    __syncthreads();
}

constexpr int NTHREADS = 512, NWAVES = 8;
constexpr int LDS_BYTES = 147456;
constexpr int LDS_MISC = 143360;

struct Args {
    const float* in[24]; float* out; unsigned char* ws; int ph_lo, ph_hi;
};
struct Ctx {
    const float *x, *c, *ctx, *c_ctx, *ada_w, *ada_b, *norm_g, *w_in, *q_gain, *kv_gain, *w_uq, *w_ukv, *sink, *dlam, *subln, *pool_w, *pool_scale,
                *w_out, *r_gw, *r_gb, *r_ew, *r_eb, *w_gu, *w_down;
    float* out; unsigned char* ws; int wv;
    float* mod; float* hctx;
    bf16_t *QA, *KA, *VA, *QB, *KB, *VB, *QC, *KC, *VC, *U, *O;
    bf16_t *WIN, *WOUT, *WUQ, *WUKV, *WGU, *WDN, *HX, *CQ, *CKVR; float *SSQ, *SSK;
    bf16_t *OX, *ACT, *HM, *FX; float *SS1, *SS2, *TOKW; int* LIST; int* CNTW;
};
__device__ __forceinline__ int lane_id();
template <int K> __device__ __forceinline__ float xshfl(float v) {
    if constexpr (K == 32) { auto rr = __builtin_amdgcn_permlane32_swap(__float_as_uint(v), __float_as_uint(v), false, false); return __uint_as_float(lane_id() < 32 ? rr[1] : rr[0]); }
    else return __uint_as_float((unsigned)__builtin_amdgcn_ds_swizzle((int)__float_as_uint(v), (K << 10) | 0x1f));
}
__device__ __forceinline__ float wave_sum(float v) {
    v += xshfl<32>(v); v += xshfl<16>(v); v += xshfl<8>(v); v += xshfl<4>(v); v += xshfl<2>(v); v += xshfl<1>(v);
    return v;
}
__device__ __forceinline__ float wave_max(float v) {
    v = fmaxf(v, xshfl<32>(v)); v = fmaxf(v, xshfl<16>(v)); v = fmaxf(v, xshfl<8>(v)); v = fmaxf(v, xshfl<4>(v)); v = fmaxf(v, xshfl<2>(v)); v = fmaxf(v, xshfl<1>(v));
    return v;
}
__device__ __forceinline__ float block_sum(float v, float* red) {
    v = wave_sum(v);
    __syncthreads();
    if ((threadIdx.x & 63) == 0) red[threadIdx.x >> 6] = v;
    __syncthreads();
    float s = 0.f;
#pragma unroll
    for (int i = 0; i < NWAVES; ++i) s += red[i];
    return s;
}
__device__ __forceinline__ int lane_id() { int l = (int)__builtin_amdgcn_mbcnt_hi(~0u, __builtin_amdgcn_mbcnt_lo(~0u, 0u)); asm volatile("" : "+v"(l)); return l; }
__device__ __forceinline__ int opaque_tid(int wv) { int t = wv * 64 + lane_id(); asm volatile("" : "+v"(t)); return t; }
__device__ __forceinline__ float silu_f(float v) { return v / (1.f + __expf(-v)); }
__device__ __forceinline__ float lam_init_of(int layer) { return layer == 0 ? 0.2f : (0.8f - 0.6f * 0.7408182206817179f); }

__device__ __forceinline__ const float* xrow_in(const Ctx& C, int layer, int r) {
    const float* a0 = C.x + 0; const float* a1 = C.out + 0; const float* b0 = C.ctx + 0; const float* b1 = C.hctx + 0;
    if (r < TL) return (layer == 0 ? a0 : a1) + (size_t)r * D;
    return (layer == 0 ? b0 : b1) + (size_t)(r - TL) * D;
}
__device__ __forceinline__ float* xrow_out(const Ctx& C, int r) { float* a1 = C.out + 0; float* b1 = C.hctx + 0; return (r < TL) ? a1 + (size_t)r * D : b1 + (size_t)(r - TL) * D; }

__device__ __forceinline__ void phase_mod(const Ctx& C, float* lds) {
    float* sv = lds;
    float* part = lds + 17 * 1024;
    const int tid = opaque_tid(C.wv), lane = tid & 63, wave = tid >> 6;
    for (int i = tid; i < 17 * 1024; i += NTHREADS) { const float v = (i < 16 * 1024) ? C.c[i] : C.c_ctx[i - 16 * 1024]; sv[i] = silu_f(v); }
    __syncthreads();
    const int nitems = DEPTH * (NMOD * D / 64);
    for (int item = blockIdx.x; item < nitems; item += gridDim.x) {
        const int l = item / (NMOD * D / 64), j = (item % (NMOD * D / 64)) * 64 + lane;
        const float* w = C.ada_w + (size_t)l * D * (NMOD * D) + j;
        float acc[17];
#pragma unroll
        for (int r = 0; r < 17; ++r) acc[r] = 0.f;
#pragma unroll 1
        for (int k0 = wave * 128; k0 < wave * 128 + 128; k0 += 32) {
            float wv[32];
#pragma unroll
            for (int i = 0; i < 32; ++i) wv[i] = w[(size_t)(k0 + i) * (NMOD * D)];
#pragma unroll
            for (int i = 0; i < 32; ++i)
#pragma unroll
                for (int r = 0; r < 17; ++r) acc[r] += sv[r * 1024 + k0 + i] * wv[i];
        }
#pragma unroll
        for (int r = 0; r < 17; ++r) part[(wave * 17 + r) * 64 + lane] = acc[r];
        __syncthreads();
        for (int i = tid; i < 17 * 64; i += NTHREADS) {
            const int r = i >> 6, jj = i & 63; float s = 0.f;
#pragma unroll
            for (int w8 = 0; w8 < 8; ++w8) s += part[(w8 * 17 + r) * 64 + jj];
            const int col = (item % (NMOD * D / 64)) * 64 + jj;
            C.mod[((size_t)l * 17 + r) * (NMOD * D) + col] = s + C.ada_b[(size_t)l * NMOD * D + col];
        }
        __syncthreads();
    }
}

namespace pg8 {
typedef short bf16x8 __attribute__((ext_vector_type(8)));
typedef float f32x4 __attribute__((ext_vector_type(4)));
typedef unsigned u32x4 __attribute__((ext_vector_type(4)));
typedef unsigned u32x2 __attribute__((ext_vector_type(2)));
constexpr int BM = 256, BK = 64, HALF = 128, HTB = HALF * BK * 2, STAGE_BYTES = 8 * HTB, NXCD = 8, WGM = 8;
__host__ __device__ __forceinline__ int lds_byte(int r, int c) { const int st = (r >> 4) * 2 + (c >> 5), rr = r & 15, cc = c & 31, ob = rr * 64 + cc * 2; return st * 1024 + (ob ^ (((ob >> 9) & 1) << 5)); }
__host__ __device__ __forceinline__ void stage_rc(int b, int& R, int& C) { const int st = b / 1024, sb = b % 1024, swz = sb ^ (((sb >> 9) & 1) << 5); R = (st >> 1) * 16 + swz / 64; C = (st & 1) * 32 + (swz % 64) / 2; }
__host__ __device__ __forceinline__ int perm32(int rho) { const int n = rho >> 4, i = rho & 15; return 8 * (i >> 2) + 4 * n + (i & 3); }
__device__ __forceinline__ unsigned cvt_pk_bf16(float lo, float hi) { unsigned r; asm volatile("v_cvt_pk_bf16_f32 %0, %1, %2" : "=v"(r) : "v"(lo), "v"(hi)); return r; }

__device__ __forceinline__ bool static_tile(int i, int G, int c, int nM, int nN, int& pm, int& pn) {
    const int nwg = nM * nN; const long L = (long)i * G + c; if (L >= nwg) return false;
    int wgid = (int)L; { const int q = nwg / NXCD, r = nwg % NXCD, xcd = wgid % NXCD, off = wgid / NXCD; wgid = (xcd < r ? xcd * (q + 1) : r * (q + 1) + (xcd - r) * q) + off; }
    const int nig = WGM * nN, gid = wgid / nig, fm = gid * WGM, gsz = (nM - fm) < WGM ? (nM - fm) : WGM;
    pm = fm + ((wgid % nig) % gsz); pn = (wgid % nig) / gsz; return true;
}
struct GUnit { const char* A; const char* B; const char* B2; int pm, pn, x0, x1; };
template <int PH, class Epi, class Sched>
__device__ __forceinline__ void gemm_phase(LAS unsigned char* lds, const int wv, const int K, const int ldb  , const int ksplit  , const Sched& S, const Epi& E) {
    const int tid = opaque_tid(wv), wid = __builtin_amdgcn_readfirstlane(tid >> 6), lane = tid & 63, wr = wid >> 2, wc = wid & 3, fr = lane & 15, fq = lane >> 4;
    volatile LAS unsigned* MISC = (volatile LAS unsigned*)(lds + LDS_MISC); (void)MISC;
    int nt = K / BK; asm volatile("" : "+s"(nt));
    unsigned voffB[2];
#pragma unroll
    for (int i = 0; i < 2; ++i) { int R_, C_; stage_rc(tid * 16 + i * 8192, R_, C_); const int Rb = Epi::PERM ? ((R_ & ~31) + perm32(R_ & 31)) : R_; voffB[i] = (unsigned)(Rb * ldb + C_) * 2u; }
    const size_t kstep = (size_t)(BK * 2);
    const size_t hstepB = (size_t)HALF * ldb * 2;
    const unsigned ldsw = (unsigned)wid * 1024u;
    const int aoff = lds_byte(wr * 64 + fr, fq * 8), boff = lds_byte(wc * 32 + fr, fq * 8);
#define PG8_SA(b, h) (((b) * 2 + (h)) * HTB)
#define PG8_SB(b, h) ((4 + (b) * 2 + (h)) * HTB)
#define PG8_STAGE(bufoff, gbase, v0, v1) do { \
        __builtin_amdgcn_global_load_lds((const unsigned*)((const char*)(gbase) + (v0)), (LAS unsigned*)(lds + (bufoff) + ldsw), 16, 0, 0); \
        __builtin_amdgcn_global_load_lds((const unsigned*)((const char*)(gbase) + (v1)), (LAS unsigned*)(lds + (bufoff) + ldsw + 8192), 16, 0, 0); } while (0)
#define PG8_STAGE_B(bufoff, gbase) PG8_STAGE(bufoff, gbase, voffB[0], voffB[1])
#define PG8_LDA(dst, b, h) do { _Pragma("unroll") for (int m = 0; m < 4; ++m) _Pragma("unroll") for (int k = 0; k < 2; ++k) dst[m][k] = *(const LAS bf16x8*)(lds + PG8_SA(b, h) + aoff + m * 2048 + k * 1024); } while (0)
#define PG8_LDB(dst, b, h) do { _Pragma("unroll") for (int n = 0; n < 2; ++n) _Pragma("unroll") for (int k = 0; k < 2; ++k) dst[n][k] = *(const LAS bf16x8*)(lds + PG8_SB(b, h) + boff + n * 2048 + k * 1024); } while (0)
#define PG8_MMA(ai, bj, At, Bt) do { __builtin_amdgcn_s_setprio(1); _Pragma("unroll") for (int m = 0; m < 4; ++m) _Pragma("unroll") for (int n = 0; n < 2; ++n) _Pragma("unroll") for (int k = 0; k < 2; ++k) \
        acc[ai][bj][m][n] = __builtin_amdgcn_mfma_f32_16x16x32_bf16(Bt[n][k], At[m][k], acc[ai][bj][m][n], 0, 0, 0); __builtin_amdgcn_s_setprio(0); } while (0)
#define PG8_WAIT_V(n) asm volatile("s_waitcnt vmcnt(" #n ")" ::: "memory")
#define PG8_WAIT_L(n) asm volatile("s_waitcnt lgkmcnt(" #n ")" ::: "memory")
#define PG8_BAR __builtin_amdgcn_s_barrier()
#define PG8_SCHED __builtin_amdgcn_sched_barrier(0)
#define PG8_BPTR(u, kt) (((kt) < ksplit) ? (u).B + (size_t)(kt) * kstep : (u).B2 + (size_t)((kt) - ksplit) * kstep)
    GUnit cur, nxt; int ui = 0;
    if (!S.next(0, cur)) return;

    f32x4 acc[2][2][4][2];
#pragma unroll
    for (int a = 0; a < 2; ++a)
#pragma unroll
        for (int b = 0; b < 2; ++b)
#pragma unroll
            for (int m = 0; m < 4; ++m)
#pragma unroll
                for (int n = 0; n < 2; ++n) acc[a][b][m][n] = (f32x4){0.f, 0.f, 0.f, 0.f};
    bf16x8 At[4][2], B0[2][2], B1[2][2];
    unsigned vc00, vc01, vc10, vc11;
#define PG8_AOFFS(u) do { int R0_, C0_, R1_, C1_; stage_rc(tid * 16, R0_, C0_); stage_rc(tid * 16 + 8192, R1_, C1_); \
        vc00 = S.arow(u, R0_) + C0_ * 2u; vc01 = S.arow(u, R1_) + C1_ * 2u; vc10 = S.arow(u, HALF + R0_) + C0_ * 2u; vc11 = S.arow(u, HALF + R1_) + C1_ * 2u; } while (0)
    PG8_AOFFS(cur);
    const char* cA = cur.A;
    {
        const char* b0 = PG8_BPTR(cur, 0); const char* b1 = PG8_BPTR(cur, 1);
        PG8_STAGE_B(PG8_SB(0, 0), b0); PG8_STAGE(PG8_SA(0, 0), cA, vc00, vc01); PG8_STAGE_B(PG8_SB(0, 1), b0 + hstepB); PG8_STAGE(PG8_SA(0, 1), cA, vc10, vc11);
        if (wr == 1) PG8_BAR;
        PG8_WAIT_V(4); PG8_BAR;
        PG8_STAGE_B(PG8_SB(1, 0), b1); PG8_STAGE(PG8_SA(1, 0), cA + kstep, vc00, vc01); PG8_STAGE_B(PG8_SB(1, 1), b1 + hstepB);
        PG8_WAIT_V(6); PG8_BAR;
    }
#pragma unroll 1
    for (;;) {
        const bool has_next = S.next(ui + 1, nxt);
        if (!has_next) nxt = cur;
        const char* nA = nxt.A;
#pragma unroll 1
        for (int t = 0; t < nt; t += 2) {
            const bool last = (t == nt - 2);
            const char* a1 = cA + (size_t)(t + 1) * kstep;
            const char* a2 = last ? nA : cA + (size_t)(t + 2) * kstep;
            const char* a3 = a2 + kstep;
            const char* b2 = last ? PG8_BPTR(nxt, 0) : PG8_BPTR(cur, t + 2);
            const char* b3 = last ? PG8_BPTR(nxt, 1) : PG8_BPTR(cur, t + 3);
            PG8_LDB(B0, 0, 0); PG8_SCHED; PG8_LDA(At, 0, 0); PG8_STAGE(PG8_SA(1, 1), a1, vc10, vc11);
            PG8_WAIT_L(8); PG8_BAR; PG8_WAIT_L(0); PG8_MMA(0, 0, At, B0); PG8_BAR; PG8_SCHED;
            if (last) PG8_AOFFS(nxt);
            PG8_LDB(B1, 0, 1); PG8_STAGE_B(PG8_SB(0, 0), b2);
            PG8_BAR; PG8_WAIT_L(0); PG8_MMA(0, 1, At, B1); PG8_BAR;
            PG8_LDA(At, 0, 1); PG8_STAGE(PG8_SA(0, 0), a2, vc00, vc01);
            PG8_BAR; PG8_WAIT_L(0); PG8_MMA(1, 0, At, B0); PG8_BAR; PG8_SCHED;
            PG8_STAGE_B(PG8_SB(0, 1), b2 + hstepB);
            PG8_WAIT_V(6); PG8_BAR; PG8_MMA(1, 1, At, B1); PG8_BAR;
            PG8_LDB(B0, 1, 0); PG8_SCHED; PG8_LDA(At, 1, 0); PG8_STAGE(PG8_SA(0, 1), a2, vc10, vc11);
            PG8_WAIT_L(8); PG8_BAR; PG8_WAIT_L(0); PG8_MMA(0, 0, At, B0); PG8_BAR; PG8_SCHED;
            PG8_LDB(B1, 1, 1); PG8_STAGE_B(PG8_SB(1, 0), b3);
            PG8_BAR; PG8_WAIT_L(0); PG8_MMA(0, 1, At, B1); PG8_BAR;
            PG8_LDA(At, 1, 1); PG8_STAGE(PG8_SA(1, 0), a3, vc00, vc01);
            PG8_BAR; PG8_WAIT_L(0); PG8_MMA(1, 0, At, B0); PG8_BAR; PG8_SCHED;
            PG8_STAGE_B(PG8_SB(1, 1), b3 + hstepB);
            PG8_WAIT_V(6); PG8_BAR; PG8_MMA(1, 1, At, B1); PG8_BAR;
        }
        { STAMP_BEGIN(); E(acc, cur, wr, wc, fr, fq); STAMP_END(20 + PH); }
        if (!has_next) break;
#pragma unroll
        for (int a = 0; a < 2; ++a)
#pragma unroll
            for (int b = 0; b < 2; ++b)
#pragma unroll
                for (int m = 0; m < 4; ++m)
#pragma unroll
                    for (int n = 0; n < 2; ++n) acc[a][b][m][n] = (f32x4){0.f, 0.f, 0.f, 0.f};
        cur = nxt; cA = nA; ++ui;
    }
    PG8_WAIT_V(0);
    if (wr == 0) PG8_BAR;
    PG8_BAR;
#undef PG8_SA
#undef PG8_SB
#undef PG8_STAGE
#undef PG8_STAGE_B
#undef PG8_LDA
#undef PG8_LDB
#undef PG8_MMA
#undef PG8_WAIT_V
#undef PG8_WAIT_L
#undef PG8_BAR
#undef PG8_SCHED
#undef PG8_BPTR
#undef PG8_AOFFS
}
}

template <class CM>
__device__ __forceinline__ void transpose_item(const float* W, int ldw, int Ksrc, const float* rs, bf16_t* dst, int K, const CM& cm, float* scr, int kb, int nb, int lane) {
    const int k0 = 64 * kb, n0 = 32 * nb;
    const int col = cm(n0 + (lane & 31));
    float v[32];
#pragma unroll
    for (int i = 0; i < 32; ++i) { const int k = k0 + 2 * i + (lane >> 5); const bool ok = (col >= 0) && (k < Ksrc);
        const float x = W[ok ? (size_t)k * ldw + col : (size_t)0]; v[i] = ok ? (rs ? x * rs[ok ? k : 0] : x) : 0.f; }
#pragma unroll
    for (int i = 0; i < 32; ++i) scr[(2 * i + (lane >> 5)) * 33 + (lane & 31)] = v[i];
    asm volatile("s_waitcnt lgkmcnt(0)" ::: "memory");
    const int c = lane & 7;
#pragma unroll
    for (int j = 0; j < 4; ++j) { const int n = (lane >> 3) + 8 * j; const float* sp = scr + (8 * c) * 33 + n;
        uint4 o; o.x = pg8::cvt_pk_bf16(sp[0 * 33], sp[1 * 33]); o.y = pg8::cvt_pk_bf16(sp[2 * 33], sp[3 * 33]); o.z = pg8::cvt_pk_bf16(sp[4 * 33], sp[5 * 33]); o.w = pg8::cvt_pk_bf16(sp[6 * 33], sp[7 * 33]);
        *(uint4*)(dst + (size_t)(n0 + n) * K + k0 + 8 * c) = o; }
    asm volatile("s_waitcnt lgkmcnt(0)" ::: "memory");
}
__device__ __forceinline__ int headperm64(int w) { const int gi = w >> 5, wp = w & 31; return (wp < 16) ? 16 * gi + wp : 32 + 16 * gi + (wp - 16); }
struct WinMap { __device__ __forceinline__ int operator()(int n) const {
    if (n < 416) return n;
    if (n < 512) return -1;
    if (n < 768) { const int h = (n - 512) >> 6; return Z_BQ + h * 64 + headperm64((n - 512) & 63); }
    if (n < 896) { const int h = (n - 768) >> 6; return Z_BK + h * 64 + headperm64((n - 768) & 63); }
    if (n < 1024) return Z_BV + (n - 896);
    if (n < 1280) return Z_DQ + (n - 1024);
    if (n < 1536) return Z_DK + (n - 1280);
    if (n < 1792) return Z_DV + (n - 1536);
    return Z_U + (n - 1792); } };
struct IdMap { int nvalid; __device__ __forceinline__ int operator()(int n) const { return n < nvalid ? n : -1; } };
struct GuMap { __device__ __forceinline__ int operator()(int n) const { const int q = n >> 8, c = n & 255, jj = c >> 3, t = c & 7, hid = 128 * q + 4 * jj + (t & 3); return (t < 4) ? hid : 512 + hid; } };

constexpr int CV_IN = 16 * 64, CV_UQ = 4 * 16, CV_UKV = 4 * 16, CV_OUT = 16 * 32, CV_GU = 16 * 16 * 32, CV_DN = 16 * 8 * 32;
constexpr int CV_L = CV_IN + CV_UQ + CV_UKV + CV_OUT + CV_GU + CV_DN, CV_FOLD = 64 * 4, CV_TOTAL = CV_L + CV_FOLD;
__device__ __forceinline__ void convert_item(const Ctx& C, int l, int r, float* scr, int lane) {
    if (r < CV_L) {
        if (r < CV_IN) { if ((r % 64) >= 56) return;
            transpose_item(C.w_in + (size_t)l * D * D_IN, D_IN, D, nullptr, C.WIN + (size_t)l * 2048 * 1024, 1024, WinMap{}, scr, r / 64, r % 64, lane); return; } r -= CV_IN;
        if (r < CV_UQ) { transpose_item(C.w_uq + (size_t)l * 256 * 384, 384, 256, C.q_gain + l * 256, C.WUQ + (size_t)l * 512 * 256, 256, IdMap{384}, scr, r / 16, r % 16, lane); return; } r -= CV_UQ;
        if (r < CV_UKV) { transpose_item(C.w_ukv + (size_t)l * 128 * 512, 512, 128, C.kv_gain + l * 128, C.WUKV + (size_t)l * 512 * 256, 256, IdMap{512}, scr, r / 16, r % 16, lane); return; } r -= CV_UKV;
        if (r < CV_OUT) { transpose_item(C.w_out + (size_t)l * D * D, D, D, nullptr, C.WOUT + (size_t)l * 1024 * 1024, 1024, IdMap{1024}, scr, r / 32, r % 32, lane); return; } r -= CV_OUT;
        if (r < CV_GU) { const int e = r / (16 * 32), q = r % (16 * 32);
            transpose_item(C.w_gu + ((size_t)l * 16 + e) * D * 1024, 1024, D, nullptr, C.WGU + ((size_t)l * 16 + e) * 1024 * 1024, 1024, GuMap{}, scr, q / 32, q % 32, lane); return; } r -= CV_GU;
        { const int e = r / (8 * 32), q = r % (8 * 32);
            transpose_item(C.w_down + ((size_t)l * 16 + e) * 512 * D, D, 512, nullptr, C.WDN + ((size_t)l * 16 + e) * 1024 * 512, 512, IdMap{1024}, scr, q / 32, q % 32, lane); }
        return;
    }
    const int f = r - CV_L, kb = f / 4, g = f % 4;
    float pwr[64];
#pragma unroll
    for (int c = 0; c < 64; ++c) pwr[c] = C.pool_w[(((size_t)l * 4 + g) * 64 + c) * 64 + lane];
    const float sc = C.pool_scale[l * 256 + g * 64 + lane];
    bf16_t* dst = C.WIN + ((size_t)l * 2048 + 1792 + g * 64 + lane) * 1024 + kb * 16;
#pragma unroll 1
    for (int k8 = 0; k8 < 2; ++k8) {
        float acc[8];
#pragma unroll
        for (int j = 0; j < 8; ++j) {
            const float wk = C.w_in[((size_t)l * D + kb * 16 + k8 * 8 + j) * D_IN + Z_U + g * 64 + lane];
            float a = 0.f;
#pragma unroll
            for (int c = 0; c < 64; ++c) a += __builtin_bit_cast(float, __builtin_amdgcn_readlane(__builtin_bit_cast(int, wk), c)) * pwr[c];
            acc[j] = a * sc;
        }
        uint4 o; o.x = pg8::cvt_pk_bf16(acc[0], acc[1]); o.y = pg8::cvt_pk_bf16(acc[2], acc[3]); o.z = pg8::cvt_pk_bf16(acc[4], acc[5]); o.w = pg8::cvt_pk_bf16(acc[6], acc[7]);
        *(uint4*)(dst + k8 * 8) = o;
    }
}
__device__ __forceinline__ void phase_convert(const Ctx& C, float* lds) {
    const int tid = opaque_tid(C.wv), lane = tid & 63, wave = tid >> 6;
    float* scr = lds + wave * (64 * 33);
    const int gw = blockIdx.x * NWAVES + wave, ngw = gridDim.x * NWAVES;
    for (int it = gw; it < CV_TOTAL; it += ngw) convert_item(C, 0, (it < CV_FOLD) ? CV_L + it : it - CV_FOLD, scr, lane);
}
constexpr int CW_BG = 10240;
__device__ __forceinline__ void bg_convert(const Ctx& C, float* lds, volatile LAS unsigned* MISC, int max_batches) {
    const int tid = opaque_tid(C.wv), lane = tid & 63, wave = tid >> 6;
    float* scr = lds + wave * (64 * 33);
    unsigned* head = (unsigned*)(C.ws + WS_CTL) + CW_BG;
    for (int bt = 0; max_batches < 0 || bt < max_batches; ++bt) {
        __syncthreads();
        if (tid == 0) MISC[25] = atomicAdd(head, 8u);
        __syncthreads();
        const int base = (int)MISC[25];
        if (base >= CV_TOTAL) break;
        const int it = base + wave;
        if (it < CV_TOTAL) convert_item(C, 1, (it < CV_FOLD) ? CV_L + it : it - CV_FOLD, scr, lane);
    }
    __syncthreads();
}

__device__ __forceinline__ void phase_ln0(const Ctx& C, int layer) {
    const int tid = opaque_tid(C.wv), lane = tid & 63, wave = tid >> 6;
    const int gw = blockIdx.x * NWAVES + wave, ngw = gridDim.x * NWAVES;
    const float4* g0 = (const float4*)(C.norm_g + ((size_t)layer * 4 + 0) * D);
    for (int r = gw; r < T; r += ngw) {
        const bool isctx = r >= TL; const int b = isctx ? (r - TL) / CTXL : r / SEQ;
        const float4* modp = (const float4*)(C.mod + ((size_t)layer * 17 + (isctx ? 16 : b)) * (NMOD * D));
        const float4* xr = (const float4*)xrow_in(C, layer, r);
        float4 v[4]; float ss = 0.f;
#pragma unroll
        for (int j = 0; j < 4; ++j) { v[j] = xr[lane + 64 * j]; ss += (v[j].x * v[j].x + v[j].y * v[j].y) + (v[j].z * v[j].z + v[j].w * v[j].w); }
        const float rstd = rsqrtf(wave_sum(ss) * (1.f / D) + EPS);
        uint2* o = (uint2*)(C.HX + (size_t)r * D);
#pragma unroll
        for (int j = 0; j < 4; ++j) { const float4 g = g0[lane + 64 * j], sh = modp[lane + 64 * j], sc = modp[256 + lane + 64 * j];
            uint2 w; w.x = pg8::cvt_pk_bf16((v[j].x * rstd * g.x) * (1.f + sc.x) + sh.x, (v[j].y * rstd * g.y) * (1.f + sc.y) + sh.y);
            w.y = pg8::cvt_pk_bf16((v[j].z * rstd * g.z) * (1.f + sc.z) + sh.z, (v[j].w * rstd * g.w) * (1.f + sc.w) + sh.w);
            o[lane + 64 * j] = w; }
    }
}

__device__ __forceinline__ void rope8(pg8::f32x4& v0, pg8::f32x4& v1, LAS const float* tabrow, int fq) {
    const pg8::f32x4 c0 = *(LAS const pg8::f32x4*)tabrow, c1 = *(LAS const pg8::f32x4*)(tabrow + 4), s0 = *(LAS const pg8::f32x4*)(tabrow + 64 * 24), s1 = *(LAS const pg8::f32x4*)(tabrow + 64 * 24 + 4);
    const float cs[8] = {c0.x, c0.y, c0.z, c0.w, c1.x, c1.y, c1.z, c1.w}; const float sn[8] = {s0.x, s0.y, s0.z, s0.w, s1.x, s1.y, s1.z, s1.w};
    const float sg = (fq < 2) ? -1.f : 1.f;
#pragma unroll
    for (int e = 0; e < 8; ++e) {
        const float v = (e < 4) ? v0[e & 3] : v1[e & 3];
        const float pv = xshfl<32>(v);
        const float o = v * cs[e] + pv * (sg * sn[e]);
        if (e < 4) v0[e & 3] = o; else v1[e & 3] = o;
    }
}
__device__ __forceinline__ size_t kimg_off(int r, int hs, int nhs, int nch, int c) { return ((size_t)((r >> 6) * nhs + hs) * nch + c) * 512 + (r & 63) * 8; }
__device__ __forceinline__ size_t vimg_off(int r, int hs, int nhs, int d8) { return (size_t)((r >> 6) * nhs + hs) * 4096 + ((d8 >> 2) * 4 + ((r & 63) >> 4)) * 512 + (r & 15) * 32 + (d8 & 3) * 8; }
constexpr int ROPE_LDS = 131072;
__device__ __forceinline__ void stage_rope_table(LAS unsigned char* lds3, int wv) {
    const int tid = opaque_tid(wv); LAS float* dst = (LAS float*)(lds3 + ROPE_LDS); const float* src = (const float*)&g_rope;
    for (int i = tid; i < 2 * 64 * 24; i += NTHREADS) dst[i] = src[i];
    __syncthreads();
}
struct SchedInProj {
    int G, c, layer; const char* A; const char* W;
    __device__ __forceinline__ bool next(int i, pg8::GUnit& u) const { int pm, pn;
        if ((G & 7) == 0) { const int per = G >> 3; pn = c & 7; pm = (c >> 3) + per * i; if (pm >= T / 256) return false; }
        else if (!pg8::static_tile(i, G, c, T / 256, 8, pm, pn)) return false;
        u.pm = pm; u.pn = pn; u.A = A; u.B = W + (size_t)pn * 256 * 1024 * 2; u.B2 = u.B; u.x0 = 0; u.x1 = 0; return true; }
    __device__ __forceinline__ unsigned arow(const pg8::GUnit& u, int row) const { return (unsigned)(u.pm * 256 + row) * 2048u; }
};
struct EpiInProj {
    static constexpr bool PERM = true;
    bf16_t *CQ, *CKVR, *KA, *QB, *KB, *VB, *QC, *KC, *VC, *U; float *SSQ, *SSK; LAS const float* rtab;
    __device__ __forceinline__ void operator()(const pg8::f32x4 (&acc)[2][2][4][2], const pg8::GUnit& u, int wr, int wc, int fr, int fq) const {
        const int row0 = u.pm * 256 + wr * 64 + fr;
        if (u.pn <= 1) {
            float* SS = (u.pn == 0) ? SSQ : SSK;
#pragma unroll
            for (int ai = 0; ai < 2; ++ai)
#pragma unroll
                for (int m = 0; m < 4; ++m) {
                    float p = 0.f;
#pragma unroll
                    for (int bj = 0; bj < 2; ++bj) { if (bj == 1 && u.pn == 1) continue;
#pragma unroll
                        for (int n = 0; n < 2; ++n) { const pg8::f32x4 a = acc[ai][bj][m][n]; p += (a[0] * a[0] + a[1] * a[1]) + (a[2] * a[2] + a[3] * a[3]); } }
                    p += xshfl<16>(p); p += xshfl<32>(p);
                    if (fq == 0) SS[(size_t)(row0 + ai * 128 + m * 16) * 4 + wc] = p;
                }
        }
#pragma unroll
        for (int bj = 0; bj < 2; ++bj) {
            const int g = u.pn * 8 + bj * 4 + wc;
            bf16_t* dst; int pitch, col; int rope = 0  ; float scale = 1.f; bool zero = false;
            int img = 0  , hs = 0, nhs = 1, nch = 1, cbase = 0;
            if (g < 8) { dst = CQ; pitch = 256; col = g * 32; }
            else if (g < 12) { dst = CKVR; pitch = 256; col = (g - 8) * 32; }
            else if (g < 16) { dst = CKVR; pitch = 256; col = (g - 8) * 32; zero = true; if (g == 12) rope = 1; }
            else if (g < 24) { dst = QB; pitch = 256; col = (g - 16) * 32; rope = 2 + (g & 1); scale = SC_B; }
            else if (g < 28) { dst = KB; pitch = 0; col = 0; rope = 2 + (g & 1); img = 1; hs = (g - 24) >> 1; nhs = 2; nch = 8; cbase = (g & 1) * 4; }
            else if (g < 32) { dst = VB; pitch = 0; col = 0; img = 2; hs = (g - 28) >> 1; nhs = 2; cbase = (g & 1) * 4; }
            else if (g < 40) { dst = QC; pitch = 256; col = (g - 32) * 32; rope = 1; scale = SC_C; }
            else if (g < 48) { dst = KC; pitch = 0; col = 0; rope = 1; img = 1; hs = g - 40; nhs = 8; nch = 4; cbase = 0; }
            else if (g < 56) { dst = VC; pitch = 0; col = 0; img = 2; hs = (g - 48) >> 1; nhs = 4; cbase = (g & 1) * 4; }
            else { dst = U; pitch = 256; col = (g - 56) * 32; }
#pragma unroll
            for (int ai = 0; ai < 2; ++ai)
#pragma unroll
                for (int m = 0; m < 4; ++m) {
                    const int row = row0 + ai * 128 + m * 16;
                    pg8::f32x4 v0 = acc[ai][bj][m][0], v1 = acc[ai][bj][m][1];
                    if (rope) {
                        const int t = row & (SEQ - 1);
                        int p, f0;
                        if (rope == 1) { p = (fq & 1) ? (t & 63) : (t >> 6); f0 = 0; }
                        else { p = (rope == 3) ? (t & 63) : (t >> 6); f0 = 8 + 8 * (fq & 1); }
                        if (row >= TL) { p = 0; }
                        rope8(v0, v1, rtab + p * 24 + f0, fq);
                    }
                    if (g == 12) {
                        pg8::u32x4 w; w.x = pg8::cvt_pk_bf16(v0[0], v0[1]); w.y = pg8::cvt_pk_bf16(v0[2], v0[3]); w.z = pg8::cvt_pk_bf16(v1[0], v1[1]); w.w = pg8::cvt_pk_bf16(v1[2], v1[3]);
#pragma unroll
                        for (int h = 0; h < 4; ++h) *(pg8::u32x4*)(KA + kimg_off(row, h, 4, 12, 8 + fq)) = w;
                    }
                    if (zero) { v0 = (pg8::f32x4){0.f, 0.f, 0.f, 0.f}; v1 = v0; }
                    v0 = v0 * scale; v1 = v1 * scale;
                    pg8::u32x4 w; w.x = pg8::cvt_pk_bf16(v0[0], v0[1]); w.y = pg8::cvt_pk_bf16(v0[2], v0[3]); w.z = pg8::cvt_pk_bf16(v1[0], v1[1]); w.w = pg8::cvt_pk_bf16(v1[2], v1[3]);
                    const size_t off = (img == 0) ? (size_t)row * pitch + col + 8 * fq : (img == 1) ? kimg_off(row, hs, nhs, nch, cbase + fq) : vimg_off(row, hs, nhs, cbase + fq);
                    *(pg8::u32x4*)(dst + off) = w;
                }
        }
    }
};

struct SchedMlaUp {
    int G, c, nQ  , nTot; const char *CQ, *CKVR, *WUQ, *WUKV;
    __device__ __forceinline__ bool next(int i, pg8::GUnit& u) const { const long L = (long)i * G + c; if (L >= nTot) return false;
        const int kind = (L >= nQ) ? 1 : 0, tl = (int)L - kind * nQ; u.pm = tl >> 1; u.pn = tl & 1; u.x0 = kind; u.x1 = 0;
        u.A = kind ? CKVR : CQ; u.B = (kind ? WUKV : WUQ) + (size_t)u.pn * 256 * 256 * 2; u.B2 = u.B; return true; }
    __device__ __forceinline__ unsigned arow(const pg8::GUnit& u, int row) const { return (unsigned)(u.pm * 256 + row) * 512u; }
};
struct EpiMlaUp {
    static constexpr bool PERM = true;
    bf16_t *QA, *KA, *VA; const float *SSQ, *SSK; LAS const float* rtab;
    __device__ __forceinline__ void operator()(const pg8::f32x4 (&acc)[2][2][4][2], const pg8::GUnit& u, int wr, int wc, int fr, int fq) const {
        const int row0 = u.pm * 256 + wr * 64 + fr; const bool kv = u.x0 != 0;
        const float* SS = kv ? SSK : SSQ; const float inv_n = kv ? (1.f / 128) : (1.f / 256);
        float rstd8[2][4];
#pragma unroll
        for (int ai = 0; ai < 2; ++ai)
#pragma unroll
            for (int m = 0; m < 4; ++m) { const float4 pp = *(const float4*)(SS + (size_t)(row0 + ai * 128 + m * 16) * 4); rstd8[ai][m] = rsqrtf(((pp.x + pp.y) + (pp.z + pp.w)) * inv_n + EPS); }
#pragma unroll
        for (int bj = 0; bj < 2; ++bj) {
            const int g = u.pn * 8 + bj * 4 + wc;
            bf16_t* dst; int pitch, col; bool rope = false; float scale = 1.f; int img = 0, hs = 0, cbase = 0;
            if (!kv) { if (g >= 12) continue; const int h = g / 3, part = g % 3; dst = QA; pitch = 384; col = h * 96 + part * 32; rope = (part == 2); scale = SC_A; }
            else { hs = g >> 2; const int part = g & 3; if (part < 2) { dst = KA; img = 1; cbase = part * 4; } else { dst = VA; img = 2; cbase = (part - 2) * 4; } pitch = 0; col = 0; }
#pragma unroll
            for (int ai = 0; ai < 2; ++ai)
#pragma unroll
                for (int m = 0; m < 4; ++m) {
                    const int row = row0 + ai * 128 + m * 16;
                    const float rs = rstd8[ai][m] * scale;
                    pg8::f32x4 v0 = acc[ai][bj][m][0] * rs, v1 = acc[ai][bj][m][1] * rs;
                    if (rope) { const int t = row & (SEQ - 1); int p = (fq & 1) ? (t & 63) : (t >> 6); if (row >= TL) p = 0; rope8(v0, v1, rtab + p * 24, fq); }
                    pg8::u32x4 w; w.x = pg8::cvt_pk_bf16(v0[0], v0[1]); w.y = pg8::cvt_pk_bf16(v0[2], v0[3]); w.z = pg8::cvt_pk_bf16(v1[0], v1[1]); w.w = pg8::cvt_pk_bf16(v1[2], v1[3]);
                    const size_t off = (img == 0) ? (size_t)row * pitch + col + 8 * fq : (img == 1) ? kimg_off(row, hs, 4, 12, cbase + fq) : vimg_off(row, hs, 4, cbase + fq);
                    *(pg8::u32x4*)(dst + off) = w;
                }
        }
    }
};

namespace att {
typedef short bf16x8 __attribute__((ext_vector_type(8)));
typedef short s16x4 __attribute__((ext_vector_type(4)));
typedef float f32x16 __attribute__((ext_vector_type(16)));
typedef unsigned u32x4 __attribute__((ext_vector_type(4)));
constexpr int L_K = 0, KBUF = 12288, L_V = 2 * KBUF, VBUF = 8192, L_WS = L_V + 3 * VBUF, L_OST = L_WS + 2048, OST_W = 8704, L_END = L_OST + 8 * OST_W;
static_assert(L_END <= 131072, "attention LDS");
constexpr float NEG_BIG = -1.0e30f;
__device__ __forceinline__ int crow(int r, int hi) { return (r & 3) + 8 * (r >> 2) + 4 * hi; }
__device__ __forceinline__ s16x4 vtr(LAS const char* p) { typedef short v4i16_t __attribute__((ext_vector_type(4))); return __builtin_bit_cast(s16x4, __builtin_amdgcn_ds_read_tr16_b64_v4i16((LAS v4i16_t*)p)); }
__device__ __forceinline__ float max3f(float a, float b, float c) { float r; asm("v_max3_f32 %0, %1, %2, %3" : "=v"(r) : "v"(a), "v"(b), "v"(c)); return r; }
__device__ __forceinline__ float max2f(float a, float b) { float r; asm("v_max_f32_e32 %0, %1, %2" : "=v"(r) : "v"(a), "v"(b)); return r; }
__device__ __forceinline__ float xhalf_max(float v) { auto rr = __builtin_amdgcn_permlane32_swap(__float_as_uint(v), __float_as_uint(v), false, false); return max2f(__uint_as_float(rr[0]), __uint_as_float(rr[1])); }
__device__ __forceinline__ float xhalf_sum(float v) { auto rr = __builtin_amdgcn_permlane32_swap(__float_as_uint(v), __float_as_uint(v), false, false); return __uint_as_float(rr[0]) + __uint_as_float(rr[1]); }

struct Unit {
    const bf16_t *Q, *K, *V;
    int qpitch, khs, knhs, vhs, vnhs;
    int qrow0, qpos0;
    int ctxrow0;
    int latrow0, latpos0, nlat;
    int window;
    bf16_t* O;
    float sink2;
    float lam, postmul; const float* subln;
    int wv;
    volatile LAS unsigned* misc;
    int pass;
};
#define ATT_BAR() asm volatile("s_waitcnt lgkmcnt(0)\n\ts_barrier" ::: "memory")
template <int NSTEP  , int MODE>
__device__ __forceinline__ void attn_unit(const Unit& U, LAS char* lds) {
    constexpr int NCOMP = 1;
    constexpr int NCH = 2 * NSTEP * NCOMP;
    constexpr float THR = 8.f;
    const int tid = opaque_tid(U.wv), lane = tid & 63, r32 = lane & 31, hi = lane >> 5; const int wid = U.wv;
    const int grp = wid >> 2;
    const int wv = U.wv; volatile LAS unsigned* MISC = U.misc; (void)wv; (void)MISC;
    LAS float* wsf = (LAS float*)(lds + L_WS) + wid * 64;
    bf16x8 qf[NCOMP][NSTEP];
    { const bf16_t* qp = U.Q + (size_t)(U.qrow0 + wid * 32 + r32) * U.qpitch + hi * 8;
#pragma unroll
      for (int c = 0; c < NCOMP; ++c)
#pragma unroll
        for (int d0 = 0; d0 < NSTEP; ++d0) qf[c][d0] = *(const bf16x8*)(qp + c * NSTEP * 16 + d0 * 16); }
    constexpr bool USE_NEGM = (NCOMP == 1);
    float mrow[NCOMP], lrow[NCOMP]; f32x16 o[NCOMP][2], negm[USE_NEGM ? NCOMP : 1], ps0, ps1;
#pragma unroll
    for (int c = 0; c < NCOMP; ++c) { mrow[c] = 0.f; lrow[c] = 0.f; o[c][0] = f32x16{}; o[c][1] = f32x16{}; if (USE_NEGM) negm[c] = f32x16{}; }
    const int NT = 4 + U.nlat;
    constexpr int KPT = (NCH * 64 + NTHREADS - 1) / NTHREADS;
    u32x4 kreg[KPT], vreg;
#define ATT_ROW0(t) (((t) < 4) ? U.ctxrow0 + 64 * (t) : U.latrow0 + 64 * ((t) - 4))
#define ATT_LOAD(t) do { const int tile_ = ATT_ROW0(t) >> 6; const bf16_t* kt_ = U.K + (size_t)(tile_ * U.knhs + U.khs) * (NCH * 512); \
        _Pragma("unroll") for (int i_ = 0; i_ < KPT; ++i_) { const int pi_ = tid + NTHREADS * i_; if (pi_ < NCH * 64) kreg[i_] = *(const u32x4*)(kt_ + pi_ * 8); } \
        vreg = *(const u32x4*)(U.V + (size_t)(tile_ * U.vnhs + U.vhs) * 4096 + tid * 8); } while (0)
#define ATT_WRITE(buf) do { \
        _Pragma("unroll") for (int i_ = 0; i_ < KPT; ++i_) { const int pi_ = tid + NTHREADS * i_; if (pi_ < NCH * 64) *(LAS u32x4*)(lds + L_K + (buf) * KBUF + pi_ * 16) = kreg[i_]; } \
        *(LAS u32x4*)(lds + L_V + (buf) * VBUF + tid * 16) = vreg; } while (0)
    const int qpos = U.qpos0 + wid * 32 + r32;
    auto QS = [&](const int t) __attribute__((always_inline)) {
        const int buf = t & 1;
        bool skip = false; int kpos0 = 0;
        if (MODE == 1 && t >= 4) { kpos0 = U.latpos0 + 64 * (t - 4); const int qw = U.qpos0 + wid * 32; skip = (kpos0 + 63 < qw - U.window) || (kpos0 > qw + 31 + U.window); }
        if (skip) return;
        LAS const char* kb = lds + L_K + buf * KBUF + hi * 1024 + r32 * 16;
#pragma unroll
        for (int c = 0; c < NCOMP; ++c) {
            bf16x8 kf[2 * NSTEP];
#pragma unroll
            for (int d0 = 0; d0 < NSTEP; ++d0) { kf[2 * d0] = *(LAS const bf16x8*)(kb + (c * 2 * NSTEP + 2 * d0) * 1024); kf[2 * d0 + 1] = *(LAS const bf16x8*)(kb + (c * 2 * NSTEP + 2 * d0) * 1024 + 512); }
            __builtin_amdgcn_sched_barrier(0);
#pragma unroll
            for (int d0 = 0; d0 < NSTEP; ++d0) {
                if (d0 == 0) { const f32x16 cin = USE_NEGM ? negm[USE_NEGM ? c : 0] : f32x16{}; ps0 = __builtin_amdgcn_mfma_f32_32x32x16_bf16(kf[0], qf[c][0], cin, 0, 0, 0); ps1 = __builtin_amdgcn_mfma_f32_32x32x16_bf16(kf[1], qf[c][0], cin, 0, 0, 0); }
                else { ps0 = __builtin_amdgcn_mfma_f32_32x32x16_bf16(kf[2 * d0], qf[c][d0], ps0, 0, 0, 0); ps1 = __builtin_amdgcn_mfma_f32_32x32x16_bf16(kf[2 * d0 + 1], qf[c][d0], ps1, 0, 0, 0); }
            }
            asm volatile("s_nop 15\n\ts_nop 7" : "+v"(ps0), "+v"(ps1));
            if (MODE == 1 && t >= 4) {
#pragma unroll
                for (int r = 0; r < 16; ++r) { const int rel0 = kpos0 + crow(r, hi) - qpos;
                    if (rel0 > U.window || rel0 < -U.window) ps0[r] = NEG_BIG;
                    if (rel0 + 32 > U.window || rel0 + 32 < -U.window) ps1[r] = NEG_BIG; }
            }
            if (!USE_NEGM && t > 0) {
#pragma unroll
                for (int r = 0; r < 16; ++r) { ps0[r] -= mrow[c]; ps1[r] -= mrow[c]; } }
            float ma = max3f(ps0[0], ps0[1], ps1[0]), mb = max3f(ps0[2], ps0[3], ps1[1]); ma = max3f(ma, ps1[2], ps1[3]);
#pragma unroll
            for (int r = 4; r < 16; r += 4) { ma = max3f(ma, ps0[r], ps0[r + 1]); mb = max3f(mb, ps0[r + 2], ps0[r + 3]); ma = max3f(ma, ps1[r], ps1[r + 1]); mb = max3f(mb, ps1[r + 2], ps1[r + 3]); }
            float mx = max2f(ma, mb);
            mx = xhalf_max(mx);
            if (t == 0) {
                mrow[c] = mx;
#pragma unroll
                for (int r = 0; r < 16; ++r) { ps0[r] -= mx; ps1[r] -= mx; if (USE_NEGM) negm[USE_NEGM ? c : 0][r] = -mx; }
            } else if (__builtin_expect(__any(mx > THR), 0)) {
                const float dl = fmaxf(mx, 0.f);
                mrow[c] += dl;
#pragma unroll
                for (int r = 0; r < 16; ++r) { ps0[r] -= dl; ps1[r] -= dl; if (USE_NEGM) negm[USE_NEGM ? c : 0][r] = -mrow[c]; }
                const float alpha = __builtin_amdgcn_exp2f(-dl);
                lrow[c] *= alpha;
                if (hi == 0) wsf[r32] = alpha;
#pragma unroll
                for (int g4 = 0; g4 < 4; ++g4) { const pg8::f32x4 a4 = *(LAS const pg8::f32x4*)(wsf + 8 * g4 + 4 * hi);
                    o[c][0][4 * g4 + 0] *= a4.x; o[c][0][4 * g4 + 1] *= a4.y; o[c][0][4 * g4 + 2] *= a4.z; o[c][0][4 * g4 + 3] *= a4.w;
                    o[c][1][4 * g4 + 0] *= a4.x; o[c][1][4 * g4 + 1] *= a4.y; o[c][1][4 * g4 + 2] *= a4.z; o[c][1][4 * g4 + 3] *= a4.w; }
            }
        }
    };
    auto PV = [&](const int t) __attribute__((always_inline)) {
        if (MODE == 1 && t >= 4) { const int kpos0 = U.latpos0 + 64 * (t - 4); const int qw = U.qpos0 + wid * 32; if ((kpos0 + 63 < qw - U.window) || (kpos0 > qw + 31 + U.window)) return; }
        LAS const char* vp = lds + L_V + (t & 1) * VBUF + ((lane >> 4) & 1) * 32 + (lane & 3) * 8 + (4 * hi + ((lane & 15) >> 2)) * 64;
        s16x4 vlo[8], vhi[8];
#pragma unroll
        for (int i = 0; i < 8; ++i) { vlo[i] = vtr(vp + (i >> 2) * 4096 + (i & 3) * 1024); vhi[i] = vtr(vp + (i >> 2) * 4096 + (i & 3) * 1024 + 512); }
        __builtin_amdgcn_sched_barrier(0);
        bf16x8 pa[4];
        {
            float rs[4] = {0.f, 0.f, 0.f, 0.f};
#pragma unroll
            for (int r = 0; r < 16; ++r) { ps0[r] = __builtin_amdgcn_exp2f(ps0[r]); ps1[r] = __builtin_amdgcn_exp2f(ps1[r]); rs[r & 1] += ps0[r]; rs[2 + (r & 1)] += ps1[r]; }
            lrow[0] += xhalf_sum((rs[0] + rs[1]) + (rs[2] + rs[3]));
            typedef float f32x2_t __attribute__((ext_vector_type(2))); typedef __bf16 bf16x2_t __attribute__((ext_vector_type(2)));
#define ATT_PK(a, b) __builtin_bit_cast(unsigned, __builtin_convertvector((f32x2_t){a, b}, bf16x2_t))
            const u32x4 w0 = (u32x4){ATT_PK(ps0[0], ps0[1]), ATT_PK(ps0[2], ps0[3]), ATT_PK(ps0[4], ps0[5]), ATT_PK(ps0[6], ps0[7])};
            const u32x4 w1 = (u32x4){ATT_PK(ps0[8], ps0[9]), ATT_PK(ps0[10], ps0[11]), ATT_PK(ps0[12], ps0[13]), ATT_PK(ps0[14], ps0[15])};
            const u32x4 w2 = (u32x4){ATT_PK(ps1[0], ps1[1]), ATT_PK(ps1[2], ps1[3]), ATT_PK(ps1[4], ps1[5]), ATT_PK(ps1[6], ps1[7])};
            const u32x4 w3 = (u32x4){ATT_PK(ps1[8], ps1[9]), ATT_PK(ps1[10], ps1[11]), ATT_PK(ps1[12], ps1[13]), ATT_PK(ps1[14], ps1[15])};
#undef ATT_PK
            pa[0] = __builtin_bit_cast(bf16x8, w0); pa[1] = __builtin_bit_cast(bf16x8, w1); pa[2] = __builtin_bit_cast(bf16x8, w2); pa[3] = __builtin_bit_cast(bf16x8, w3);
        }
        __builtin_amdgcn_sched_barrier(0);
#pragma unroll
        for (int d0 = 0; d0 < 2; ++d0)
#pragma unroll
            for (int ks = 0; ks < 4; ++ks) {
                const int i = d0 * 4 + ks;
                const bf16x8 vb = (bf16x8){vlo[i][0], vlo[i][1], vlo[i][2], vlo[i][3], vhi[i][0], vhi[i][1], vhi[i][2], vhi[i][3]};
                o[0][d0] = __builtin_amdgcn_mfma_f32_32x32x16_bf16(pa[ks], vb, o[0][d0], 0, 0, 0);
            }
    };
#ifndef ATT_SKEW
#define ATT_SKEW 0
#endif
#if ATT_SKEW
    ATT_LOAD(0); ATT_WRITE(0);
    if (grp == 1 && NT > 1) ATT_LOAD(1);
    __syncthreads();
    if (grp == 0) {
#pragma unroll 1
        for (int t = 0; t < NT; ++t) {
            { STAMP_BEGIN(); if (t + 1 < NT) ATT_LOAD(t + 1);
            QS(t); STAMP_END(16); }
            { STAMP_BEGIN(); ATT_BAR(); STAMP_END(15); }
            { STAMP_BEGIN(); PV(t); STAMP_END(17); }
            { STAMP_BEGIN(); if (t + 1 < NT) ATT_WRITE((t + 1) & 1); STAMP_END(18); }
            { STAMP_BEGIN(); ATT_BAR(); STAMP_END(15); }
        }
        ATT_BAR();
    } else {
        ATT_BAR();
#pragma unroll 1
        for (int t = 0; t < NT; ++t) {
            QS(t);
            if (t + 1 < NT) ATT_WRITE((t + 1) & 1);
            ATT_BAR();
            if (t + 2 < NT) ATT_LOAD(t + 2);
            PV(t);
            ATT_BAR();
        }
    }
#else
    (void)grp;
    ATT_LOAD(0); ATT_WRITE(0);
    __syncthreads();
#pragma unroll 1
    for (int t = 0; t < NT; ++t) {
        if (t + 1 < NT) ATT_LOAD(t + 1);
        QS(t);
        PV(t);
        if (t + 1 < NT) ATT_WRITE((t + 1) & 1);
        ATT_BAR();
    }
#endif
#undef ATT_ROW0
#undef ATT_LOAD
#undef ATT_WRITE
    float fac = (MODE == 1) ? 1.f / (lrow[0] + __builtin_amdgcn_exp2f(U.sink2 - mrow[0])) : 1.f / lrow[0];
    if (MODE == 2 && U.pass == 2) fac *= -U.lam;
    if (hi == 0) wsf[r32] = fac;
    LAS float* stg = (LAS float*)(lds + L_OST + wid * OST_W);
#pragma unroll
    for (int g4 = 0; g4 < 4; ++g4) {
        const pg8::f32x4 f0 = *(LAS const pg8::f32x4*)(wsf + 8 * g4 + 4 * hi);
        const float ff0[4] = {f0.x, f0.y, f0.z, f0.w};
#pragma unroll
        for (int j = 0; j < 4; ++j) { const int r = 4 * g4 + j, orow = crow(r, hi);
#pragma unroll
            for (int d0 = 0; d0 < 2; ++d0) { float v = o[0][d0][r] * ff0[j]; if (MODE == 2 && U.pass == 2) v += stg[orow * 68 + d0 * 32 + r32]; stg[orow * 68 + d0 * 32 + r32] = v; } }
    }
    if (MODE == 2 && U.pass == 1) { __syncthreads(); return; }
    { const int row = lane >> 1, half = lane & 1; float v[32];
#pragma unroll
      for (int k = 0; k < 8; ++k) { const pg8::f32x4 x = *(LAS const pg8::f32x4*)(stg + row * 68 + half * 32 + 4 * k); v[4 * k] = x.x; v[4 * k + 1] = x.y; v[4 * k + 2] = x.z; v[4 * k + 3] = x.w; }
      if (MODE == 2) { float ss = 0.f;
#pragma unroll
          for (int k = 0; k < 32; ++k) ss += v[k] * v[k];
          ss += xshfl<1>(ss);
          const float rstd = rsqrtf(ss * (1.f / 64) + EPS) * U.postmul;
#pragma unroll
          for (int k = 0; k < 32; ++k) v[k] = v[k] * rstd * U.subln[half * 32 + k]; }
      bf16_t* op = U.O + (size_t)(U.qrow0 + wid * 32 + row) * 1024 + half * 32;
#pragma unroll
      for (int k = 0; k < 4; ++k) { u32x4 w; w.x = pg8::cvt_pk_bf16(v[8 * k], v[8 * k + 1]); w.y = pg8::cvt_pk_bf16(v[8 * k + 2], v[8 * k + 3]); w.z = pg8::cvt_pk_bf16(v[8 * k + 4], v[8 * k + 5]); w.w = pg8::cvt_pk_bf16(v[8 * k + 6], v[8 * k + 7]);
          *(u32x4*)(op + 8 * k) = w; } }
    __syncthreads();
}
#undef ATT_BAR

#define ATT_BAR() asm volatile("s_waitcnt lgkmcnt(0)\n\ts_barrier" ::: "memory")
template <int NSTEP  , int MODE>
__device__ __forceinline__ void attn_unit_p(const Unit& U, LAS char* lds) {
    constexpr int NCH = 2 * NSTEP, NG = 2 * NSTEP, IPG = 48 / NG;
    static_assert(48 % NG == 0, "work items per gap");
    constexpr float THR = 8.f;
    const int tid = opaque_tid(U.wv), lane = tid & 63, r32 = lane & 31, hi = lane >> 5; const int wid = U.wv;
    LAS float* wsf = (LAS float*)(lds + L_WS) + wid * 64;
    const int wv = U.wv; volatile LAS unsigned* MISC = U.misc; (void)wv; (void)MISC;
    bf16x8 qf[NSTEP];
    { const bf16_t* qp = U.Q + (size_t)(U.qrow0 + wid * 32 + r32) * U.qpitch + hi * 8;
#pragma unroll
      for (int d0 = 0; d0 < NSTEP; ++d0) qf[d0] = *(const bf16x8*)(qp + d0 * 16); }
    constexpr bool USE_LACC = (ATT_DEFER != 0) && (NSTEP < ATT_LACC_MAX);
    float mrow = 0.f, lrow = 0.f; f32x16 o0 = f32x16{}, o1 = f32x16{}, negm = f32x16{}, pA0, pA1, pB0 = f32x16{}, pB1 = f32x16{}, lacc = f32x16{};
    const bf16x8 ones = (bf16x8){0x3f80, 0x3f80, 0x3f80, 0x3f80, 0x3f80, 0x3f80, 0x3f80, 0x3f80};
    const int NT = 4 + U.nlat;
    constexpr int KPT = (NCH * 64 + NTHREADS - 1) / NTHREADS;
    constexpr bool DEEP = (ATT_DEFER != 0) && (NSTEP < ATT_DEEP_MAX);
    u32x4 kreg[KPT], vreg, kreg2[DEEP ? KPT : 1], vreg2;
#define ATP_TILE(t) ((((t) < 4) ? U.ctxrow0 + 64 * (t) : U.latrow0 + 64 * ((t) - 4)) >> 6)
#define ATP_LOADK(t, KR) do { const bf16_t* kt_ = U.K + (size_t)(ATP_TILE(t) * U.knhs + U.khs) * (NCH * 512); \
        _Pragma("unroll") for (int i_ = 0; i_ < KPT; ++i_) { const int pi_ = (tid + NTHREADS * i_) % (NCH * 64); KR[i_] = *(const u32x4*)(kt_ + pi_ * 8); } } while (0)
#define ATP_LOADV(t, VR) do { VR = *(const u32x4*)(U.V + (size_t)(ATP_TILE(t) * U.vnhs + U.vhs) * 4096 + tid * 8); } while (0)
#define ATP_WRITEK(buf, KR) do { _Pragma("unroll") for (int i_ = 0; i_ < KPT; ++i_) { const int pi_ = tid + NTHREADS * i_; if (pi_ < NCH * 64) *(LAS u32x4*)(lds + L_K + (buf) * KBUF + pi_ * 16) = KR[i_]; } } while (0)
#define ATP_WRITEV(buf, VR) do { *(LAS u32x4*)(lds + L_V + (buf) * VBUF + tid * 16) = VR; } while (0)
    const int qpos = U.qpos0 + wid * 32 + r32;
    typedef float f32x2_t __attribute__((ext_vector_type(2))); typedef __bf16 bf16x2_t __attribute__((ext_vector_type(2)));
#define ATP_PK(a, b) __builtin_bit_cast(unsigned, __builtin_convertvector((f32x2_t){a, b}, bf16x2_t))
#define ATP_EXP(x) asm volatile("v_exp_f32_e32 %0, %0" : "+v"(x))
#define ATP_ADD(acc, x) asm volatile("v_add_f32_e32 %0, %1, %0" : "+v"(acc) : "v"(x))
    auto MASK = [&](f32x16& p0, f32x16& p1, const int t) __attribute__((always_inline)) {
        if (MODE == 1 && t >= 4) { const int kpos0 = U.latpos0 + 64 * (t - 4);
#pragma unroll
            for (int r = 0; r < 16; ++r) { const int rel0 = kpos0 + crow(r, hi) - qpos;
                if (rel0 > U.window || rel0 < -U.window) p0[r] = NEG_BIG;
                if (rel0 + 32 > U.window || rel0 + 32 < -U.window) p1[r] = NEG_BIG; } } };
    auto DECIDE = [&](f32x16& p0, f32x16& p1, const float mx, const bool first) __attribute__((always_inline)) {
        if (first) { mrow = mx;
#pragma unroll
            for (int r = 0; r < 16; ++r) { p0[r] -= mx; p1[r] -= mx; negm[r] = -mx; }
        } else if (__builtin_expect(__any(mx > THR), 0)) {
            const float dl = fmaxf(mx, 0.f); mrow += dl;
#pragma unroll
            for (int r = 0; r < 16; ++r) { p0[r] -= dl; p1[r] -= dl; negm[r] = -mrow; }
            const float alpha = __builtin_amdgcn_exp2f(-dl); lrow *= alpha;
            if (hi == 0) wsf[r32] = alpha;
#pragma unroll
            for (int g4 = 0; g4 < 4; ++g4) { const pg8::f32x4 a4 = *(LAS const pg8::f32x4*)(wsf + 8 * g4 + 4 * hi);
                o0[4 * g4 + 0] *= a4.x; o0[4 * g4 + 1] *= a4.y; o0[4 * g4 + 2] *= a4.z; o0[4 * g4 + 3] *= a4.w;
                o1[4 * g4 + 0] *= a4.x; o1[4 * g4 + 1] *= a4.y; o1[4 * g4 + 2] *= a4.z; o1[4 * g4 + 3] *= a4.w;
                if (USE_LACC) { lacc[4 * g4 + 0] *= a4.x; lacc[4 * g4 + 1] *= a4.y; lacc[4 * g4 + 2] *= a4.z; lacc[4 * g4 + 3] *= a4.w; } } } };
    ATP_LOADK(0, kreg); ATP_LOADV(0, vreg); ATP_WRITEK(0, kreg); ATP_WRITEV(0, vreg);
    ATP_LOADK(1, kreg); ATP_WRITEK(1, kreg);
    if (DEEP) { ATP_LOADK(2, kreg); ATP_LOADV(1, vreg); }
    __syncthreads();
    { LAS const char* kb = lds + L_K + hi * 1024 + r32 * 16;
#pragma unroll
      for (int d0 = 0; d0 < NSTEP; ++d0) { const bf16x8 b0 = *(LAS const bf16x8*)(kb + 2 * d0 * 1024), b1 = *(LAS const bf16x8*)(kb + 2 * d0 * 1024 + 512);
          if (d0 == 0) { pA0 = __builtin_amdgcn_mfma_f32_32x32x16_bf16(b0, qf[0], negm, 0, 0, 0); pA1 = __builtin_amdgcn_mfma_f32_32x32x16_bf16(b1, qf[0], negm, 0, 0, 0); }
          else { pA0 = __builtin_amdgcn_mfma_f32_32x32x16_bf16(b0, qf[d0], pA0, 0, 0, 0); pA1 = __builtin_amdgcn_mfma_f32_32x32x16_bf16(b1, qf[d0], pA1, 0, 0, 0); } }
      asm volatile("s_nop 15\n\ts_nop 7" : "+v"(pA0), "+v"(pA1));
      MASK(pA0, pA1, 0);
      float ma = max3f(pA0[0], pA0[1], pA1[0]), mb = max3f(pA0[2], pA0[3], pA1[1]); ma = max3f(ma, pA1[2], pA1[3]);
#pragma unroll
      for (int r = 4; r < 16; r += 4) { ma = max3f(ma, pA0[r], pA0[r + 1]); mb = max3f(mb, pA0[r + 2], pA0[r + 3]); ma = max3f(ma, pA1[r], pA1[r + 1]); mb = max3f(mb, pA1[r + 2], pA1[r + 3]); }
      DECIDE(pA0, pA1, xhalf_max(max2f(ma, mb)), true); }
#if ATT_DEFER
    u32x4 pp0 = (u32x4){0u, 0u, 0u, 0u}, pp1 = pp0, pp2 = pp0, pp3 = pp0;
    auto STEP = [&](f32x16& C0, f32x16& C1, f32x16& N0, f32x16& N1, const int t, u32x4 (&kW)[KPT], u32x4& vW, u32x4 (&kL)[DEEP ? KPT : 1], u32x4& vL) __attribute__((always_inline)) {
        constexpr int NF = NG + 8, NM = NF + (USE_LACC ? 4 : 0);
        const bool hn = (t + 1 < NT);
        if (DEEP) { ATP_LOADK(min(t + 3, NT - 1), kL); ATP_LOADV(min(t + 2, NT - 1), vL); }
        else { if (t + 2 < NT) ATP_LOADK(t + 2, kW); if (hn) ATP_LOADV(t + 1, vW); }
        const int vbp = (t == 0) ? 0 : (t - 1) % 3;
        LAS const char* kb = lds + L_K + ((t + 1) & 1) * KBUF + hi * 1024 + r32 * 16;
        LAS const char* vp = lds + L_V + vbp * VBUF + ((lane >> 4) & 1) * 32 + (lane & 3) * 8 + (4 * hi + ((lane & 15) >> 2)) * 64;
        unsigned pw[16]; float rs0 = 0.f, rs1 = 0.f, ma = 0.f, mb = 0.f;
        bf16x8 fr[NF];
#define ATP_LOADF(i) do { if ((i) < NG) fr[(i)] = *(LAS const bf16x8*)(kb + (2 * ((i) >> 1)) * 1024 + ((i) & 1) * 512); \
            else { const int j_ = (i) - NG; const s16x4 lo_ = vtr(vp + (j_ & 1) * 4096 + (j_ >> 1) * 1024), hi_ = vtr(vp + (j_ & 1) * 4096 + (j_ >> 1) * 1024 + 512); \
                   fr[(i)] = (bf16x8){lo_[0], lo_[1], lo_[2], lo_[3], hi_[0], hi_[1], hi_[2], hi_[3]}; } } while (0)
        constexpr int PF = (NSTEP >= 6) ? 1 : 2;
        constexpr int PER = USE_LACC ? 3 : 2;
        ATP_LOADF(0); if (PF > 1) ATP_LOADF(1);
#pragma unroll
        for (int idx = 0; idx < NM; ++idx) {
            const int m = idx - NG, kk = (m >= 0) ? m / PER : 0, sub = (m >= 0) ? m % PER : 0;
            const int f = (idx < NG) ? idx : ((sub < 2) ? NG + 2 * kk + sub : -1);
            if (f >= 0 && f + PF < NF) ATP_LOADF(f + PF);
            if (idx < NG) {
                if (idx == 0) N0 = __builtin_amdgcn_mfma_f32_32x32x16_bf16(fr[idx], qf[0], negm, 0, 0, 0);
                else if (idx == 1) N1 = __builtin_amdgcn_mfma_f32_32x32x16_bf16(fr[idx], qf[0], negm, 0, 0, 0);
                else if ((idx & 1) == 0) N0 = __builtin_amdgcn_mfma_f32_32x32x16_bf16(fr[idx], qf[idx >> 1], N0, 0, 0, 0);
                else N1 = __builtin_amdgcn_mfma_f32_32x32x16_bf16(fr[idx], qf[idx >> 1], N1, 0, 0, 0);
            } else {
                const u32x4 pq = (kk == 0) ? pp0 : (kk == 1) ? pp1 : (kk == 2) ? pp2 : pp3;
                if (sub == 0) o0 = __builtin_amdgcn_mfma_f32_32x32x16_bf16(__builtin_bit_cast(bf16x8, pq), fr[f >= 0 ? f : 0], o0, 0, 0, 0);
                else if (sub == 1) o1 = __builtin_amdgcn_mfma_f32_32x32x16_bf16(__builtin_bit_cast(bf16x8, pq), fr[f >= 0 ? f : 0], o1, 0, 0, 0);
                else lacc = __builtin_amdgcn_mfma_f32_32x32x16_bf16(__builtin_bit_cast(bf16x8, pq), ones, lacc, 0, 0, 0);
                if (m == 2) { asm volatile("s_nop 15\n\ts_nop 7" : "+v"(N0), "+v"(N1)); MASK(N0, N1, t + 1);
                              ma = max3f(N0[0], N0[1], N1[0]); mb = max3f(N0[2], N0[3], N1[1]); ma = max3f(ma, N1[2], N1[3]); }
                else if (m >= 3 && m < 6) { const int r = 4 * (m - 2); ma = max3f(ma, N0[r], N0[r + 1]); mb = max3f(mb, N0[r + 2], N0[r + 3]); ma = max3f(ma, N1[r], N1[r + 1]); mb = max3f(mb, N1[r + 2], N1[r + 3]); }
            }
#pragma unroll
            for (int it = idx * 48 / NM; it < (idx + 1) * 48 / NM; ++it) {
                if (it < 16) { ATP_EXP(C0[it]); if (!USE_LACC && it > 0) { if (it & 1) ATP_ADD(rs0, C0[it - 1]); else ATP_ADD(rs1, C0[it - 1]); } }
                else if (it < 32) { ATP_EXP(C1[it - 16]); if (!USE_LACC) { if (it == 16) ATP_ADD(rs1, C0[15]); else if (it & 1) ATP_ADD(rs0, C1[it - 17]); else ATP_ADD(rs1, C1[it - 17]); } }
                else { const int k = it - 32; if (!USE_LACC && k == 0) ATP_ADD(rs1, C1[15]);
                       pw[k] = (k < 8) ? ATP_PK(C0[2 * k], C0[2 * k + 1]) : ATP_PK(C1[2 * (k - 8)], C1[2 * (k - 8) + 1]); }
            }
            __builtin_amdgcn_sched_barrier(0);
        }
#undef ATP_LOADF
        if (!USE_LACC) lrow += xhalf_sum(rs0 + rs1);
        if (hn) {
            const float mx = xhalf_max(max2f(ma, mb));
            if (__builtin_expect(__any(mx > THR), 0)) {
                const float al = __builtin_amdgcn_exp2f(-fmaxf(mx, 0.f));
#pragma unroll
                for (int k = 0; k < 16; ++k) { const float lo_ = __uint_as_float(pw[k] << 16) * al, hi_ = __uint_as_float(pw[k] & 0xffff0000u) * al; pw[k] = ATP_PK(lo_, hi_); }
            }
            DECIDE(N0, N1, mx, false);
        }
        pp0 = (u32x4){pw[0], pw[1], pw[2], pw[3]}; pp1 = (u32x4){pw[4], pw[5], pw[6], pw[7]}; pp2 = (u32x4){pw[8], pw[9], pw[10], pw[11]}; pp3 = (u32x4){pw[12], pw[13], pw[14], pw[15]};
        if (t + 2 < NT) ATP_WRITEK(t & 1, kW);
        if (hn) ATP_WRITEV((t + 1) % 3, vW);
        ATT_BAR();
    };
#else
    auto STEP = [&](f32x16& C0, f32x16& C1, f32x16& N0, f32x16& N1, const int t) __attribute__((always_inline)) {
        const bool hn = (t + 1 < NT);
        if (t + 2 < NT) ATP_LOADK(t + 2, kreg);
        if (hn) ATP_LOADV(t + 1, vreg);
        LAS const char* kb = lds + L_K + ((t + 1) & 1) * KBUF + hi * 1024 + r32 * 16;
        LAS const char* vp = lds + L_V + (t & 1) * VBUF + ((lane >> 4) & 1) * 32 + (lane & 3) * 8 + (4 * hi + ((lane & 15) >> 2)) * 64;
        unsigned pw[16]; float rs0 = 0.f, rs1 = 0.f;
        bf16x8 kcur = *(LAS const bf16x8*)(kb);
#pragma unroll
        for (int g = 0; g < NG; ++g) {
            bf16x8 knext = kcur;
            if (g + 1 < NG) knext = *(LAS const bf16x8*)(kb + (2 * ((g + 1) >> 1)) * 1024 + ((g + 1) & 1) * 512);
            if (g == 0) N0 = __builtin_amdgcn_mfma_f32_32x32x16_bf16(kcur, qf[0], negm, 0, 0, 0);
            else if (g == 1) N1 = __builtin_amdgcn_mfma_f32_32x32x16_bf16(kcur, qf[0], negm, 0, 0, 0);
            else if ((g & 1) == 0) N0 = __builtin_amdgcn_mfma_f32_32x32x16_bf16(kcur, qf[g >> 1], N0, 0, 0, 0);
            else N1 = __builtin_amdgcn_mfma_f32_32x32x16_bf16(kcur, qf[g >> 1], N1, 0, 0, 0);
#pragma unroll
            for (int it = g * IPG; it < (g + 1) * IPG; ++it) {
                if (it < 16) { C0[it] = __builtin_amdgcn_exp2f(C0[it]); rs0 += C0[it]; }
                else if (it < 32) { C1[it - 16] = __builtin_amdgcn_exp2f(C1[it - 16]); rs1 += C1[it - 16]; }
                else { const int k = it - 32; pw[k] = (k < 8) ? ATP_PK(C0[2 * k], C0[2 * k + 1]) : ATP_PK(C1[2 * (k - 8)], C1[2 * (k - 8) + 1]); }
            }
            kcur = knext;
            __builtin_amdgcn_sched_barrier(0);
        }
        lrow += xhalf_sum(rs0 + rs1);
        const bf16x8 pa0 = __builtin_bit_cast(bf16x8, (u32x4){pw[0], pw[1], pw[2], pw[3]}), pa1 = __builtin_bit_cast(bf16x8, (u32x4){pw[4], pw[5], pw[6], pw[7]}),
                     pa2 = __builtin_bit_cast(bf16x8, (u32x4){pw[8], pw[9], pw[10], pw[11]}), pa3 = __builtin_bit_cast(bf16x8, (u32x4){pw[12], pw[13], pw[14], pw[15]});
        asm volatile("s_nop 15\n\ts_nop 7" : "+v"(N0), "+v"(N1)); MASK(N0, N1, t + 1);
        float ma = 0.f, mb = 0.f;
        s16x4 vlo = vtr(vp), vhi = vtr(vp + 512);
#pragma unroll
        for (int j = 0; j < 8; ++j) {
            s16x4 nlo = vlo, nhi = vhi;
            if (j + 1 < 8) { nlo = vtr(vp + ((j + 1) >> 2) * 4096 + ((j + 1) & 3) * 1024); nhi = vtr(vp + ((j + 1) >> 2) * 4096 + ((j + 1) & 3) * 1024 + 512); }
            const bf16x8 vb = (bf16x8){vlo[0], vlo[1], vlo[2], vlo[3], vhi[0], vhi[1], vhi[2], vhi[3]};
            const bf16x8 pa = ((j & 3) == 0) ? pa0 : ((j & 3) == 1) ? pa1 : ((j & 3) == 2) ? pa2 : pa3;
            if (j < 4) o0 = __builtin_amdgcn_mfma_f32_32x32x16_bf16(pa, vb, o0, 0, 0, 0); else o1 = __builtin_amdgcn_mfma_f32_32x32x16_bf16(pa, vb, o1, 0, 0, 0);
            if (j == 0) { ma = max3f(N0[0], N0[1], N1[0]); mb = max3f(N0[2], N0[3], N1[1]); ma = max3f(ma, N1[2], N1[3]); }
            else if (j < 4) { const int r = 4 * j; ma = max3f(ma, N0[r], N0[r + 1]); mb = max3f(mb, N0[r + 2], N0[r + 3]); ma = max3f(ma, N1[r], N1[r + 1]); mb = max3f(mb, N1[r + 2], N1[r + 3]); }
            vlo = nlo; vhi = nhi;
            __builtin_amdgcn_sched_barrier(0);
        }
        if (hn) DECIDE(N0, N1, xhalf_max(max2f(ma, mb)), false);
        if (t + 2 < NT) ATP_WRITEK(t & 1, kreg);
        if (hn) ATP_WRITEV((t + 1) & 1, vreg);
        ATT_BAR();
    };
#endif
#pragma unroll 1
#if ATT_DEFER
    for (int t = 0; t < NT; t += 2) {
        if constexpr (DEEP) { STEP(pA0, pA1, pB0, pB1, t, kreg, vreg, kreg2, vreg2); STEP(pB0, pB1, pA0, pA1, t + 1, kreg2, vreg2, kreg, vreg); }
        else { STEP(pA0, pA1, pB0, pB1, t, kreg, vreg, kreg2, vreg2); STEP(pB0, pB1, pA0, pA1, t + 1, kreg, vreg, kreg2, vreg2); } }
#else
    for (int t = 0; t < NT; t += 2) { STEP(pA0, pA1, pB0, pB1, t); STEP(pB0, pB1, pA0, pA1, t + 1); }
#endif
#if ATT_DEFER
    {
        LAS const char* vp = lds + L_V + ((NT - 1) % 3) * VBUF + ((lane >> 4) & 1) * 32 + (lane & 3) * 8 + (4 * hi + ((lane & 15) >> 2)) * 64;
        s16x4 vlo[8], vhi[8];
#pragma unroll
        for (int i = 0; i < 8; ++i) { vlo[i] = vtr(vp + (i >> 2) * 4096 + (i & 3) * 1024); vhi[i] = vtr(vp + (i >> 2) * 4096 + (i & 3) * 1024 + 512); }
#pragma unroll
        for (int j = 0; j < 8; ++j) {
            const bf16x8 vb = (bf16x8){vlo[j][0], vlo[j][1], vlo[j][2], vlo[j][3], vhi[j][0], vhi[j][1], vhi[j][2], vhi[j][3]};
            const u32x4 pq = ((j & 3) == 0) ? pp0 : ((j & 3) == 1) ? pp1 : ((j & 3) == 2) ? pp2 : pp3;
            if (j < 4) o0 = __builtin_amdgcn_mfma_f32_32x32x16_bf16(__builtin_bit_cast(bf16x8, pq), vb, o0, 0, 0, 0);
            else o1 = __builtin_amdgcn_mfma_f32_32x32x16_bf16(__builtin_bit_cast(bf16x8, pq), vb, o1, 0, 0, 0);
        }
        if (USE_LACC) { lacc = __builtin_amdgcn_mfma_f32_32x32x16_bf16(__builtin_bit_cast(bf16x8, pp0), ones, lacc, 0, 0, 0); lacc = __builtin_amdgcn_mfma_f32_32x32x16_bf16(__builtin_bit_cast(bf16x8, pp1), ones, lacc, 0, 0, 0);
                        lacc = __builtin_amdgcn_mfma_f32_32x32x16_bf16(__builtin_bit_cast(bf16x8, pp2), ones, lacc, 0, 0, 0); lacc = __builtin_amdgcn_mfma_f32_32x32x16_bf16(__builtin_bit_cast(bf16x8, pp3), ones, lacc, 0, 0, 0); }
    }
#endif
#undef ATP_TILE
#undef ATP_LOADK
#undef ATP_LOADV
#undef ATP_WRITEK
#undef ATP_WRITEV
#undef ATP_PK
#undef ATP_EXP
#undef ATP_ADD
    const int tid_e = opaque_tid(U.wv), lane_e = tid_e & 63, r32_e = lane_e & 31, hi_e = lane_e >> 5;
    LAS float* wsf_e = (LAS float*)(lds + L_WS) + wid * 64;
    float fac = USE_LACC ? ((MODE == 1) ? __builtin_amdgcn_exp2f(U.sink2 - mrow) : 0.f) : ((MODE == 1) ? 1.f / (lrow + __builtin_amdgcn_exp2f(U.sink2 - mrow)) : 1.f / lrow);
    if (!USE_LACC && MODE == 2 && U.pass == 2) fac *= -U.lam;
    if (!USE_LACC || MODE == 1) { if (hi_e == 0) wsf_e[r32_e] = fac; }
    LAS float* stg = (LAS float*)(lds + L_OST + wid * OST_W);
#pragma unroll
    for (int g4 = 0; g4 < 4; ++g4) {
        pg8::f32x4 f0 = (pg8::f32x4){0.f, 0.f, 0.f, 0.f};
        if (!USE_LACC || MODE == 1) f0 = *(LAS const pg8::f32x4*)(wsf_e + 8 * g4 + 4 * hi_e);
        float ff0[4] = {f0.x, f0.y, f0.z, f0.w};
        if (USE_LACC) {
#pragma unroll
            for (int j = 0; j < 4; ++j) { ff0[j] = 1.f / (lacc[4 * g4 + j] + ff0[j]); if (MODE == 2 && U.pass == 2) ff0[j] *= -U.lam; } }
#pragma unroll
        for (int j = 0; j < 4; ++j) { const int r = 4 * g4 + j, orow = crow(r, hi_e);
            float v0 = o0[r] * ff0[j], v1 = o1[r] * ff0[j];
            if (MODE == 2 && U.pass == 2) { v0 += stg[orow * 68 + r32_e]; v1 += stg[orow * 68 + 32 + r32_e]; }
            stg[orow * 68 + r32_e] = v0; stg[orow * 68 + 32 + r32_e] = v1; }
    }
    if (MODE == 2 && U.pass == 1) { __syncthreads(); return; }
    { const int row = lane_e >> 1, half = lane_e & 1; float v[32];
#pragma unroll
      for (int k = 0; k < 8; ++k) { const pg8::f32x4 x = *(LAS const pg8::f32x4*)(stg + row * 68 + half * 32 + 4 * k); v[4 * k] = x.x; v[4 * k + 1] = x.y; v[4 * k + 2] = x.z; v[4 * k + 3] = x.w; }
      if (MODE == 2) { float ss = 0.f;
#pragma unroll
          for (int k = 0; k < 32; ++k) ss += v[k] * v[k];
          ss += xshfl<1>(ss);
          const float rstd = rsqrtf(ss * (1.f / 64) + EPS) * U.postmul;
#pragma unroll
          for (int k = 0; k < 32; ++k) v[k] = v[k] * rstd * U.subln[half * 32 + k]; }
      bf16_t* op = U.O + (size_t)(U.qrow0 + wid * 32 + row) * 1024 + half * 32;
#pragma unroll
      for (int k = 0; k < 4; ++k) { u32x4 w; w.x = pg8::cvt_pk_bf16(v[8 * k], v[8 * k + 1]); w.y = pg8::cvt_pk_bf16(v[8 * k + 2], v[8 * k + 3]); w.z = pg8::cvt_pk_bf16(v[8 * k + 4], v[8 * k + 5]); w.w = pg8::cvt_pk_bf16(v[8 * k + 6], v[8 * k + 7]);
          *(u32x4*)(op + 8 * k) = w; } }
    __syncthreads();
}
#undef ATT_BAR
}

__device__ __forceinline__ void phase_attn(const Ctx& C, int layer, LAS char* lds, volatile LAS unsigned* MISC) {
    const int wv = C.wv; (void)wv;
    const int G = gridDim.x, bx = blockIdx.x;
    const int vcu = (G % 8 == 0) ? (bx % 8) * (G / 8) + bx / 8 : bx;
    float lam;
    { const float* dl = C.dlam + (size_t)layer * 128; float s1 = 0.f, s2 = 0.f; for (int i = 0; i < 32; ++i) { s1 += dl[i] * dl[32 + i]; s2 += dl[64 + i] * dl[96 + i]; }
      lam = expf(s1) - expf(s2) + lam_init_of(layer); }
    const bool has_ctx_q = layer < DEPTH - 1;
    const int NLAT = BATCH * 4 * (SEQ / 256);
    const int NCTXU = has_ctx_q ? BATCH * 4 : 0;
    const int ntot = 3 * NLAT + 3 * NCTXU;
#pragma unroll 1
    for (int uidx = vcu; uidx < ntot; uidx += G) {
        int kind, b, h, qb; bool cq;
        if (uidx < 3 * NLAT) { kind = uidx / NLAT; const int r = uidx % NLAT; b = r / 32; h = (r / 8) & 3; qb = r & 7; cq = false; }
        else { const int r2 = uidx - 3 * NLAT; kind = r2 / NCTXU; const int r = r2 % NCTXU; b = r >> 2; h = r & 3; qb = 0; cq = true; }
        STAMP_BEGIN();
        att::Unit U;
        U.qrow0 = cq ? TL + b * CTXL : b * SEQ + qb * 256; U.qpos0 = cq ? 0 : qb * 256; U.ctxrow0 = TL + b * CTXL;
        U.latrow0 = b * SEQ; U.latpos0 = 0; U.nlat = cq ? 0 : SEQ / 64; U.window = -1; U.sink2 = 0.f; U.lam = 0.f; U.postmul = 1.f; U.subln = nullptr; U.pass = 0; U.wv = C.wv; U.misc = MISC;
        if (kind == 0) {
            U.V = C.VC; U.vhs = h; U.vnhs = 4; U.qpitch = 256; U.K = C.KC; U.knhs = 8; U.O = C.O + 512 + h * 64;
            U.lam = lam; U.postmul = 1.f - lam_init_of(layer); U.subln = C.subln + layer * 64;
            U.Q = C.QC + h * 64; U.khs = 2 * h; U.pass = 1;
            if (ATT_PIPE) att::attn_unit_p<2, 2>(U, lds); else att::attn_unit<2, 2>(U, lds);
            U.Q = C.QC + h * 64 + 32; U.khs = 2 * h + 1; U.pass = 2;
            if (ATT_PIPE) att::attn_unit_p<2, 2>(U, lds); else att::attn_unit<2, 2>(U, lds); STAMP_END(12);
        } else if (kind == 1) {
            U.Q = C.QA + h * 96; U.K = C.KA; U.khs = h; U.knhs = 4; U.V = C.VA; U.vhs = h; U.vnhs = 4; U.qpitch = 384; U.O = C.O + h * 64;
            if (ATT_PIPE) att::attn_unit_p<6, 0>(U, lds); else att::attn_unit<6, 0>(U, lds); STAMP_END(13);
        } else {
            const int kvh = h >> 1;
            U.Q = C.QB + h * 64; U.K = C.KB; U.khs = kvh; U.knhs = 2; U.V = C.VB; U.vhs = kvh; U.vnhs = 2; U.qpitch = 256; U.O = C.O + 256 + h * 64;
            U.sink2 = C.sink[layer * 4 + h] * LOG2E;
            if (!cq) { U.window = 128; const int p0 = max(qb * 256 - 128, 0), p1 = min(qb * 256 + 256 + 128, SEQ); U.latpos0 = p0; U.latrow0 = b * SEQ + p0; U.nlat = (p1 - p0) / 64; }
            if (ATT_PIPE) att::attn_unit_p<4, 1>(U, lds); else att::attn_unit<4, 1>(U, lds); STAMP_END(14);
        }
    }
    {
        STAMP_BEGIN();
        const int tid = opaque_tid(C.wv);
        const int nrows = has_ctx_q ? T : TL;
        for (int idx = blockIdx.x * NTHREADS + tid; idx < nrows * 32; idx += gridDim.x * NTHREADS) {
            const int r = idx >> 5, ch = idx & 31, g = ch >> 3;
            const bool isctx = r >= TL; const int t = isctx ? (r - TL) % CTXL : r % SEQ;
            const int w = 2 << g, half = w >> 1, L = isctx ? CTXL : SEQ;
            const int lo = max(t - half, 0), hi = min(t - half + w, L);
            const bf16_t* base = C.U + (size_t)(r - t) * 256 + ch * 8;
            float acc[8];
#pragma unroll
            for (int j = 0; j < 8; ++j) acc[j] = 0.f;
            const uint4 sv = *(const uint4*)(base + (size_t)t * 256); const unsigned swv[4] = {sv.x, sv.y, sv.z, sv.w};
#pragma unroll 1
            for (int k0 = 0; k0 < 16; k0 += 8) {
                uint4 v[8];
#pragma unroll
                for (int k = 0; k < 8; ++k) { const int p = min(lo + k0 + k, hi - 1); v[k] = *(const uint4*)(base + (size_t)p * 256); }
#pragma unroll
                for (int k = 0; k < 8; ++k) { const float m = (lo + k0 + k < hi) ? 1.f : 0.f; const unsigned wv[4] = {v[k].x, v[k].y, v[k].z, v[k].w};
#pragma unroll
                    for (int j = 0; j < 4; ++j) { acc[2 * j] += m * __uint_as_float(wv[j] << 16); acc[2 * j + 1] += m * __uint_as_float(wv[j] & 0xffff0000u); } }
            }
            const float inv = 1.f / (float)(hi - lo);
            uint4 o; unsigned ow[4];
#pragma unroll
            for (int j = 0; j < 4; ++j) ow[j] = pg8::cvt_pk_bf16(acc[2 * j] * inv - __uint_as_float(swv[j] << 16), acc[2 * j + 1] * inv - __uint_as_float(swv[j] & 0xffff0000u));
            o.x = ow[0]; o.y = ow[1]; o.z = ow[2]; o.w = ow[3];
            *(uint4*)(C.O + (size_t)r * D + 768 + ch * 8) = o;
        }
        STAMP_END(11);
    }
}

struct SchedRows {
    int G, c, nM, nN; const char* A; const char* W; unsigned lda2  ; size_t wtile  ;
    __device__ __forceinline__ bool next(int i, pg8::GUnit& u) const { int pm, pn; if (!pg8::static_tile(i, G, c, nM, nN, pm, pn)) return false;
        u.pm = pm; u.pn = pn; u.A = A; u.B = W + (size_t)pn * wtile; u.B2 = u.B; u.x0 = 0; u.x1 = 256; return true; }
    __device__ __forceinline__ unsigned arow(const pg8::GUnit& u, int row) const { return (unsigned)(u.pm * 256 + row) * lda2; }
};
struct EpiRowsSS {
    static constexpr bool PERM = true;
    bf16_t* OUT; float* SS;
    __device__ __forceinline__ void operator()(const pg8::f32x4 (&acc)[2][2][4][2], const pg8::GUnit& u, int wr, int wc, int fr, int fq) const {
        const int row0 = u.pm * 256 + wr * 64 + fr;
#pragma unroll
        for (int ai = 0; ai < 2; ++ai)
#pragma unroll
            for (int m = 0; m < 4; ++m) {
                const int row = row0 + ai * 128 + m * 16; float p = 0.f;
#pragma unroll
                for (int bj = 0; bj < 2; ++bj) {
                    const pg8::f32x4 v0 = acc[ai][bj][m][0], v1 = acc[ai][bj][m][1];
                    p += ((v0[0] * v0[0] + v0[1] * v0[1]) + (v0[2] * v0[2] + v0[3] * v0[3])) + ((v1[0] * v1[0] + v1[1] * v1[1]) + (v1[2] * v1[2] + v1[3] * v1[3]));
                    pg8::u32x4 w; w.x = pg8::cvt_pk_bf16(v0[0], v0[1]); w.y = pg8::cvt_pk_bf16(v0[2], v0[3]); w.z = pg8::cvt_pk_bf16(v1[0], v1[1]); w.w = pg8::cvt_pk_bf16(v1[2], v1[3]);
                    *(pg8::u32x4*)(OUT + (size_t)row * 1024 + u.pn * 256 + bj * 128 + wc * 32 + 8 * fq) = w;
                }
                p += xshfl<16>(p); p += xshfl<32>(p);
                if (fq == 0) SS[(size_t)row * 16 + u.pn * 4 + wc] = p;
            }
    }
};

__device__ __forceinline__ float sum16(const float* p) { const float4 a = *(const float4*)p, b = *(const float4*)(p + 4), c = *(const float4*)(p + 8), d = *(const float4*)(p + 12);
    return (((a.x + a.y) + (a.z + a.w)) + ((b.x + b.y) + (b.z + b.w))) + (((c.x + c.y) + (c.z + c.w)) + ((d.x + d.y) + (d.z + d.w))); }
struct ThinIn { float4 x[4]; uint2 o[4]; float4 ss[4]; };
__device__ __forceinline__ float ss16(const ThinIn& R) { return (((R.ss[0].x + R.ss[0].y) + (R.ss[0].z + R.ss[0].w)) + ((R.ss[1].x + R.ss[1].y) + (R.ss[1].z + R.ss[1].w))) + (((R.ss[2].x + R.ss[2].y) + (R.ss[2].z + R.ss[2].w)) + ((R.ss[3].x + R.ss[3].y) + (R.ss[3].z + R.ss[3].w))); }
__device__ __forceinline__ int modrow_of(int r) { return (r >= TL) ? 16 : r / SEQ; }
__device__ __forceinline__ void router_load(ThinIn& R, const Ctx& C, int layer, int r, int lane) {
    const float4* xr = (const float4*)xrow_in(C, layer, r); const uint2* oxr = (const uint2*)(C.OX + (size_t)r * D);
#pragma unroll
    for (int j = 0; j < 4; ++j) { R.x[j] = xr[lane + 64 * j]; R.o[j] = oxr[lane + 64 * j]; R.ss[j] = *(const float4*)(C.SS1 + (size_t)r * 16 + 4 * j); }
}
__device__ __forceinline__ void router_row_a(const ThinIn& R, const Ctx& C, int layer, int r, int lane, const float* G1, const float* G2, const float* MODS, float4 (&xa)[4]) {
    const float rstd1 = rsqrtf(ss16(R) * (1.f / D) + EPS);
    float4* xo = (float4*)xrow_out(C, r);
    float ss = 0.f;
#pragma unroll
    for (int j = 0; j < 4; ++j) { const int ci = lane + 64 * j; const uint2 ow = R.o[j]; const float4 g = *(const float4*)(G1 + 4 * ci), gt = *(const float4*)(MODS + 4 * ci), xv = R.x[j];
        xa[j].x = xv.x + gt.x * (__uint_as_float(ow.x << 16) * rstd1 * g.x); xa[j].y = xv.y + gt.y * (__uint_as_float(ow.x & 0xffff0000u) * rstd1 * g.y);
        xa[j].z = xv.z + gt.z * (__uint_as_float(ow.y << 16) * rstd1 * g.z); xa[j].w = xv.w + gt.w * (__uint_as_float(ow.y & 0xffff0000u) * rstd1 * g.w);
        xo[ci] = xa[j]; ss += (xa[j].x * xa[j].x + xa[j].y * xa[j].y) + (xa[j].z * xa[j].z + xa[j].w * xa[j].w); }
    const float rstd2 = rsqrtf(wave_sum(ss) * (1.f / D) + EPS);
    uint2* hmr = (uint2*)(C.HM + (size_t)r * D);
#pragma unroll
    for (int j = 0; j < 4; ++j) { const int ci = lane + 64 * j; const float4 g = *(const float4*)(G2 + 4 * ci), sh = *(const float4*)(MODS + 1024 + 4 * ci), sc = *(const float4*)(MODS + 2048 + 4 * ci);
        xa[j].x = (xa[j].x * rstd2 * g.x) * (1.f + sc.x) + sh.x; xa[j].y = (xa[j].y * rstd2 * g.y) * (1.f + sc.y) + sh.y;
        xa[j].z = (xa[j].z * rstd2 * g.z) * (1.f + sc.z) + sh.z; xa[j].w = (xa[j].w * rstd2 * g.w) * (1.f + sc.w) + sh.w;
        uint2 w; w.x = pg8::cvt_pk_bf16(xa[j].x, xa[j].y); w.y = pg8::cvt_pk_bf16(xa[j].z, xa[j].w); hmr[ci] = w; }
}
__device__ __forceinline__ float reduce20(float (&lp)[32], int lane) {
#define RSTEP(W) { const bool up = (lane & W) != 0; _Pragma("unroll") for (int i = 0; i < W; ++i) { const float send = up ? lp[i] : lp[i + W]; const float keep = up ? lp[i + W] : lp[i]; lp[i] = keep + xshfl<W>(send); } }
    RSTEP(16) RSTEP(8) RSTEP(4) RSTEP(2) RSTEP(1)
#undef RSTEP
    return lp[0] + xshfl<32>(lp[0]);
}
__device__ __forceinline__ void router_select(float tot, const Ctx& C, int layer, int r, int lane, int* lcnt) {
    float lg[20];
#pragma unroll
    for (int q = 0; q < 20; ++q) lg[q] = __builtin_bit_cast(float, __builtin_amdgcn_readlane(__builtin_bit_cast(int, tot), q)) + ((q < 4) ? C.r_gb[layer * 4 + q] : C.r_eb[layer * 16 + (q - 4)]);
    int gsel = 0; float gmax = lg[0];
#pragma unroll
    for (int i = 1; i < 4; ++i) if (lg[i] > gmax) { gmax = lg[i]; gsel = i; }
    float gs = 0.f;
#pragma unroll
    for (int i = 0; i < 4; ++i) gs += __expf(lg[i] - gmax);
    const float pg = 1.f / gs;
    float el[4];
#pragma unroll
    for (int i = 0; i < 4; ++i) el[i] = (gsel == 0) ? lg[4 + i] : (gsel == 1) ? lg[8 + i] : (gsel == 2) ? lg[12 + i] : lg[16 + i];
    int i1 = 0; float v1 = el[0];
#pragma unroll
    for (int i = 1; i < 4; ++i) if (el[i] > v1) { v1 = el[i]; i1 = i; }
    int i2 = -1; float v2 = -INFINITY;
#pragma unroll
    for (int i = 0; i < 4; ++i) if (i != i1 && el[i] > v2) { v2 = el[i]; i2 = i; }
    const float e2 = __expf(v2 - v1); const float w1 = pg / (1.f + e2), w2 = pg * e2 / (1.f + e2);
    const int elo = min(i1, i2), ehi = max(i1, i2);
    const int pair = (elo == 0) ? (ehi - 1) : (elo == 1) ? (ehi + 1) : 5;
    const int cls = gsel * 6 + pair;
    if (lane == 0) {
        const int slot = atomicAdd(lcnt + cls, 1);
        if (slot < LIST_CAP) C.LIST[((size_t)blockIdx.x * 24 + cls) * LIST_CAP + slot] = r;
        *(float2*)(C.TOKW + (size_t)r * 2) = make_float2(i1 < i2 ? w1 : w2, i1 < i2 ? w2 : w1);
    }
}
__device__ __forceinline__ void phase_router(const Ctx& C, int layer, float* lds) {
    const int tid = opaque_tid(C.wv), lane = tid & 63, wave = tid >> 6;
    float* RW = lds;
    int* lcnt = (int*)(lds + 20 * 1024);
    float* G1 = lds + 20 * 1024 + 32; float* G2 = G1 + 1024; float* MODS = G2 + 1024;
    const int nrows = (layer == DEPTH - 1) ? TL : T;
    const int rpw = (nrows + gridDim.x * NWAVES - 1) / (gridDim.x * NWAVES);
    const int wg_r0 = blockIdx.x * NWAVES * rpw, wg_r1 = min(wg_r0 + NWAVES * rpw, nrows);
    const int mrA = modrow_of(min(wg_r0, nrows - 1)), mrB = modrow_of(max(wg_r1 - 1, 0));
    if (tid < 24) lcnt[tid] = 0;
    {
        const float* gwp = C.r_gw + (size_t)layer * D * 4; const float* ewp = C.r_ew + (size_t)layer * D * 16;
#pragma unroll 4
        for (int i = tid; i < 4 * 1024; i += NTHREADS) RW[(i & 3) * 1024 + (i >> 2)] = gwp[i];
#pragma unroll 8
        for (int i = tid; i < 16 * 1024; i += NTHREADS) RW[(4 + (i & 15)) * 1024 + (i >> 4)] = ewp[i];
        for (int i = tid; i < 1024; i += NTHREADS) { G1[i] = C.norm_g[((size_t)layer * 4 + 1) * D + i]; G2[i] = C.norm_g[((size_t)layer * 4 + 2) * D + i]; }
        for (int i = tid; i < 2 * 3 * 1024; i += NTHREADS) { const int which = i / 3072, rem = i % 3072; MODS[i] = C.mod[((size_t)layer * 17 + (which ? mrB : mrA)) * (NMOD * D) + 2 * D + rem]; }
    }
    __syncthreads();
    const int r0 = wg_r0 + wave * rpw, r1 = min(r0 + rpw, nrows);
    if (r0 < r1) {
        ThinIn A, B;
        router_load(A, C, layer, r0, lane); router_load(B, C, layer, min(r0 + 1, r1 - 1), lane);
#pragma unroll 1
        for (int r = r0; r < r1; r += 2) {
            const int rb = min(r + 1, r1 - 1); const bool two = r + 1 < r1;
            float4 xa[4], xb[4];
            router_row_a(A, C, layer, r, lane, G1, G2, MODS + ((modrow_of(r) == mrA) ? 0 : 3072), xa);
            if (r + 2 < r1) router_load(A, C, layer, r + 2, lane);
            router_row_a(B, C, layer, rb, lane, G1, G2, MODS + ((modrow_of(rb) == mrA) ? 0 : 3072), xb);
            if (r + 3 < r1) router_load(B, C, layer, r + 3, lane); else if (r + 2 < r1) router_load(B, C, layer, r + 2, lane);
            float la[32], lb[32];
#pragma unroll
            for (int q = 0; q < 20; ++q) { float pa = 0.f, pb = 0.f;
#pragma unroll
                for (int j = 0; j < 4; ++j) { const float4 w = *(const float4*)(RW + q * 1024 + 4 * (lane + 64 * j));
                    pa += (xa[j].x * w.x + xa[j].y * w.y) + (xa[j].z * w.z + xa[j].w * w.w); pb += (xb[j].x * w.x + xb[j].y * w.y) + (xb[j].z * w.z + xb[j].w * w.w); }
                la[q] = pa; lb[q] = pb; }
#pragma unroll
            for (int q = 20; q < 32; ++q) { la[q] = 0.f; lb[q] = 0.f; }
            const float ta = reduce20(la, lane), tb = reduce20(lb, lane);
            router_select(ta, C, layer, r, lane, lcnt);
            if (two) router_select(tb, C, layer, rb, lane, lcnt);
        }
    }
    __syncthreads();
    if (tid < 24) C.CNTW[((size_t)layer * 24 + tid) * 256 + blockIdx.x] = lcnt[tid];
}

constexpr int MOE_LDS = 131072, MOE_MAXU = 8;
__device__ __forceinline__ bool moe_unit(int i, int G, int c, int npn, int ntiles, int& tile, int& pn) {
    if (npn == 8 && (G & 7) == 0 && G >= 64) {
        const int x = c & 7, j = c >> 3, per = G >> 3;
        const int slot = i * per + j;
        const int q = (slot >> 5) * 8 + x;
        tile = q * 4 + (slot & 3); pn = (slot >> 2) & 7;
        const int nquads = (ntiles + 3) >> 2;
        if (q >= nquads) return false;
        return tile < ntiles;
    }
    const long L = (long)i * G + c; if (L >= (long)ntiles * npn) return false;
    tile = (int)(L / npn); pn = (int)(L % npn); return true;
}
__device__ __forceinline__ bool moe_fewer_units(int G, int c, int npn, int ntiles) {
    int me = 0, mx = 0;
#pragma unroll 1
    for (int i = 0; i < MOE_MAXU; ++i) { int t_, p_; if (moe_unit(i, G, c, npn, ntiles, t_, p_)) ++me; if (moe_unit(i, G, 0, npn, ntiles, t_, p_)) ++mx; }
    return me < mx;
}
struct MoeSched {
    int G, c, npn, layer, mode  ; const char *A, *W; LAS const int* meta  ; LAS const int* tab  ;
    __device__ __forceinline__ bool next(int i, pg8::GUnit& u) const {
        const int ntiles = meta[32 + 24]; if (i >= MOE_MAXU) return false;
        int tile, pn; if (!moe_unit(i, G, c, npn, ntiles, tile, pn)) return false;
        int cls = 0;
#pragma unroll 1
        for (int k = 1; k < 24; ++k) if (tile >= meta[32 + k]) cls = k;
        const int tin = tile - meta[32 + cls], cnt = meta[cls];
        const int g = cls / 6, pr = cls % 6; const int elo = (pr < 3) ? 0 : (pr < 5) ? 1 : 2, ehi = (pr < 3) ? pr + 1 : (pr < 5) ? pr - 1 : 3;
        u.pm = tile; u.pn = pn; u.x0 = i; u.x1 = min(256, cnt - tin * 256); u.A = A;
        if (mode == 0) { const int e = g * 4 + ((pn < 4) ? elo : ehi); u.B = W + (((size_t)layer * 16 + e) * 1024 + (size_t)(pn & 3) * 256) * 1024 * 2; u.B2 = u.B; }
        else { u.B = W + (((size_t)layer * 16 + g * 4 + elo) * 1024 + (size_t)pn * 256) * 512 * 2; u.B2 = W + (((size_t)layer * 16 + g * 4 + ehi) * 1024 + (size_t)pn * 256) * 512 * 2; }
        return true;
    }
    __device__ __forceinline__ unsigned arow(const pg8::GUnit& u, int row) const { return (mode == 0) ? (unsigned)tab[u.x0 * 256 + row] * 2048u : (unsigned)(u.pm * 256 + row) * 2048u; }
};
__device__ __forceinline__ void moe_setup(const Ctx& C, int layer, int npn, LAS int* meta, LAS int* tab, LAS char* scratch  ) {
    const int tid = opaque_tid(C.wv), G = gridDim.x;
    LAS int* cnt = (LAS int*)scratch;
    LAS int* pw = cnt + 24 * 256;
    LAS int* bs = pw + 24 * 257;
    {   const int4* srcp = (const int4*)(C.CNTW + (size_t)layer * 24 * 256);
        int4 v[3];
#pragma unroll
        for (int j = 0; j < 3; ++j) v[j] = srcp[tid + NTHREADS * j];
#pragma unroll
        for (int j = 0; j < 3; ++j) { const int q = tid + NTHREADS * j, w0 = (4 * q) & 255;
            if (w0 + 0 >= G) v[j].x = 0; if (w0 + 1 >= G) v[j].y = 0; if (w0 + 2 >= G) v[j].z = 0; if (w0 + 3 >= G) v[j].w = 0;
            cnt[4 * q] = v[j].x; cnt[4 * q + 1] = v[j].y; cnt[4 * q + 2] = v[j].z; cnt[4 * q + 3] = v[j].w; } }
    __syncthreads();
    const int c = tid >> 4, b = tid & 15;
    if (tid < 384) { int acc = 0;
#pragma unroll
        for (int w = 0; w < 16; ++w) acc += cnt[c * 256 + b * 16 + w];
        bs[tid] = acc; }
    __syncthreads();
    if (tid < 384) { int base = 0;
        for (int k = 0; k < b; ++k) base += bs[c * 16 + k];
#pragma unroll
        for (int w = 0; w < 16; ++w) { pw[c * 257 + b * 16 + w] = base; base += cnt[c * 256 + b * 16 + w]; }
        if (b == 15) { pw[c * 257 + 256] = base; meta[c] = base; } }
    __syncthreads();
    if (tid == 0) { int acc = 0; for (int k = 0; k < 24; ++k) { meta[32 + k] = acc; acc += (meta[k] + 255) >> 8; } meta[32 + 24] = acc; }
    __syncthreads();
    const int ntiles = meta[32 + 24];
    const int s = tid & 255;
    const int* gp[MOE_MAXU / 2]; bool ok[MOE_MAXU / 2];
#pragma unroll
    for (int k = 0; k < MOE_MAXU / 2; ++k) {
        const int i = (tid >> 8) + 2 * k; int tile = 0, pn_;
        ok[k] = moe_unit(i, G, blockIdx.x, npn, ntiles, tile, pn_);
        int cls = 0;
        for (int kk = 1; kk < 24; ++kk) if (tile >= meta[32 + kk]) cls = kk;
        const int tin = tile - meta[32 + cls], cn = meta[cls];
        int slot = tin * 256 + s; if (slot >= cn) slot = 0;
        LAS const int* pc = pw + cls * 257;
        int lo = 0, hi = 256;
#pragma unroll 1
        while (hi - lo > 1) { const int mid = (lo + hi) >> 1; if (pc[mid] <= slot) lo = mid; else hi = mid; }
        gp[k] = C.LIST + ((size_t)lo * 24 + cls) * LIST_CAP + (slot - pc[lo]);
        if (!ok[k]) gp[k] = C.LIST;
    }
    int tv[MOE_MAXU / 2];
#pragma unroll
    for (int k = 0; k < MOE_MAXU / 2; ++k) tv[k] = *gp[k];
#pragma unroll
    for (int k = 0; k < MOE_MAXU / 2; ++k) if (ok[k]) tab[((tid >> 8) + 2 * k) * 256 + s] = tv[k];
    __syncthreads();
}
__device__ __forceinline__ float silu_fast(float v) { return v * __builtin_amdgcn_rcpf(1.f + __expf(-v)); }
struct EpiMoeUp {
    static constexpr bool PERM = true;
    bf16_t* ACT; const float* TOKW; LAS const int* tab;
    __device__ __forceinline__ void operator()(const pg8::f32x4 (&acc)[2][2][4][2], const pg8::GUnit& u, int wr, int wc, int fr, int fq) const {
        const int hi = (u.pn >= 4) ? 1 : 0;
        float w8[2][4];
#pragma unroll
        for (int ai = 0; ai < 2; ++ai)
#pragma unroll
            for (int m = 0; m < 4; ++m) { const int rt = ai * 128 + wr * 64 + m * 16 + fr; const int token = tab[u.x0 * 256 + rt]; w8[ai][m] = TOKW[(size_t)token * 2 + hi]; }
#pragma unroll
        for (int ai = 0; ai < 2; ++ai)
#pragma unroll
            for (int m = 0; m < 4; ++m) {
                const int rt = ai * 128 + wr * 64 + m * 16 + fr;
                if (rt < u.x1) {
                    const float w = w8[ai][m];
#pragma unroll
                    for (int bj = 0; bj < 2; ++bj) {
                        const pg8::f32x4 gt = acc[ai][bj][m][0], up = acc[ai][bj][m][1];
                        pg8::u32x2 o; o.x = pg8::cvt_pk_bf16(silu_fast(gt[0]) * up[0] * w, silu_fast(gt[1]) * up[1] * w); o.y = pg8::cvt_pk_bf16(silu_fast(gt[2]) * up[2] * w, silu_fast(gt[3]) * up[3] * w);
                        *(pg8::u32x2*)(ACT + (size_t)(u.pm * 256 + rt) * 1024 + hi * 512 + (u.pn & 3) * 128 + 4 * (16 * bj + 4 * wc + fq)) = o;
                    }
                }
            }
    }
};
struct EpiMoeDown {
    static constexpr bool PERM = true;
    bf16_t* FX; float* SS; LAS const int* tab;
    __device__ __forceinline__ void operator()(const pg8::f32x4 (&acc)[2][2][4][2], const pg8::GUnit& u, int wr, int wc, int fr, int fq) const {
        int tok8[2][4];
#pragma unroll
        for (int ai = 0; ai < 2; ++ai)
#pragma unroll
            for (int m = 0; m < 4; ++m) tok8[ai][m] = tab[u.x0 * 256 + ai * 128 + wr * 64 + m * 16 + fr];
#pragma unroll
        for (int ai = 0; ai < 2; ++ai)
#pragma unroll
            for (int m = 0; m < 4; ++m) {
                const int rt = ai * 128 + wr * 64 + m * 16 + fr; const bool ok = rt < u.x1;
                const int token = tok8[ai][m]; float p = 0.f;
#pragma unroll
                for (int bj = 0; bj < 2; ++bj) {
                    const pg8::f32x4 v0 = acc[ai][bj][m][0], v1 = acc[ai][bj][m][1];
                    p += ((v0[0] * v0[0] + v0[1] * v0[1]) + (v0[2] * v0[2] + v0[3] * v0[3])) + ((v1[0] * v1[0] + v1[1] * v1[1]) + (v1[2] * v1[2] + v1[3] * v1[3]));
                    pg8::u32x4 w; w.x = pg8::cvt_pk_bf16(v0[0], v0[1]); w.y = pg8::cvt_pk_bf16(v0[2], v0[3]); w.z = pg8::cvt_pk_bf16(v1[0], v1[1]); w.w = pg8::cvt_pk_bf16(v1[2], v1[3]);
                    if (ok) *(pg8::u32x4*)(FX + (size_t)token * 1024 + u.pn * 256 + bj * 128 + wc * 32 + 8 * fq) = w;
                }
                p += xshfl<16>(p); p += xshfl<32>(p);
                if (ok && fq == 0) SS[(size_t)token * 16 + u.pn * 4 + wc] = p;
            }
    }
};

__device__ __forceinline__ void final_load(ThinIn& R, const Ctx& C, int r, int lane) {
    const float4* xr = (const float4*)xrow_out(C, r); const uint2* fxr = (const uint2*)(C.FX + (size_t)r * D);
#pragma unroll
    for (int j = 0; j < 4; ++j) { R.x[j] = xr[lane + 64 * j]; R.o[j] = fxr[lane + 64 * j]; R.ss[j] = *(const float4*)(C.SS2 + (size_t)r * 16 + 4 * j); }
}
__device__ __forceinline__ void final_row(const ThinIn& R, const Ctx& C, int r, int lane, bool nextln, const float* G3, const float* G0N, const float* MODS  ) {
    const float rstd = rsqrtf(ss16(R) * (1.f / D) + EPS);
    float4* xo = (float4*)xrow_out(C, r);
    float4 xv[4]; float ss = 0.f;
#pragma unroll
    for (int j = 0; j < 4; ++j) { const int ci = lane + 64 * j; const uint2 fw = R.o[j]; const float4 g = *(const float4*)(G3 + 4 * ci), gt = *(const float4*)(MODS + 4 * ci); xv[j] = R.x[j];
        xv[j].x += gt.x * (__uint_as_float(fw.x << 16) * rstd * g.x); xv[j].y += gt.y * (__uint_as_float(fw.x & 0xffff0000u) * rstd * g.y);
        xv[j].z += gt.z * (__uint_as_float(fw.y << 16) * rstd * g.z); xv[j].w += gt.w * (__uint_as_float(fw.y & 0xffff0000u) * rstd * g.w);
        xo[ci] = xv[j]; ss += (xv[j].x * xv[j].x + xv[j].y * xv[j].y) + (xv[j].z * xv[j].z + xv[j].w * xv[j].w); }
    if (nextln) {
        const float rs2 = rsqrtf(wave_sum(ss) * (1.f / D) + EPS);
        uint2* o = (uint2*)(C.HX + (size_t)r * D);
#pragma unroll
        for (int j = 0; j < 4; ++j) { const int ci = lane + 64 * j; const float4 g = *(const float4*)(G0N + 4 * ci), sh = *(const float4*)(MODS + 1024 + 4 * ci), sc = *(const float4*)(MODS + 2048 + 4 * ci);
            uint2 w; w.x = pg8::cvt_pk_bf16((xv[j].x * rs2 * g.x) * (1.f + sc.x) + sh.x, (xv[j].y * rs2 * g.y) * (1.f + sc.y) + sh.y);
            w.y = pg8::cvt_pk_bf16((xv[j].z * rs2 * g.z) * (1.f + sc.z) + sh.z, (xv[j].w * rs2 * g.w) * (1.f + sc.w) + sh.w);
            o[ci] = w; }
    }
}
__device__ __forceinline__ void phase_final(const Ctx& C, int layer, float* lds) {
    const int tid = opaque_tid(C.wv), lane = tid & 63, wave = tid >> 6;
    const bool nextln = layer < DEPTH - 1;
    float* G3 = lds; float* G0N = G3 + 1024; float* MODS = G0N + 1024;
    const int nrows = (layer == DEPTH - 1) ? TL : T;
    const int rpw = (nrows + gridDim.x * NWAVES - 1) / (gridDim.x * NWAVES);
    const int wg_r0 = blockIdx.x * NWAVES * rpw, wg_r1 = min(wg_r0 + NWAVES * rpw, nrows);
    const int mrA = modrow_of(min(wg_r0, nrows - 1)), mrB = modrow_of(max(wg_r1 - 1, 0));
    const int ln = nextln ? layer + 1 : layer;
    for (int i = tid; i < 1024; i += NTHREADS) { G3[i] = C.norm_g[((size_t)layer * 4 + 3) * D + i]; G0N[i] = C.norm_g[((size_t)ln * 4 + 0) * D + i]; }
    for (int i = tid; i < 2 * 3 * 1024; i += NTHREADS) { const int which = i / 3072, rem = i % 3072, mr = which ? mrB : mrA;
        MODS[i] = (rem < 1024) ? C.mod[((size_t)layer * 17 + mr) * (NMOD * D) + 5 * D + rem] : C.mod[((size_t)ln * 17 + mr) * (NMOD * D) + (rem - 1024)]; }
    __syncthreads();
    const int r0 = wg_r0 + wave * rpw, r1 = min(r0 + rpw, nrows);
    if (r0 < r1) {
        ThinIn A, B;
        final_load(A, C, r0, lane);
#pragma unroll 1
        for (int r = r0; r < r1; r += 2) {
            if (r + 1 < r1) final_load(B, C, r + 1, lane);
            final_row(A, C, r, lane, nextln, G3, G0N, MODS + ((modrow_of(r) == mrA) ? 0 : 3072));
            if (r + 1 < r1) {
                if (r + 2 < r1) final_load(A, C, r + 2, lane);
                final_row(B, C, r + 1, lane, nextln, G3, G0N, MODS + ((modrow_of(r + 1) == mrA) ? 0 : 3072));
            }
        }
    }
}

__device__ __forceinline__ Ctx make_ctx(const Args& a, int wv) {
    Ctx C; C.wv = wv;
    C.x = a.in[0]; C.c = a.in[1]; C.ctx = a.in[2]; C.c_ctx = a.in[3]; C.ada_w = a.in[4]; C.ada_b = a.in[5]; C.norm_g = a.in[6]; C.w_in = a.in[7];
    C.q_gain = a.in[8]; C.kv_gain = a.in[9]; C.w_uq = a.in[10]; C.w_ukv = a.in[11]; C.sink = a.in[12]; C.dlam = a.in[13]; C.subln = a.in[14];
    C.pool_w = a.in[15]; C.pool_scale = a.in[16]; C.w_out = a.in[17]; C.r_gw = a.in[18]; C.r_gb = a.in[19]; C.r_ew = a.in[20]; C.r_eb = a.in[21];
    C.w_gu = a.in[22]; C.w_down = a.in[23]; C.out = a.out; C.ws = a.ws;
    C.mod = (float*)(a.ws + WS_MOD); C.hctx = (float*)(a.ws + WS_HCTX);
    unsigned char* q = a.ws + WS_QKV;
    C.QA = (bf16_t*)(q + QA_OFF); C.KA = (bf16_t*)(q + KA_OFF); C.VA = (bf16_t*)(q + VA_OFF); C.QB = (bf16_t*)(q + QB_OFF); C.KB = (bf16_t*)(q + KB_OFF);
    C.VB = (bf16_t*)(q + VB_OFF); C.QC = (bf16_t*)(q + QC_OFF); C.KC = (bf16_t*)(q + KC_OFF); C.VC = (bf16_t*)(q + VC_OFF); C.U = (bf16_t*)(q + U_OFF);
    C.O = (bf16_t*)(a.ws + WS_O);
    C.WIN = (bf16_t*)(a.ws + WS_WIN); C.WOUT = (bf16_t*)(a.ws + WS_WOUT); C.WUQ = (bf16_t*)(a.ws + WS_WUQ); C.WUKV = (bf16_t*)(a.ws + WS_WUKV);
    C.WGU = (bf16_t*)(a.ws + WS_WGU); C.WDN = (bf16_t*)(a.ws + WS_WDN); C.HX = (bf16_t*)(a.ws + WS_HX); C.CQ = (bf16_t*)(a.ws + WS_CQ); C.CKVR = (bf16_t*)(a.ws + WS_CKVR);
    C.SSQ = (float*)(a.ws + WS_SSQ); C.SSK = (float*)(a.ws + WS_SSK);
    C.OX = (bf16_t*)(a.ws + WS_OX); C.ACT = (bf16_t*)(a.ws + WS_ACT); C.HM = (bf16_t*)(a.ws + WS_HM); C.FX = (bf16_t*)(a.ws + WS_FX);
    C.SS1 = (float*)(a.ws + WS_SS1); C.SS2 = (float*)(a.ws + WS_SS2); C.TOKW = (float*)(a.ws + WS_TOKW); C.LIST = (int*)(a.ws + WS_LIST); C.CNTW = (int*)(a.ws + WS_CNTW);
    return C;
}
constexpr int PH_PER_LAYER = 9;
constexpr int N_PHASES = 1 + PH_PER_LAYER * DEPTH;
__global__ void __launch_bounds__(NTHREADS, 2) fwd(Args a) {
    extern __shared__ __attribute__((aligned(16))) unsigned char lds_raw[];
    float* lds = (float*)lds_raw;
    LAS unsigned char* lds3 = (LAS unsigned char*)lds_raw;
    volatile LAS unsigned* MISC = (volatile LAS unsigned*)((LAS unsigned char*)lds_raw + LDS_MISC);
    const int wv = __builtin_amdgcn_readfirstlane(threadIdx.x >> 6);
    for (int u = threadIdx.x; u < (LDS_BYTES - LDS_MISC) / 4; u += NTHREADS) MISC[u] = 0u;
    __syncthreads();
    const bool one = (a.ph_hi - a.ph_lo) > 1;
    XcdBarrier bar; bar.bar = (unsigned*)(a.ws + WS_CTL) + 4096; bar.x = 0; bar.st = nullptr;
    if (one) bar = xcd_barrier_post((unsigned*)(a.ws + WS_CTL) + 4096, MISC + 8, wv);
    const int lo = a.ph_lo, hi = a.ph_hi;
    const int G = gridDim.x, bid = blockIdx.x;
#define IN(k) (lo <= (k) && (k) < hi)
#define SEAM(k) do { if (IN(k) && IN((k) + 1)) { STAMP_BEGIN(); xcd_barrier(bar, wv); STAMP_END(10); STAMP_END(((k) == 0) ? 49 : 40 + (((k) + 8) % 9)); } } while (0)
    if (IN(0)) REPEAT(REP_PRO) { REP_SYNC(); STAMP_BEGIN(); const Ctx C = make_ctx(a, wv); phase_mod(C, lds); __syncthreads(); phase_convert(C, lds); STAMP_END(0); }
    SEAM(0);
#pragma unroll 1
    for (int layer = 0; layer < DEPTH; ++layer) {
        const int p = 1 + PH_PER_LAYER * layer;
        if (layer == 0) {
        if (IN(p)) REPEAT(REP_LN0) { REP_SYNC(); STAMP_BEGIN(); const Ctx C = make_ctx(a, wv); phase_ln0(C, layer); STAMP_END(1); }
        SEAM(p);
        }
        if (IN(p + 1)) REPEAT(REP_INP) {
            REP_SYNC(); STAMP_BEGIN(); const Ctx C = make_ctx(a, wv);
            SchedInProj S{G, bid, layer, (const char*)C.HX, (const char*)(C.WIN + (size_t)layer * 2048 * 1024)};
            stage_rope_table(lds3, wv);
            EpiInProj E{C.CQ, C.CKVR, C.KA, C.QB, C.KB, C.VB, C.QC, C.KC, C.VC, C.U, C.SSQ, C.SSK, (LAS const float*)(lds3 + ROPE_LDS)};
            pg8::gemm_phase<0>(lds3, wv, 1024, 1024, 16, S, E); STAMP_END(2);
            if (layer == 0 && (G & 7) == 0 && (bid >> 3) + (G >> 3) * 4 >= T / 256) bg_convert(C, lds, MISC, BG_INP);
        }
        SEAM(p + 1);
        if (IN(p + 2)) REPEAT(REP_MLA) {
            REP_SYNC(); STAMP_BEGIN(); const Ctx C = make_ctx(a, wv);
            const int nQ = ((layer == DEPTH - 1) ? TL : T) / 256 * 2;
            SchedMlaUp S{G, bid, nQ, nQ + T / 256 * 2, (const char*)C.CQ, (const char*)C.CKVR, (const char*)(C.WUQ + (size_t)layer * 512 * 256), (const char*)(C.WUKV + (size_t)layer * 512 * 256)};
            stage_rope_table(lds3, wv);
            EpiMlaUp E{C.QA, C.KA, C.VA, C.SSQ, C.SSK, (LAS const float*)(lds3 + ROPE_LDS)};
            pg8::gemm_phase<1>(lds3, wv, 256, 256, 4, S, E); STAMP_END(3);
        }
        SEAM(p + 2);
        if (IN(p + 3)) REPEAT(REP_ATT) { REP_SYNC(); STAMP_BEGIN(); const Ctx C = make_ctx(a, wv); phase_attn(C, layer, (LAS char*)lds3, MISC); STAMP_END(4); }
        SEAM(p + 3);
        if (IN(p + 4)) REPEAT(REP_OUT) {
            REP_SYNC(); STAMP_BEGIN(); const Ctx C = make_ctx(a, wv);
            SchedRows S{G, bid, ((layer == DEPTH - 1) ? TL : T) / 256, 4, (const char*)C.O, (const char*)(C.WOUT + (size_t)layer * 1024 * 1024), 2048u, (size_t)256 * 1024 * 2};
            EpiRowsSS E{C.OX, C.SS1};
            pg8::gemm_phase<2>(lds3, wv, 1024, 1024, 16, S, E); STAMP_END(5);
            if (layer == 0 && (long)2 * G + bid >= (long)(T / 256) * 4) bg_convert(C, lds, MISC, BG_OUT);
        }
        SEAM(p + 4);
        if (IN(p + 5)) { STAMP_BEGIN(); const Ctx C = make_ctx(a, wv); phase_router(C, layer, lds); STAMP_END(6); }
        SEAM(p + 5);
        if (IN(p + 6)) REPEAT(REP_MUP) {
            REP_SYNC(); STAMP_BEGIN(); const Ctx C = make_ctx(a, wv);
            LAS int* meta = (LAS int*)(lds3 + MOE_LDS); LAS int* tab = (LAS int*)(lds3 + MOE_LDS + 4096);
            moe_setup(C, layer, 8, meta, tab, (LAS char*)lds3); STAMP_END(30);
            MoeSched S{G, bid, 8, layer, 0, (const char*)C.HM, (const char*)C.WGU, meta, tab};
            EpiMoeUp E{C.ACT, C.TOKW, tab};
            pg8::gemm_phase<3>(lds3, wv, 1024, 1024, 16, S, E); STAMP_END(7);
            if (layer == 0 && BG_MUP > 0 && moe_fewer_units(G, bid, 8, meta[32 + 24])) bg_convert(C, lds, MISC, BG_MUP);
        }
        SEAM(p + 6);
        if (IN(p + 7)) REPEAT(REP_MDN) {
            REP_SYNC(); STAMP_BEGIN(); const Ctx C = make_ctx(a, wv);
            LAS int* meta = (LAS int*)(lds3 + MOE_LDS); LAS int* tab = (LAS int*)(lds3 + MOE_LDS + 4096);
            moe_setup(C, layer, 4, meta, tab, (LAS char*)lds3); STAMP_END(30);
            MoeSched S{G, bid, 4, layer, 1, (const char*)C.ACT, (const char*)C.WDN, meta, tab};
            EpiMoeDown E{C.FX, C.SS2, tab};
            pg8::gemm_phase<4>(lds3, wv, 1024, 512, 8, S, E); STAMP_END(8);
            if (layer == 0 && BG_MDN > 0 && moe_fewer_units(G, bid, 4, meta[32 + 24])) bg_convert(C, lds, MISC, BG_MDN);
        }
        SEAM(p + 7);
        if (IN(p + 8)) { STAMP_BEGIN(); const Ctx C = make_ctx(a, wv); if (layer == 0) bg_convert(C, lds, MISC, -1); phase_final(C, layer, lds); STAMP_END(9); }
        SEAM(p + 8);
    }
#undef IN
#undef SEAM
#if PROBE_SEL >= 0
    if (blockIdx.x == 0 && wv == 0 && lane_id() == 0) { const unsigned long long te = wall_clock64(), pa_ = *(volatile LAS unsigned long long*)(MISC + 16); while (wall_clock64() - te < pa_ * PROBE_MULT) __builtin_amdgcn_s_sleep(8); }
#endif
}

extern "C" void kernel_launch(void* const* d_in, const int* in_sizes, int n_in, void* d_out, int out_size, void* d_ws, size_t ws_size, hipStream_t stream) {
    static int grid = 0;
    if (grid == 0) {
        if (n_in != 24 || out_size != TL * D || ws_size < WS_END) { fprintf(stderr, "kernel_launch: unexpected shapes (n_in %d out %d ws %zu)\n", n_in, out_size, ws_size); grid = -1; return; }
        int dev = 0, cus = 0;
        if (hipGetDevice(&dev) != hipSuccess || hipDeviceGetAttribute(&cus, hipDeviceAttributeMultiprocessorCount, dev) != hipSuccess) { grid = -1; return; }
        if (hipFuncSetAttribute((const void*)fwd, hipFuncAttributeMaxDynamicSharedMemorySize, LDS_BYTES) != hipSuccess) { fprintf(stderr, "kernel_launch: hipFuncSetAttribute failed\n"); grid = -1; return; }
        int per_cu = 0;
        if (hipOccupancyMaxActiveBlocksPerMultiprocessor(&per_cu, (const void*)fwd, NTHREADS, LDS_BYTES) != hipSuccess || per_cu < 1) { fprintf(stderr, "kernel_launch: occupancy query says %d\n", per_cu); }
        (void)hipGetLastError();
        grid = cus;
    }
    if (grid < 0) return;
    (void)hipMemsetAsync((char*)d_ws + WS_CTL, 0, CTL_BYTES, stream);
    Args a{};
    for (int i = 0; i < 24; ++i) a.in[i] = (const float*)d_in[i];
    a.out = (float*)d_out; a.ws = (unsigned char*)d_ws;
#if N_LAUNCH_MODE == 1
    a.ph_lo = 0; a.ph_hi = N_PHASES;
    hipLaunchKernelGGL(fwd, dim3(grid), dim3(NTHREADS), LDS_BYTES, stream, a);
#else
    for (int p = 0; p < N_PHASES; ++p) { a.ph_lo = p; a.ph_hi = p + 1; hipLaunchKernelGGL(fwd, dim3(grid), dim3(NTHREADS), LDS_BYTES, stream, a); }
#endif
}
```

```cpp
#include <hip/hip_runtime.h>
#include <cstdio>
#include <cstdint>

#ifndef REP_PRO
#define REP_PRO 1
#endif
#ifndef REP_LN0
#define REP_LN0 1
#endif
#ifndef REP_INP
#define REP_INP 1
#endif
#ifndef REP_MLA
#define REP_MLA 1
#endif
#ifndef REP_ATT
#define REP_ATT 1
#endif
#ifndef REP_OUT
#define REP_OUT 1
#endif
#ifndef REP_MUP
#define REP_MUP 1
#endif
#ifndef REP_MDN
#define REP_MDN 1
#endif
#define REPEAT(n) _Pragma("unroll 1") for (int rep_ = 0; rep_ < (n); ++rep_)
#define REP_SYNC() do { if (rep_ > 0) { if (one) xcd_barrier(bar, wv); else __syncthreads(); } } while (0)
#ifndef PROBE_SEL
#define PROBE_SEL -1
#endif
#define PROBE_MULT 4
#if PROBE_SEL >= 0
#define STAMP_BEGIN() do { if (blockIdx.x == 0 && wv == 0 && lane_id() == 0) *(volatile LAS unsigned long long*)(MISC + 18) = wall_clock64(); } while (0)
#define STAMP_END(kind) do { if (blockIdx.x == 0 && wv == 0 && lane_id() == 0 && (kind) == PROBE_SEL) *(volatile LAS unsigned long long*)(MISC + 16) += wall_clock64() - *(volatile LAS unsigned long long*)(MISC + 18); } while (0)
#else
#define STAMP_BEGIN() do {} while (0)
#define STAMP_END(kind) do {} while (0)
#endif
#ifndef BG_INP
#define BG_INP 4
#endif
#ifndef BG_OUT
#define BG_OUT 3
#endif
#ifndef BG_MUP
#define BG_MUP 0
#endif
#ifndef BG_MDN
#define BG_MDN 0
#endif
#ifndef ATT_STAGGER
#define ATT_STAGGER 1
#endif
#ifndef SWA_TWOHEAD
#define SWA_TWOHEAD 1
#endif
#ifndef ATT_DEFER
#define ATT_DEFER 1
#endif
#ifndef ATT_LACC_MAX
#define ATT_LACC_MAX 0
#endif
#ifndef ATT_DEEP_MAX
#define ATT_DEEP_MAX 0
#endif
#ifndef ATT_PIPE
#define ATT_PIPE 1
#endif
#ifndef USE_NAIVE_ATTN
#define USE_NAIVE_ATTN 0
#endif
#ifndef USE_NAIVE_TOKB
#define USE_NAIVE_TOKB 0
#endif
#ifndef N_LAUNCH_MODE
#define N_LAUNCH_MODE 1
#endif

constexpr int D = 1024, BATCH = 16, SEQ = 2048, CTXL = 256, DEPTH = 2, GRIDW = 64;
constexpr int TL = BATCH * SEQ, TC = BATCH * CTXL, T = TL + TC;
constexpr int D_IN = 1952, NMOD = 6;
constexpr float EPS = 1e-6f;
constexpr float LOG2E = 1.4426950408889634f;
constexpr int Z_CQ = 0, Z_CKV = 256, Z_KR = 384, Z_BQ = 416, Z_BK = 672, Z_BV = 800, Z_DQ = 928, Z_DK = 1184, Z_DV = 1440, Z_U = 1696;
constexpr float SC_A = 0.10206207261596577f * LOG2E;
constexpr float SC_B = 0.125f * LOG2E;
constexpr float SC_C = 0.17677669529663687f * LOG2E;

constexpr size_t MiB = 1u << 20;
constexpr size_t WS_CTL = 0, CTL_BYTES = 1 * MiB;
constexpr size_t WS_MOD = 1 * MiB;
constexpr size_t WS_HCTX = 4 * MiB;
constexpr size_t WS_QKV = 130 * MiB;
constexpr size_t QA_OFF = 0, KA_OFF = QA_OFF + (size_t)T * 384 * 2, VA_OFF = KA_OFF + (size_t)T * 384 * 2,
                 QB_OFF = VA_OFF + (size_t)T * 256 * 2, KB_OFF = QB_OFF + (size_t)T * 256 * 2, VB_OFF = KB_OFF + (size_t)T * 128 * 2,
                 QC_OFF = VB_OFF + (size_t)T * 128 * 2, KC_OFF = QC_OFF + (size_t)T * 256 * 2, VC_OFF = KC_OFF + (size_t)T * 256 * 2,
                 U_OFF = VC_OFF + (size_t)T * 256 * 2, QKV_END = U_OFF + (size_t)T * 256 * 2;
static_assert(QKV_END <= 180 * MiB, "qkv region");
constexpr size_t WS_O = 310 * MiB;
constexpr size_t WS_WIN = 20 * MiB;
constexpr size_t WS_WOUT = 28 * MiB;
constexpr size_t WS_WUQ = 32 * MiB;
constexpr size_t WS_WUKV = 32 * MiB + 512 * 1024;
constexpr size_t WS_WGU = 34 * MiB;
constexpr size_t WS_WDN = 98 * MiB;
constexpr size_t WS_HX = 382 * MiB;
constexpr size_t WS_CQ = 454 * MiB;
constexpr size_t WS_CKVR = 472 * MiB;
constexpr size_t WS_SSQ = 490 * MiB;
constexpr size_t WS_SSK = 491 * MiB;
constexpr size_t WS_SS1 = 492 * MiB;
constexpr size_t WS_SS2 = 495 * MiB;
constexpr size_t WS_LIST = 498 * MiB;
constexpr int LIST_CAP = 160;
constexpr size_t WS_CNTW = 502 * MiB + 512 * 1024;
constexpr size_t WS_TOKW = 502 * MiB;
constexpr size_t WS_END = 503 * MiB;
constexpr size_t WS_OX = WS_QKV;
constexpr size_t WS_ACT = WS_QKV;
constexpr size_t WS_HM = WS_QKV + 96 * MiB;
constexpr size_t WS_FX = WS_O;
constexpr int ACT_ROWS = 43008;
static_assert((size_t)ACT_ROWS * 2048 <= 96 * MiB && WS_HM + (size_t)T * 2048 <= WS_QKV + 180 * MiB, "aliases");
constexpr int CW_CNT = 8192;

typedef unsigned short bf16_t;
#define LAS __attribute__((address_space(3)))

__device__ __forceinline__ float bf2f(bf16_t b) { return __uint_as_float(((unsigned)b) << 16); }
__device__ __forceinline__ bf16_t f2bf(float f) { unsigned u = __float_as_uint(f); u += 0x7fffu + ((u >> 16) & 1u); return (bf16_t)(u >> 16); }

struct alignas(16) RopeTab { float c[64][24]; float s[64][24]; };
constexpr double cx_exp(double x) {
    int k = 0; while (x < -0.5) { x *= 0.5; ++k; }
    double t = 1.0, s = 1.0; for (int i = 1; i < 30; ++i) { t *= x / i; s += t; }
    for (int i = 0; i < k; ++i) s *= s; return s;
}
constexpr double cx_pi = 3.14159265358979323846264338327950288;
constexpr double cx_sin_small(double x) { double t = x, s = x; for (int i = 1; i < 14; ++i) { t *= -x * x / ((2 * i) * (2 * i + 1)); s += t; } return s; }
constexpr double cx_cos_small(double x) { double t = 1.0, s = 1.0; for (int i = 1; i < 14; ++i) { t *= -x * x / ((2 * i - 1) * (2 * i)); s += t; } return s; }
constexpr double cx_reduce(double x) { double q = x / (2 * cx_pi); long long n = (long long)q; double r = x - (double)n * 2 * cx_pi; if (r > cx_pi) r -= 2 * cx_pi; return r; }
constexpr RopeTab make_rope() {
    RopeTab t{};
    const double ln1e4 = 9.21034037197618273607196581873745683;
    double inv[24] = {};
    for (int f = 0; f < 24; ++f) inv[f] = (f < 8) ? cx_exp(-(double)f / 8.0 * ln1e4) : cx_exp(-(double)(f - 8) / 16.0 * ln1e4);
    for (int p = 0; p < 64; ++p) for (int f = 0; f < 24; ++f) {
        const double a = cx_reduce((double)p * inv[f]);
        t.c[p][f] = (float)cx_cos_small(a); t.s[p][f] = (float)cx_sin_small(a);
    }
    return t;
}
__device__ constexpr RopeTab g_rope = make_rope();
__device__ __forceinline__ void rope_cs_a(int t, int i, float& c, float& s) { const int p = (i < 8) ? (t >> 6) : (t & 63), f = i & 7; c = g_rope.c[p][f]; s = g_rope.s[p][f]; }
__device__ __forceinline__ void rope_cs_b(int t, int i, float& c, float& s) { const int p = (i < 16) ? (t >> 6) : (t & 63), f = 8 + (i & 15); c = g_rope.c[p][f]; s = g_rope.s[p][f]; }

#define XB_TMO      128
#define XB_XCNT(j)  (256  + 64 * (j))
#define XB_XSUB(j)  (1280 + 64 * (j))
#define XB_XGEN(j)  (2304 + 64 * (j))
#define XB_TOP      3328
#define XB_TOPGEN   3392
#define XCD_BAR_WORDS 3456
#define XB_SPIN_CAP (1u << 18)
__device__ __forceinline__ unsigned xb_ld(unsigned* p)              { return __hip_atomic_load(p, __ATOMIC_RELAXED, __HIP_MEMORY_SCOPE_AGENT); }
__device__ __forceinline__ unsigned xb_add(unsigned* p, unsigned v) { return __hip_atomic_fetch_add(p, v, __ATOMIC_RELAXED, __HIP_MEMORY_SCOPE_AGENT); }
__device__ __forceinline__ unsigned xb_xcc_id() { return (unsigned)__builtin_amdgcn_s_getreg((3 << 11) | 20) & 0xFu; }
#define XB_SPIN(cond, bar) do { unsigned _sp = 0; while (cond) { __builtin_amdgcn_s_sleep(1); \
    if ((++_sp & 255u) == 0u) { if (xb_ld(&(bar)[XB_TMO])) break; if (_sp > XB_SPIN_CAP) { atomicAdd(&(bar)[XB_TMO], 1u); break; } } } } while (0)
__device__ __forceinline__ int lane_id();
struct XcdBarrier { unsigned* bar; unsigned x; volatile LAS unsigned* st; };
__device__ __forceinline__ XcdBarrier xcd_barrier_post(unsigned* bar, volatile LAS unsigned* st, int wv) {
    XcdBarrier b; b.bar = bar; b.x = xb_xcc_id(); b.st = st;
    if (wv == 0 && lane_id() == 0) (void)xb_add(&bar[XB_XCNT(b.x)], 1u);
    return b;
}
__device__ __forceinline__ void xcd_barrier_complete(unsigned* bar, unsigned x, unsigned& nloc, unsigned& nx) {
    const unsigned G = gridDim.x * gridDim.y * gridDim.z;
    unsigned sum, cnt, mine, sp = 0u;
    for (;;) {
        sum = 0u; cnt = 0u; mine = 0u;
#pragma unroll
        for (unsigned j = 0; j < 16; ++j) { const unsigned c = xb_ld(&bar[XB_XCNT(j)]); sum += c; cnt += (c > 0u) ? 1u : 0u; mine = (j == x) ? c : mine; }
        if (sum == G) break;
        __builtin_amdgcn_s_sleep(1);
        if ((++sp & 255u) == 0u) { if (xb_ld(&bar[XB_TMO])) break; if (sp > XB_SPIN_CAP) { atomicAdd(&bar[XB_TMO], 1u); break; } }
    }
    nloc = mine > 0u ? mine : 1u; nx = cnt > 0u ? cnt : 1u;
}
__device__ __forceinline__ void xcd_barrier(const XcdBarrier& b, int wv) {
    asm volatile("s_waitcnt vmcnt(0)" ::: "memory");
    __syncthreads();
    if (wv == 0 && lane_id() == 0) {
        unsigned* bar = b.bar;
        __builtin_amdgcn_s_waitcnt(0);
        unsigned nloc = b.st[0], nx = b.st[1];
        if (nloc == 0u) { xcd_barrier_complete(bar, b.x, nloc, nx); b.st[0] = nloc; b.st[1] = nx; }
        const unsigned old = xb_add(&bar[XB_XSUB(b.x)], 1u);
        const unsigned gen = old / nloc;
        if (old + 1u == (gen + 1u) * nloc) {
            __builtin_amdgcn_fence(__ATOMIC_RELEASE, "agent");
            asm volatile("s_waitcnt vmcnt(0)" ::: "memory");
            const unsigned og = xb_add(&bar[XB_TOP], 1u);
            const unsigned tg = og / nx;
            if (og + 1u == (tg + 1u) * nx) xb_add(&bar[XB_TOPGEN], 1u);
            else XB_SPIN(xb_ld(&bar[XB_TOPGEN]) == tg, bar);
            __builtin_amdgcn_fence(__ATOMIC_ACQUIRE, "agent");
            xb_add(&bar[XB_XGEN(b.x)], 1u);
            asm volatile("s_waitcnt vmcnt(0)" ::: "memory");
        } else {
            XB_SPIN(xb_ld(&bar[XB_XGEN(b.x)]) == gen, bar);
            __builtin_amdgcn_fence(__ATOMIC_ACQUIRE, "agent");
            asm volatile("s_waitcnt vmcnt(0)" ::: "memory");
        }
    }
    __syncthreads();
}

constexpr int NTHREADS = 512, NWAVES = 8;
constexpr int LDS_BYTES = 147456;
constexpr int LDS_MISC = 143360;

struct Args {
    const float* in[24]; float* out; unsigned char* ws; int ph_lo, ph_hi;
};
struct Ctx {
    const float *x, *c, *ctx, *c_ctx, *ada_w, *ada_b, *norm_g, *w_in, *q_gain, *kv_gain, *w_uq, *w_ukv, *sink, *dlam, *subln, *pool_w, *pool_scale,
                *w_out, *r_gw, *r_gb, *r_ew, *r_eb, *w_gu, *w_down;
    float* out; unsigned char* ws; int wv;
    float* mod; float* hctx;
    bf16_t *QA, *KA, *VA, *QB, *KB, *VB, *QC, *KC, *VC, *U, *O;
    bf16_t *WIN, *WOUT, *WUQ, *WUKV, *WGU, *WDN, *HX, *CQ, *CKVR; float *SSQ, *SSK;
    bf16_t *OX, *ACT, *HM, *FX; float *SS1, *SS2, *TOKW; int* LIST; int* CNTW;
};
__device__ __forceinline__ int lane_id();
template <int K> __device__ __forceinline__ float xshfl(float v) {
    if constexpr (K == 32) { auto rr = __builtin_amdgcn_permlane32_swap(__float_as_uint(v), __float_as_uint(v), false, false); return __uint_as_float(lane_id() < 32 ? rr[1] : rr[0]); }
    else return __uint_as_float((unsigned)__builtin_amdgcn_ds_swizzle((int)__float_as_uint(v), (K << 10) | 0x1f));
}
__device__ __forceinline__ float wave_sum(float v) {
    v += xshfl<32>(v); v += xshfl<16>(v); v += xshfl<8>(v); v += xshfl<4>(v); v += xshfl<2>(v); v += xshfl<1>(v);
    return v;
}
__device__ __forceinline__ float wave_max(float v) {
    v = fmaxf(v, xshfl<32>(v)); v = fmaxf(v, xshfl<16>(v)); v = fmaxf(v, xshfl<8>(v)); v = fmaxf(v, xshfl<4>(v)); v = fmaxf(v, xshfl<2>(v)); v = fmaxf(v, xshfl<1>(v));
    return v;
}
__device__ __forceinline__ float block_sum(float v, float* red) {
    v = wave_sum(v);
    __syncthreads();
    if ((threadIdx.x & 63) == 0) red[threadIdx.x >> 6] = v;
    __syncthreads();
    float s = 0.f;
#pragma unroll
    for (int i = 0; i < NWAVES; ++i) s += red[i];
    return s;
}
__device__ __forceinline__ int lane_id() { int l = (int)__builtin_amdgcn_mbcnt_hi(~0u, __builtin_amdgcn_mbcnt_lo(~0u, 0u)); asm volatile("" : "+v"(l)); return l; }
__device__ __forceinline__ int opaque_tid(int wv) { int t = wv * 64 + lane_id(); asm volatile("" : "+v"(t)); return t; }
__device__ __forceinline__ float silu_f(float v) { return v / (1.f + __expf(-v)); }
__device__ __forceinline__ float lam_init_of(int layer) { return layer == 0 ? 0.2f : (0.8f - 0.6f * 0.7408182206817179f); }

__device__ __forceinline__ const float* xrow_in(const Ctx& C, int layer, int r) {
    const float* a0 = C.x + 0; const float* a1 = C.out + 0; const float* b0 = C.ctx + 0; const float* b1 = C.hctx + 0;
    if (r < TL) return (layer == 0 ? a0 : a1) + (size_t)r * D;
    return (layer == 0 ? b0 : b1) + (size_t)(r - TL) * D;
}
__device__ __forceinline__ float* xrow_out(const Ctx& C, int r) { float* a1 = C.out + 0; float* b1 = C.hctx + 0; return (r < TL) ? a1 + (size_t)r * D : b1 + (size_t)(r - TL) * D; }

__device__ __forceinline__ void phase_mod(const Ctx& C, float* lds) {
    float* sv = lds;
    float* part = lds + 17 * 1024;
    const int tid = opaque_tid(C.wv), lane = tid & 63, wave = tid >> 6;
    {
        float4 cv[9]; const float4* cp4 = (const float4*)(C.c + 0); const float4* cx4 = (const float4*)(C.c_ctx + 0);
#pragma unroll
        for (int j = 0; j < 9; ++j) { const int i4 = tid + NTHREADS * j; const float4* p = (i4 < 4096) ? cp4 + i4 : cx4 + min(i4 - 4096, 255); cv[j] = *p; }
#pragma unroll
        for (int j = 0; j < 9; ++j) { const int i4 = tid + NTHREADS * j;
            if (i4 < 17 * 256) ((float4*)sv)[i4] = make_float4(silu_f(cv[j].x), silu_f(cv[j].y), silu_f(cv[j].z), silu_f(cv[j].w)); }
    }
    __syncthreads();
    const int nitems = DEPTH * (NMOD * D / 64);
    for (int item = blockIdx.x; item < nitems; item += gridDim.x) {
        const int l = item / (NMOD * D / 64), j = (item % (NMOD * D / 64)) * 64 + lane;
        const float* w = C.ada_w + (size_t)l * D * (NMOD * D) + j;
        float acc[17];
#pragma unroll
        for (int r = 0; r < 17; ++r) acc[r] = 0.f;
#pragma unroll 1
        for (int k0 = wave * 128; k0 < wave * 128 + 128; k0 += 32) {
            float wv[32];
#pragma unroll
            for (int i = 0; i < 32; ++i) wv[i] = w[(size_t)(k0 + i) * (NMOD * D)];
#pragma unroll
            for (int i = 0; i < 32; ++i)
#pragma unroll
                for (int r = 0; r < 17; ++r) acc[r] += sv[r * 1024 + k0 + i] * wv[i];
        }
#pragma unroll
        for (int r = 0; r < 17; ++r) part[(wave * 17 + r) * 64 + lane] = acc[r];
        __syncthreads();
        for (int i = tid; i < 17 * 64; i += NTHREADS) {
            const int r = i >> 6, jj = i & 63; float s = 0.f;
#pragma unroll
            for (int w8 = 0; w8 < 8; ++w8) s += part[(w8 * 17 + r) * 64 + jj];
            const int col = (item % (NMOD * D / 64)) * 64 + jj;
            C.mod[((size_t)l * 17 + r) * (NMOD * D) + col] = s + C.ada_b[(size_t)l * NMOD * D + col];
        }
        __syncthreads();
    }
}

namespace pg8 {
typedef short bf16x8 __attribute__((ext_vector_type(8)));
typedef float f32x4 __attribute__((ext_vector_type(4)));
typedef unsigned u32x4 __attribute__((ext_vector_type(4)));
typedef unsigned u32x2 __attribute__((ext_vector_type(2)));
constexpr int BM = 256, BK = 64, HALF = 128, HTB = HALF * BK * 2, STAGE_BYTES = 8 * HTB, NXCD = 8, WGM = 8;
__host__ __device__ __forceinline__ int lds_byte(int r, int c) { const int st = (r >> 4) * 2 + (c >> 5), rr = r & 15, cc = c & 31, ob = rr * 64 + cc * 2; return st * 1024 + (ob ^ (((ob >> 9) & 1) << 5)); }
__host__ __device__ __forceinline__ void stage_rc(int b, int& R, int& C) { const int st = b / 1024, sb = b % 1024, swz = sb ^ (((sb >> 9) & 1) << 5); R = (st >> 1) * 16 + swz / 64; C = (st & 1) * 32 + (swz % 64) / 2; }
__host__ __device__ __forceinline__ int perm32(int rho) { const int n = rho >> 4, i = rho & 15; return 8 * (i >> 2) + 4 * n + (i & 3); }
__device__ __forceinline__ unsigned cvt_pk_bf16(float lo, float hi) { unsigned r; asm volatile("v_cvt_pk_bf16_f32 %0, %1, %2" : "=v"(r) : "v"(lo), "v"(hi)); return r; }

__device__ __forceinline__ bool static_tile(int i, int G, int c, int nM, int nN, int& pm, int& pn) {
    const int nwg = nM * nN; const long L = (long)i * G + c; if (L >= nwg) return false;
    int wgid = (int)L; { const int q = nwg / NXCD, r = nwg % NXCD, xcd = wgid % NXCD, off = wgid / NXCD; wgid = (xcd < r ? xcd * (q + 1) : r * (q + 1) + (xcd - r) * q) + off; }
    const int nig = WGM * nN, gid = wgid / nig, fm = gid * WGM, gsz = (nM - fm) < WGM ? (nM - fm) : WGM;
    pm = fm + ((wgid % nig) % gsz); pn = (wgid % nig) / gsz; return true;
}
struct GUnit { const char* A; const char* B; const char* B2; int pm, pn, x0, x1; };
template <int PH, class Epi, class Sched>
__device__ __forceinline__ void gemm_phase(LAS unsigned char* lds, const int wv, const int K, const int ldb  , const int ksplit  , const Sched& S, const Epi& E) {
    const int tid = opaque_tid(wv), wid = __builtin_amdgcn_readfirstlane(tid >> 6), lane = tid & 63, wr = wid >> 2, wc = wid & 3, fr = lane & 15, fq = lane >> 4;
    volatile LAS unsigned* MISC = (volatile LAS unsigned*)(lds + LDS_MISC); (void)MISC;
    int nt = K / BK; asm volatile("" : "+s"(nt));
    unsigned voffB[2];
#pragma unroll
    for (int i = 0; i < 2; ++i) { int R_, C_; stage_rc(tid * 16 + i * 8192, R_, C_); const int Rb = Epi::PERM ? ((R_ & ~31) + perm32(R_ & 31)) : R_; voffB[i] = (unsigned)(Rb * ldb + C_) * 2u; }
    const size_t kstep = (size_t)(BK * 2);
    const size_t hstepB = (size_t)HALF * ldb * 2;
    const unsigned ldsw = (unsigned)wid * 1024u;
    const int aoff = lds_byte(wr * 64 + fr, fq * 8), boff = lds_byte(wc * 32 + fr, fq * 8);
#define PG8_SA(b, h) (((b) * 2 + (h)) * HTB)
#define PG8_SB(b, h) ((4 + (b) * 2 + (h)) * HTB)
#define PG8_STAGE(bufoff, gbase, v0, v1) do { \
        __builtin_amdgcn_global_load_lds((const unsigned*)((const char*)(gbase) + (v0)), (LAS unsigned*)(lds + (bufoff) + ldsw), 16, 0, 0); \
        __builtin_amdgcn_global_load_lds((const unsigned*)((const char*)(gbase) + (v1)), (LAS unsigned*)(lds + (bufoff) + ldsw + 8192), 16, 0, 0); } while (0)
#define PG8_STAGE_B(bufoff, gbase) PG8_STAGE(bufoff, gbase, voffB[0], voffB[1])
#define PG8_LDA(dst, b, h) do { _Pragma("unroll") for (int m = 0; m < 4; ++m) _Pragma("unroll") for (int k = 0; k < 2; ++k) dst[m][k] = *(const LAS bf16x8*)(lds + PG8_SA(b, h) + aoff + m * 2048 + k * 1024); } while (0)
#define PG8_LDB(dst, b, h) do { _Pragma("unroll") for (int n = 0; n < 2; ++n) _Pragma("unroll") for (int k = 0; k < 2; ++k) dst[n][k] = *(const LAS bf16x8*)(lds + PG8_SB(b, h) + boff + n * 2048 + k * 1024); } while (0)
#define PG8_MMA(ai, bj, At, Bt) do { __builtin_amdgcn_s_setprio(1); _Pragma("unroll") for (int m = 0; m < 4; ++m) _Pragma("unroll") for (int n = 0; n < 2; ++n) _Pragma("unroll") for (int k = 0; k < 2; ++k) \
        acc[ai][bj][m][n] = __builtin_amdgcn_mfma_f32_16x16x32_bf16(Bt[n][k], At[m][k], acc[ai][bj][m][n], 0, 0, 0); __builtin_amdgcn_s_setprio(0); } while (0)
#define PG8_WAIT_V(n) asm volatile("s_waitcnt vmcnt(" #n ")" ::: "memory")
#define PG8_WAIT_L(n) asm volatile("s_waitcnt lgkmcnt(" #n ")" ::: "memory")
#define PG8_BAR __builtin_amdgcn_s_barrier()
#define PG8_SCHED __builtin_amdgcn_sched_barrier(0)
#define PG8_BPTR(u, kt) ((const char*)((((kt) < ksplit) ? (unsigned long long)(u).B : (unsigned long long)(u).B2 - (unsigned long long)ksplit * kstep) + (unsigned long long)(kt) * kstep))
    GUnit cur, nxt; int ui = 0;
    if (!S.next(0, cur)) return;

    f32x4 acc[2][2][4][2];
#pragma unroll
    for (int a = 0; a < 2; ++a)
#pragma unroll
        for (int b = 0; b < 2; ++b)
#pragma unroll
            for (int m = 0; m < 4; ++m)
#pragma unroll
                for (int n = 0; n < 2; ++n) acc[a][b][m][n] = (f32x4){0.f, 0.f, 0.f, 0.f};
    bf16x8 At[4][2], B0[2][2], B1[2][2];
    unsigned vc00, vc01, vc10, vc11;
#define PG8_AOFFS(u) do { int R0_, C0_, R1_, C1_; stage_rc(tid * 16, R0_, C0_); stage_rc(tid * 16 + 8192, R1_, C1_); \
        vc00 = S.arow(u, R0_) + C0_ * 2u; vc01 = S.arow(u, R1_) + C1_ * 2u; vc10 = S.arow(u, HALF + R0_) + C0_ * 2u; vc11 = S.arow(u, HALF + R1_) + C1_ * 2u; } while (0)
    PG8_AOFFS(cur);
    const char* cA = cur.A;
    {
        const char* b0 = PG8_BPTR(cur, 0); const char* b1 = PG8_BPTR(cur, 1);
        PG8_STAGE_B(PG8_SB(0, 0), b0); PG8_STAGE(PG8_SA(0, 0), cA, vc00, vc01); PG8_STAGE_B(PG8_SB(0, 1), b0 + hstepB); PG8_STAGE(PG8_SA(0, 1), cA, vc10, vc11);
        if (wr == 1) PG8_BAR;
        PG8_WAIT_V(4); PG8_BAR;
        PG8_STAGE_B(PG8_SB(1, 0), b1); PG8_STAGE(PG8_SA(1, 0), cA + kstep, vc00, vc01); PG8_STAGE_B(PG8_SB(1, 1), b1 + hstepB);
        PG8_WAIT_V(6); PG8_BAR;
    }
#pragma unroll 1
    for (;;) {
        const bool has_next = S.next(ui + 1, nxt);
        if (!has_next) nxt = cur;
        const char* nA = nxt.A;
#pragma unroll 1
        for (int t = 0; t < nt; t += 2) {
            const bool last = (t == nt - 2);
            const char* a1 = cA + (size_t)(t + 1) * kstep;
            const char* a2 = last ? nA : cA + (size_t)(t + 2) * kstep;
            const char* a3 = a2 + kstep;
            const char* b2 = last ? PG8_BPTR(nxt, 0) : PG8_BPTR(cur, t + 2);
            const char* b3 = last ? PG8_BPTR(nxt, 1) : PG8_BPTR(cur, t + 3);
            PG8_LDB(B0, 0, 0); PG8_SCHED; PG8_LDA(At, 0, 0); PG8_STAGE(PG8_SA(1, 1), a1, vc10, vc11);
            PG8_WAIT_L(8); PG8_BAR; PG8_WAIT_L(0); PG8_MMA(0, 0, At, B0); PG8_BAR; PG8_SCHED;
            {
                int R0_, C0_, R1_, C1_; stage_rc(tid * 16, R0_, C0_); stage_rc(tid * 16 + 8192, R1_, C1_);
                const unsigned n00 = S.arow(nxt, R0_) + C0_ * 2u, n01 = S.arow(nxt, R1_) + C1_ * 2u, n10 = S.arow(nxt, HALF + R0_) + C0_ * 2u, n11 = S.arow(nxt, HALF + R1_) + C1_ * 2u;
                vc00 = last ? n00 : vc00; vc01 = last ? n01 : vc01; vc10 = last ? n10 : vc10; vc11 = last ? n11 : vc11; }
            PG8_LDB(B1, 0, 1); PG8_STAGE_B(PG8_SB(0, 0), b2);
            PG8_BAR; PG8_WAIT_L(0); PG8_MMA(0, 1, At, B1); PG8_BAR;
            PG8_LDA(At, 0, 1); PG8_STAGE(PG8_SA(0, 0), a2, vc00, vc01);
            PG8_BAR; PG8_WAIT_L(0); PG8_MMA(1, 0, At, B0); PG8_BAR; PG8_SCHED;
            PG8_STAGE_B(PG8_SB(0, 1), b2 + hstepB);
            PG8_WAIT_V(6); PG8_BAR; PG8_MMA(1, 1, At, B1); PG8_BAR;
            PG8_LDB(B0, 1, 0); PG8_SCHED; PG8_LDA(At, 1, 0); PG8_STAGE(PG8_SA(0, 1), a2, vc10, vc11);
            PG8_WAIT_L(8); PG8_BAR; PG8_WAIT_L(0); PG8_MMA(0, 0, At, B0); PG8_BAR; PG8_SCHED;
            PG8_LDB(B1, 1, 1); PG8_STAGE_B(PG8_SB(1, 0), b3);
            PG8_BAR; PG8_WAIT_L(0); PG8_MMA(0, 1, At, B1); PG8_BAR;
            PG8_LDA(At, 1, 1); PG8_STAGE(PG8_SA(1, 0), a3, vc00, vc01);
            PG8_BAR; PG8_WAIT_L(0); PG8_MMA(1, 0, At, B0); PG8_BAR; PG8_SCHED;
            PG8_STAGE_B(PG8_SB(1, 1), b3 + hstepB);
            PG8_WAIT_V(6); PG8_BAR; PG8_MMA(1, 1, At, B1); PG8_BAR;
        }
        { if (PROBE_SEL >= 20 && PROBE_SEL < 30) STAMP_BEGIN(); E(acc, cur, wr, wc, fr, fq); STAMP_END(20 + PH); }
        if (!has_next) break;
#pragma unroll
        for (int a = 0; a < 2; ++a)
#pragma unroll
            for (int b = 0; b < 2; ++b)
#pragma unroll
                for (int m = 0; m < 4; ++m)
#pragma unroll
                    for (int n = 0; n < 2; ++n) acc[a][b][m][n] = (f32x4){0.f, 0.f, 0.f, 0.f};
        cur = nxt; cA = nA; ++ui;
    }
    PG8_WAIT_V(0);
    if (wr == 0) PG8_BAR;
    PG8_BAR;
#undef PG8_SA
#undef PG8_SB
#undef PG8_STAGE
#undef PG8_STAGE_B
#undef PG8_LDA
#undef PG8_LDB
#undef PG8_MMA
#undef PG8_WAIT_V
#undef PG8_WAIT_L
#undef PG8_BAR
#undef PG8_SCHED
#undef PG8_BPTR
#undef PG8_AOFFS
}
}

template <class CM>
__device__ __forceinline__ void transpose_item(const float* W, int ldw, int Ksrc, const float* rs, bf16_t* dst, int K, const CM& cm, float* scr, int kb, int nb, int lane) {
    const int k0 = 64 * kb, n0 = 32 * nb;
    const int col = cm(n0 + (lane & 31));
    float v[32];
#pragma unroll
    for (int i = 0; i < 32; ++i) { const int k = k0 + 2 * i + (lane >> 5); const bool ok = (col >= 0) && (k < Ksrc);
        const float x = __builtin_nontemporal_load(W + (ok ? (size_t)k * ldw + col : (size_t)0)); v[i] = ok ? (rs ? x * rs[ok ? k : 0] : x) : 0.f; }
#pragma unroll
    for (int i = 0; i < 32; ++i) scr[(2 * i + (lane >> 5)) * 33 + (lane & 31)] = v[i];
    asm volatile("s_waitcnt lgkmcnt(0)" ::: "memory");
    const int c = lane & 7;
#pragma unroll
    for (int j = 0; j < 4; ++j) { const int n = (lane >> 3) + 8 * j; const float* sp = scr + (8 * c) * 33 + n;
        uint4 o; o.x = pg8::cvt_pk_bf16(sp[0 * 33], sp[1 * 33]); o.y = pg8::cvt_pk_bf16(sp[2 * 33], sp[3 * 33]); o.z = pg8::cvt_pk_bf16(sp[4 * 33], sp[5 * 33]); o.w = pg8::cvt_pk_bf16(sp[6 * 33], sp[7 * 33]);
        __builtin_nontemporal_store((pg8::u32x4){o.x, o.y, o.z, o.w}, (pg8::u32x4*)(dst + (size_t)(n0 + n) * K + k0 + 8 * c)); }
    asm volatile("s_waitcnt lgkmcnt(0)" ::: "memory");
}
__device__ __forceinline__ int headperm64(int w) { const int gi = w >> 5, wp = w & 31; return (wp < 16) ? 16 * gi + wp : 32 + 16 * gi + (wp - 16); }
struct WinMap { __device__ __forceinline__ int operator()(int n) const {
    if (n < 416) return n;
    if (n < 512) return -1;
    if (n < 768) { const int h = (n - 512) >> 6; return Z_BQ + h * 64 + headperm64((n - 512) & 63); }
    if (n < 896) { const int h = (n - 768) >> 6; return Z_BK + h * 64 + headperm64((n - 768) & 63); }
    if (n < 1024) return Z_BV + (n - 896);
    if (n < 1280) return Z_DQ + (n - 1024);
    if (n < 1536) return Z_DK + (n - 1280);
    if (n < 1792) return Z_DV + (n - 1536);
    return Z_U + (n - 1792); } };
struct IdMap { int nvalid; __device__ __forceinline__ int operator()(int n) const { return n < nvalid ? n : -1; } };
struct GuMap { __device__ __forceinline__ int operator()(int n) const { const int q = n >> 8, c = n & 255, jj = c >> 3, t = c & 7, hid = 128 * q + 4 * jj + (t & 3); return (t < 4) ? hid : 512 + hid; } };

constexpr int CV_IN = 16 * 64, CV_UQ = 4 * 16, CV_UKV = 4 * 16, CV_OUT = 16 * 32, CV_GU = 16 * 16 * 32, CV_DN = 16 * 8 * 32;
constexpr int CV_L = CV_IN + CV_UQ + CV_UKV + CV_OUT + CV_GU + CV_DN, CV_FOLD = 64 * 4, CV_TOTAL = CV_L + CV_FOLD;
__device__ __forceinline__ void convert_item(const Ctx& C, int l, int r, float* scr, int lane) {
    if (r < CV_L) {
        if (r < CV_IN) { if ((r % 64) >= 56) return;
            transpose_item(C.w_in + (size_t)l * D * D_IN, D_IN, D, nullptr, C.WIN + (size_t)l * 2048 * 1024, 1024, WinMap{}, scr, r / 64, r % 64, lane); return; } r -= CV_IN;
        if (r < CV_UQ) { transpose_item(C.w_uq + (size_t)l * 256 * 384, 384, 256, C.q_gain + l * 256, C.WUQ + (size_t)l * 512 * 256, 256, IdMap{384}, scr, r / 16, r % 16, lane); return; } r -= CV_UQ;
        if (r < CV_UKV) { transpose_item(C.w_ukv + (size_t)l * 128 * 512, 512, 128, C.kv_gain + l * 128, C.WUKV + (size_t)l * 512 * 256, 256, IdMap{512}, scr, r / 16, r % 16, lane); return; } r -= CV_UKV;
        if (r < CV_OUT) { transpose_item(C.w_out + (size_t)l * D * D, D, D, nullptr, C.WOUT + (size_t)l * 1024 * 1024, 1024, IdMap{1024}, scr, r / 32, r % 32, lane); return; } r -= CV_OUT;
        if (r < CV_GU) { const int e = r / (16 * 32), q = r % (16 * 32);
            transpose_item(C.w_gu + ((size_t)l * 16 + e) * D * 1024, 1024, D, nullptr, C.WGU + ((size_t)l * 16 + e) * 1024 * 1024, 1024, GuMap{}, scr, q / 32, q % 32, lane); return; } r -= CV_GU;
        { const int e = r / (8 * 32), q = r % (8 * 32);
            transpose_item(C.w_down + ((size_t)l * 16 + e) * 512 * D, D, 512, nullptr, C.WDN + ((size_t)l * 16 + e) * 1024 * 512, 512, IdMap{1024}, scr, q / 32, q % 32, lane); }
        return;
    }
    const int f = r - CV_L, kb = f / 4, g = f % 4;
    float pwr[64];
#pragma unroll
    for (int c = 0; c < 64; ++c) pwr[c] = C.pool_w[(((size_t)l * 4 + g) * 64 + c) * 64 + lane];
    const float sc = C.pool_scale[l * 256 + g * 64 + lane];
    bf16_t* dst = C.WIN + ((size_t)l * 2048 + 1792 + g * 64 + lane) * 1024 + kb * 16;
#pragma unroll 1
    for (int k8 = 0; k8 < 2; ++k8) {
        float acc[8];
#pragma unroll
        for (int j = 0; j < 8; ++j) {
            const float wk = C.w_in[((size_t)l * D + kb * 16 + k8 * 8 + j) * D_IN + Z_U + g * 64 + lane];
            float a = 0.f;
#pragma unroll
            for (int c = 0; c < 64; ++c) a += __builtin_bit_cast(float, __builtin_amdgcn_readlane(__builtin_bit_cast(int, wk), c)) * pwr[c];
            acc[j] = a * sc;
        }
        uint4 o; o.x = pg8::cvt_pk_bf16(acc[0], acc[1]); o.y = pg8::cvt_pk_bf16(acc[2], acc[3]); o.z = pg8::cvt_pk_bf16(acc[4], acc[5]); o.w = pg8::cvt_pk_bf16(acc[6], acc[7]);
        *(uint4*)(dst + k8 * 8) = o;
    }
}
__device__ __forceinline__ void phase_convert(const Ctx& C, float* lds) {
    const int tid = opaque_tid(C.wv), lane = tid & 63, wave = tid >> 6;
    float* scr = lds + wave * (64 * 33);
    const int gw = blockIdx.x * NWAVES + wave, ngw = gridDim.x * NWAVES;
    for (int it = gw; it < CV_TOTAL; it += ngw) convert_item(C, 0, (it < CV_FOLD) ? CV_L + it : it - CV_FOLD, scr, lane);
}
constexpr int CV_S1 = 6400, CV_S2 = CV_TOTAL;
__device__ __forceinline__ void static_convert(const Ctx& C, float* lds, int first, int end, int rank, int nranks) {
    const int tid = opaque_tid(C.wv), lane = tid & 63, wave = tid >> 6;
    float* scr = lds + wave * (64 * 33);
    __syncthreads();
    for (int it = first + rank * NWAVES + wave; it < end; it += nranks * NWAVES) convert_item(C, 1, (it < CV_FOLD) ? CV_L + it : it - CV_FOLD, scr, lane);
    __syncthreads();
}
constexpr int CW_BG = 10240;
__device__ __forceinline__ void bg_convert(const Ctx& C, float* lds, volatile LAS unsigned* MISC, int max_batches) {
    const int tid = opaque_tid(C.wv), lane = tid & 63, wave = tid >> 6;
    float* scr = lds + wave * (64 * 33);
    unsigned* head = (unsigned*)(C.ws + WS_CTL) + CW_BG;
    for (int bt = 0; max_batches < 0 || bt < max_batches; ++bt) {
        __syncthreads();
        if (tid == 0) MISC[25] = atomicAdd(head, 8u);
        __syncthreads();
        const int base = (int)MISC[25];
        if (base >= CV_TOTAL) break;
        const int it = base + wave;
        if (it < CV_TOTAL) convert_item(C, 1, (it < CV_FOLD) ? CV_L + it : it - CV_FOLD, scr, lane);
    }
    __syncthreads();
}

struct Ln0In { float4 v[4], sh[4], sc[4]; };
__device__ __forceinline__ void ln0_load(Ln0In& R, const Ctx& C, int layer, int r, int lane) {
    const bool isctx = r >= TL; const int b = isctx ? (r - TL) / CTXL : r / SEQ;
    const float4* modp = (const float4*)(C.mod + ((size_t)layer * 17 + (isctx ? 16 : b)) * (NMOD * D));
    const float4* xr = (const float4*)xrow_in(C, layer, r);
#pragma unroll
    for (int j = 0; j < 4; ++j) { R.v[j] = xr[lane + 64 * j]; R.sh[j] = modp[lane + 64 * j]; R.sc[j] = modp[256 + lane + 64 * j]; }
}
__device__ __forceinline__ void ln0_row(const Ln0In& R, const float4 (&gq)[4], const Ctx& C, int r, int lane) {
    float ss = 0.f;
#pragma unroll
    for (int j = 0; j < 4; ++j) ss += (R.v[j].x * R.v[j].x + R.v[j].y * R.v[j].y) + (R.v[j].z * R.v[j].z + R.v[j].w * R.v[j].w);
    const float rstd = rsqrtf(wave_sum(ss) * (1.f / D) + EPS);
    uint2* o = (uint2*)(C.HX + (size_t)r * D);
#pragma unroll
    for (int j = 0; j < 4; ++j) { const float4 g = gq[j], sh = R.sh[j], sc = R.sc[j], v = R.v[j];
        uint2 w; w.x = pg8::cvt_pk_bf16((v.x * rstd * g.x) * (1.f + sc.x) + sh.x, (v.y * rstd * g.y) * (1.f + sc.y) + sh.y);
        w.y = pg8::cvt_pk_bf16((v.z * rstd * g.z) * (1.f + sc.z) + sh.z, (v.w * rstd * g.w) * (1.f + sc.w) + sh.w);
        o[lane + 64 * j] = w; }
}
__device__ __forceinline__ void phase_ln0(const Ctx& C, int layer) {
    const int tid = opaque_tid(C.wv), lane = tid & 63, wave = tid >> 6;
    const int gw = blockIdx.x * NWAVES + wave, ngw = gridDim.x * NWAVES;
    const float4* g0 = (const float4*)(C.norm_g + ((size_t)layer * 4 + 0) * D);
    if (gw >= T) return;
    float4 gq[4];
#pragma unroll
    for (int j = 0; j < 4; ++j) gq[j] = g0[lane + 64 * j];
    Ln0In A, B;
    ln0_load(A, C, layer, gw, lane);
#pragma unroll 1
    for (int r = gw; r < T; r += 2 * ngw) {
        const int rb = (r + ngw < T) ? r + ngw : r;
        ln0_load(B, C, layer, rb, lane);
        ln0_row(A, gq, C, r, lane);
        const int rn = (r + 2 * ngw < T) ? r + 2 * ngw : rb;
        ln0_load(A, C, layer, rn, lane);
        ln0_row(B, gq, C, rb, lane);
    }
}

__device__ __forceinline__ void rope8(pg8::f32x4& v0, pg8::f32x4& v1, LAS const float* tabrow, int fq) {
    const pg8::f32x4 c0 = *(LAS const pg8::f32x4*)tabrow, c1 = *(LAS const pg8::f32x4*)(tabrow + 4), s0 = *(LAS const pg8::f32x4*)(tabrow + 64 * 24), s1 = *(LAS const pg8::f32x4*)(tabrow + 64 * 24 + 4);
    const float cs[8] = {c0.x, c0.y, c0.z, c0.w, c1.x, c1.y, c1.z, c1.w}; const float sn[8] = {s0.x, s0.y, s0.z, s0.w, s1.x, s1.y, s1.z, s1.w};
    const float sg = (fq < 2) ? -1.f : 1.f;
#pragma unroll
    for (int e = 0; e < 8; ++e) {
        const float v = (e < 4) ? v0[e & 3] : v1[e & 3];
        const float pv = xshfl<32>(v);
        const float o = v * cs[e] + pv * (sg * sn[e]);
        if (e < 4) v0[e & 3] = o; else v1[e & 3] = o;
    }
}
__device__ __forceinline__ size_t kimg_off(int r, int hs, int nhs, int nch, int c) { return ((size_t)((r >> 6) * nhs + hs) * nch + c) * 512 + (r & 63) * 8; }
__device__ __forceinline__ size_t vimg_off(int r, int hs, int nhs, int d8) { return (size_t)((r >> 6) * nhs + hs) * 4096 + ((d8 >> 2) * 4 + ((r & 63) >> 4)) * 512 + (r & 15) * 32 + (d8 & 3) * 8; }
constexpr int ROPE_LDS = 131072;
__device__ __forceinline__ void stage_rope_table(LAS unsigned char* lds3, int wv) {
    const int tid = opaque_tid(wv); LAS float* dst = (LAS float*)(lds3 + ROPE_LDS); const float* src = (const float*)&g_rope;
    const pg8::f32x4* s4 = (const pg8::f32x4*)src; const int i1 = min(tid + NTHREADS, 2 * 64 * 24 / 4 - 1);
    const pg8::f32x4 a = s4[tid], b = s4[i1];
    *(LAS pg8::f32x4*)(dst + 4 * tid) = a; if (tid + NTHREADS < 2 * 64 * 24 / 4) *(LAS pg8::f32x4*)(dst + 4 * (tid + NTHREADS)) = b;
    __syncthreads();
}
struct SchedInProj {
    int G, c, layer; const char* A; const char* W;
    __device__ __forceinline__ bool next(int i, pg8::GUnit& u) const { int pm, pn;
        if ((G & 7) == 0) { const int per = G >> 3; pn = c & 7; pm = (c >> 3) + per * i; if (pm >= T / 256) return false; }
        else if (!pg8::static_tile(i, G, c, T / 256, 8, pm, pn)) return false;
        u.pm = pm; u.pn = pn; u.A = A; u.B = W + (size_t)pn * 256 * 1024 * 2; u.B2 = u.B; u.x0 = 0; u.x1 = 0; return true; }
    __device__ __forceinline__ unsigned arow(const pg8::GUnit& u, int row) const { return (unsigned)(u.pm * 256 + row) * 2048u; }
};
struct EpiInProj {
    static constexpr bool PERM = true;
    bf16_t *CQ, *CKVR, *KA, *QB, *KB, *VB, *QC, *KC, *VC, *U; float *SSQ, *SSK; LAS const float* rtab;
    __device__ __forceinline__ void operator()(const pg8::f32x4 (&acc)[2][2][4][2], const pg8::GUnit& u, int wr, int wc, int fr, int fq) const {
        const int row0 = u.pm * 256 + wr * 64 + fr;
        if (u.pn <= 1) {
            float* SS = (u.pn == 0) ? SSQ : SSK;
#pragma unroll
            for (int ai = 0; ai < 2; ++ai)
#pragma unroll
                for (int m = 0; m < 4; ++m) {
                    float p = 0.f;
#pragma unroll
                    for (int bj = 0; bj < 2; ++bj) { if (bj == 1 && u.pn == 1) continue;
#pragma unroll
                        for (int n = 0; n < 2; ++n) { const pg8::f32x4 a = acc[ai][bj][m][n]; p += (a[0] * a[0] + a[1] * a[1]) + (a[2] * a[2] + a[3] * a[3]); } }
                    p += xshfl<16>(p); p += xshfl<32>(p);
                    if (fq == 0) SS[(size_t)(row0 + ai * 128 + m * 16) * 4 + wc] = p;
                }
        }
#pragma unroll
        for (int bj = 0; bj < 2; ++bj) {
            const int g = u.pn * 8 + bj * 4 + wc;
            bf16_t* dst; int pitch, col; int rope = 0  ; float scale = 1.f; bool zero = false;
            int img = 0  , hs = 0, nhs = 1, nch = 1, cbase = 0;
            if (g < 8) { dst = CQ; pitch = 256; col = g * 32; }
            else if (g < 12) { dst = CKVR; pitch = 256; col = (g - 8) * 32; }
            else if (g < 16) { dst = CKVR; pitch = 256; col = (g - 8) * 32; zero = true; if (g == 12) rope = 1; }
            else if (g < 24) { dst = QB; pitch = 256; col = (g - 16) * 32; rope = 2 + (g & 1); scale = SC_B; }
            else if (g < 28) { dst = KB; pitch = 0; col = 0; rope = 2 + (g & 1); img = 1; hs = (g - 24) >> 1; nhs = 2; nch = 8; cbase = (g & 1) * 4; }
            else if (g < 32) { dst = VB; pitch = 0; col = 0; img = 2; hs = (g - 28) >> 1; nhs = 2; cbase = (g & 1) * 4; }
            else if (g < 40) { dst = QC; pitch = 256; col = (g - 32) * 32; rope = 1; scale = SC_C; }
            else if (g < 48) { dst = KC; pitch = 0; col = 0; rope = 1; img = 1; hs = g - 40; nhs = 8; nch = 4; cbase = 0; }
            else if (g < 56) { dst = VC; pitch = 0; col = 0; img = 2; hs = (g - 48) >> 1; nhs = 4; cbase = (g & 1) * 4; }
            else { dst = U; pitch = 256; col = (g - 56) * 32; }
#pragma unroll
            for (int ai = 0; ai < 2; ++ai)
#pragma unroll
                for (int m = 0; m < 4; ++m) {
                    const int row = row0 + ai * 128 + m * 16;
                    pg8::f32x4 v0 = acc[ai][bj][m][0], v1 = acc[ai][bj][m][1];
                    if (rope) {
                        const int t = row & (SEQ - 1);
                        int p, f0;
                        if (rope == 1) { p = (fq & 1) ? (t & 63) : (t >> 6); f0 = 0; }
                        else { p = (rope == 3) ? (t & 63) : (t >> 6); f0 = 8 + 8 * (fq & 1); }
                        if (row >= TL) { p = 0; }
                        rope8(v0, v1, rtab + p * 24 + f0, fq);
                    }
                    if (g == 12) {
                        pg8::u32x4 w; w.x = pg8::cvt_pk_bf16(v0[0], v0[1]); w.y = pg8::cvt_pk_bf16(v0[2], v0[3]); w.z = pg8::cvt_pk_bf16(v1[0], v1[1]); w.w = pg8::cvt_pk_bf16(v1[2], v1[3]);
#pragma unroll
                        for (int h = 0; h < 4; ++h) *(pg8::u32x4*)(KA + kimg_off(row, h, 4, 12, 8 + fq)) = w;
                    }
                    if (zero) { v0 = (pg8::f32x4){0.f, 0.f, 0.f, 0.f}; v1 = v0; }
                    v0 = v0 * scale; v1 = v1 * scale;
                    pg8::u32x4 w; w.x = pg8::cvt_pk_bf16(v0[0], v0[1]); w.y = pg8::cvt_pk_bf16(v0[2], v0[3]); w.z = pg8::cvt_pk_bf16(v1[0], v1[1]); w.w = pg8::cvt_pk_bf16(v1[2], v1[3]);
                    const size_t off = (img == 0) ? (size_t)row * pitch + col + 8 * fq : (img == 1) ? kimg_off(row, hs, nhs, nch, cbase + fq) : vimg_off(row, hs, nhs, cbase + fq);
                    *(pg8::u32x4*)(dst + off) = w;
                }
        }
    }
};

struct SchedMlaUp {
    int G, c, nQ  , nTot; const char *CQ, *CKVR, *WUQ, *WUKV;
    __device__ __forceinline__ bool next(int i, pg8::GUnit& u) const { const long L = (long)i * G + c; if (L >= nTot) return false;
        const int kind = (L >= nQ) ? 1 : 0, tl = (int)L - kind * nQ; u.pm = tl >> 1; u.pn = tl & 1; u.x0 = kind; u.x1 = 0;
        u.A = kind ? CKVR : CQ; u.B = (kind ? WUKV : WUQ) + (size_t)u.pn * 256 * 256 * 2; u.B2 = u.B; return true; }
    __device__ __forceinline__ unsigned arow(const pg8::GUnit& u, int row) const { return (unsigned)(u.pm * 256 + row) * 512u; }
};
struct EpiMlaUp {
    static constexpr bool PERM = true;
    bf16_t *QA, *KA, *VA; const float *SSQ, *SSK; LAS const float* rtab;
    __device__ __forceinline__ void operator()(const pg8::f32x4 (&acc)[2][2][4][2], const pg8::GUnit& u, int wr, int wc, int fr, int fq) const {
        const int row0 = u.pm * 256 + wr * 64 + fr; const bool kv = u.x0 != 0;
        const float* SS = kv ? SSK : SSQ; const float inv_n = kv ? (1.f / 128) : (1.f / 256);
        float rstd8[2][4];
#pragma unroll
        for (int ai = 0; ai < 2; ++ai)
#pragma unroll
            for (int m = 0; m < 4; ++m) { const float4 pp = *(const float4*)(SS + (size_t)(row0 + ai * 128 + m * 16) * 4); rstd8[ai][m] = rsqrtf(((pp.x + pp.y) + (pp.z + pp.w)) * inv_n + EPS); }
#pragma unroll
        for (int bj = 0; bj < 2; ++bj) {
            const int g = u.pn * 8 + bj * 4 + wc;
            bf16_t* dst; int pitch, col; bool rope = false; float scale = 1.f; int img = 0, hs = 0, cbase = 0;
            if (!kv) { if (g >= 12) continue; const int h = g / 3, part = g % 3; dst = QA; pitch = 384; col = h * 96 + part * 32; rope = (part == 2); scale = SC_A; }
            else { hs = g >> 2; const int part = g & 3; if (part < 2) { dst = KA; img = 1; cbase = part * 4; } else { dst = VA; img = 2; cbase = (part - 2) * 4; } pitch = 0; col = 0; }
#pragma unroll
            for (int ai = 0; ai < 2; ++ai)
#pragma unroll
                for (int m = 0; m < 4; ++m) {
                    const int row = row0 + ai * 128 + m * 16;
                    const float rs = rstd8[ai][m] * scale;
                    pg8::f32x4 v0 = acc[ai][bj][m][0] * rs, v1 = acc[ai][bj][m][1] * rs;
                    if (rope) { const int t = row & (SEQ - 1); int p = (fq & 1) ? (t & 63) : (t >> 6); if (row >= TL) p = 0; rope8(v0, v1, rtab + p * 24, fq); }
                    pg8::u32x4 w; w.x = pg8::cvt_pk_bf16(v0[0], v0[1]); w.y = pg8::cvt_pk_bf16(v0[2], v0[3]); w.z = pg8::cvt_pk_bf16(v1[0], v1[1]); w.w = pg8::cvt_pk_bf16(v1[2], v1[3]);
                    const size_t off = (img == 0) ? (size_t)row * pitch + col + 8 * fq : (img == 1) ? kimg_off(row, hs, 4, 12, cbase + fq) : vimg_off(row, hs, 4, cbase + fq);
                    *(pg8::u32x4*)(dst + off) = w;
                }
        }
    }
};

namespace att {
typedef short bf16x8 __attribute__((ext_vector_type(8)));
typedef short s16x4 __attribute__((ext_vector_type(4)));
typedef float f32x16 __attribute__((ext_vector_type(16)));
typedef unsigned u32x4 __attribute__((ext_vector_type(4)));
constexpr int L_K = 0, KBUF = 12288, L_V = 2 * KBUF, VBUF = 8192, L_WS = L_V + 4 * VBUF, L_OST = L_WS + 2048, OST_W = 8704, L_END = L_OST + 8 * OST_W;
static_assert(L_END <= 131072, "attention LDS");
constexpr float NEG_BIG = -1.0e30f;
__device__ __forceinline__ int crow(int r, int hi) { return (r & 3) + 8 * (r >> 2) + 4 * hi; }
__device__ __forceinline__ s16x4 vtr(LAS const char* p) { typedef short v4i16_t __attribute__((ext_vector_type(4))); return __builtin_bit_cast(s16x4, __builtin_amdgcn_ds_read_tr16_b64_v4i16((LAS v4i16_t*)p)); }
__device__ __forceinline__ float max3f(float a, float b, float c) { float r; asm("v_max3_f32 %0, %1, %2, %3" : "=v"(r) : "v"(a), "v"(b), "v"(c)); return r; }
__device__ __forceinline__ float max2f(float a, float b) { float r; asm("v_max_f32_e32 %0, %1, %2" : "=v"(r) : "v"(a), "v"(b)); return r; }
__device__ __forceinline__ float xhalf_max(float v) { auto rr = __builtin_amdgcn_permlane32_swap(__float_as_uint(v), __float_as_uint(v), false, false); return max2f(__uint_as_float(rr[0]), __uint_as_float(rr[1])); }
__device__ __forceinline__ float xhalf_sum(float v) { auto rr = __builtin_amdgcn_permlane32_swap(__float_as_uint(v), __float_as_uint(v), false, false); return __uint_as_float(rr[0]) + __uint_as_float(rr[1]); }

struct Unit {
    const bf16_t *Q, *K, *V;
    int qpitch, khs, knhs, vhs, vnhs;
    int qrow0, qpos0;
    int ctxrow0;
    int latrow0, latpos0, nlat;
    int window;
    bf16_t* O;
    float sink2;
    int two; float sink2b;
    float lam, postmul; const float* subln;
    int wv;
    volatile LAS unsigned* misc;
    int pass;
};
#define ATT_BAR() asm volatile("s_waitcnt lgkmcnt(0)\n\ts_barrier" ::: "memory")
template <int NSTEP  , int MODE>
__device__ __forceinline__ void attn_unit(const Unit& U, LAS char* lds) {
    constexpr int NCOMP = 1;
    constexpr int NCH = 2 * NSTEP * NCOMP;
    constexpr float THR = 8.f;
    const int tid = opaque_tid(U.wv), lane = tid & 63, r32 = lane & 31, hi = lane >> 5; const int wid = U.wv;
    const int grp = wid >> 2;
    const int wv = U.wv; volatile LAS unsigned* MISC = U.misc; (void)wv; (void)MISC;
    LAS float* wsf = (LAS float*)(lds + L_WS) + wid * 64;
    bf16x8 qf[NCOMP][NSTEP];
    { const bf16_t* qp = U.Q + (size_t)(U.qrow0 + wid * 32 + r32) * U.qpitch + hi * 8;
#pragma unroll
      for (int c = 0; c < NCOMP; ++c)
#pragma unroll
        for (int d0 = 0; d0 < NSTEP; ++d0) qf[c][d0] = *(const bf16x8*)(qp + c * NSTEP * 16 + d0 * 16); }
    constexpr bool USE_NEGM = (NCOMP == 1);
    float mrow[NCOMP], lrow[NCOMP]; f32x16 o[NCOMP][2], negm[USE_NEGM ? NCOMP : 1], ps0, ps1;
#pragma unroll
    for (int c = 0; c < NCOMP; ++c) { mrow[c] = 0.f; lrow[c] = 0.f; o[c][0] = f32x16{}; o[c][1] = f32x16{}; if (USE_NEGM) negm[c] = f32x16{}; }
    const int NT = 4 + U.nlat;
    constexpr int KPT = (NCH * 64 + NTHREADS - 1) / NTHREADS;
    u32x4 kreg[KPT], vreg;
#define ATT_ROW0(t) (((t) < 4) ? U.ctxrow0 + 64 * (t) : U.latrow0 + 64 * ((t) - 4))
#define ATT_LOAD(t) do { const int tile_ = ATT_ROW0(t) >> 6; const bf16_t* kt_ = U.K + (size_t)(tile_ * U.knhs + U.khs) * (NCH * 512); \
        _Pragma("unroll") for (int i_ = 0; i_ < KPT; ++i_) { const int pi_ = tid + NTHREADS * i_; if (pi_ < NCH * 64) kreg[i_] = *(const u32x4*)(kt_ + pi_ * 8); } \
        vreg = *(const u32x4*)(U.V + (size_t)(tile_ * U.vnhs + U.vhs) * 4096 + tid * 8); } while (0)
#define ATT_WRITE(buf) do { \
        _Pragma("unroll") for (int i_ = 0; i_ < KPT; ++i_) { const int pi_ = tid + NTHREADS * i_; if (pi_ < NCH * 64) *(LAS u32x4*)(lds + L_K + (buf) * KBUF + pi_ * 16) = kreg[i_]; } \
        *(LAS u32x4*)(lds + L_V + (buf) * VBUF + tid * 16) = vreg; } while (0)
    const int qpos = U.qpos0 + wid * 32 + r32;
    auto QS = [&](const int t) __attribute__((always_inline)) {
        const int buf = t & 1;
        bool skip = false; int kpos0 = 0;
        if (MODE == 1 && t >= 4) { kpos0 = U.latpos0 + 64 * (t - 4); const int qw = U.qpos0 + wid * 32; skip = (kpos0 + 63 < qw - U.window) || (kpos0 > qw + 31 + U.window); }
        if (skip) return;
        LAS const char* kb = lds + L_K + buf * KBUF + hi * 1024 + r32 * 16;
#pragma unroll
        for (int c = 0; c < NCOMP; ++c) {
            bf16x8 kf[2 * NSTEP];
#pragma unroll
            for (int d0 = 0; d0 < NSTEP; ++d0) { kf[2 * d0] = *(LAS const bf16x8*)(kb + (c * 2 * NSTEP + 2 * d0) * 1024); kf[2 * d0 + 1] = *(LAS const bf16x8*)(kb + (c * 2 * NSTEP + 2 * d0) * 1024 + 512); }
            __builtin_amdgcn_sched_barrier(0);
#pragma unroll
            for (int d0 = 0; d0 < NSTEP; ++d0) {
                if (d0 == 0) { const f32x16 cin = USE_NEGM ? negm[USE_NEGM ? c : 0] : f32x16{}; ps0 = __builtin_amdgcn_mfma_f32_32x32x16_bf16(kf[0], qf[c][0], cin, 0, 0, 0); ps1 = __builtin_amdgcn_mfma_f32_32x32x16_bf16(kf[1], qf[c][0], cin, 0, 0, 0); }
                else { ps0 = __builtin_amdgcn_mfma_f32_32x32x16_bf16(kf[2 * d0], qf[c][d0], ps0, 0, 0, 0); ps1 = __builtin_amdgcn_mfma_f32_32x32x16_bf16(kf[2 * d0 + 1], qf[c][d0], ps1, 0, 0, 0); }
            }
            asm volatile("s_nop 15\n\ts_nop 7" : "+v"(ps0), "+v"(ps1));
            if (MODE == 1 && t >= 4) {
#pragma unroll
                for (int r = 0; r < 16; ++r) { const int rel0 = kpos0 + crow(r, hi) - qpos;
                    if (rel0 > U.window || rel0 < -U.window) ps0[r] = NEG_BIG;
                    if (rel0 + 32 > U.window || rel0 + 32 < -U.window) ps1[r] = NEG_BIG; }
            }
            if (!USE_NEGM && t > 0) {
#pragma unroll
                for (int r = 0; r < 16; ++r) { ps0[r] -= mrow[c]; ps1[r] -= mrow[c]; } }
            float ma = max3f(ps0[0], ps0[1], ps1[0]), mb = max3f(ps0[2], ps0[3], ps1[1]); ma = max3f(ma, ps1[2], ps1[3]);
#pragma unroll
            for (int r = 4; r < 16; r += 4) { ma = max3f(ma, ps0[r], ps0[r + 1]); mb = max3f(mb, ps0[r + 2], ps0[r + 3]); ma = max3f(ma, ps1[r], ps1[r + 1]); mb = max3f(mb, ps1[r + 2], ps1[r + 3]); }
            float mx = max2f(ma, mb);
            mx = xhalf_max(mx);
            if (t == 0) {
                mrow[c] = mx;
#pragma unroll
                for (int r = 0; r < 16; ++r) { ps0[r] -= mx; ps1[r] -= mx; if (USE_NEGM) negm[USE_NEGM ? c : 0][r] = -mx; }
            } else if (__builtin_expect(__any(mx > THR), 0)) {
                const float dl = fmaxf(mx, 0.f);
                mrow[c] += dl;
#pragma unroll
                for (int r = 0; r < 16; ++r) { ps0[r] -= dl; ps1[r] -= dl; if (USE_NEGM) negm[USE_NEGM ? c : 0][r] = -mrow[c]; }
                const float alpha = __builtin_amdgcn_exp2f(-dl);
                lrow[c] *= alpha;
                if (hi == 0) wsf[r32] = alpha;
#pragma unroll
                for (int g4 = 0; g4 < 4; ++g4) { const pg8::f32x4 a4 = *(LAS const pg8::f32x4*)(wsf + 8 * g4 + 4 * hi);
                    o[c][0][4 * g4 + 0] *= a4.x; o[c][0][4 * g4 + 1] *= a4.y; o[c][0][4 * g4 + 2] *= a4.z; o[c][0][4 * g4 + 3] *= a4.w;
                    o[c][1][4 * g4 + 0] *= a4.x; o[c][1][4 * g4 + 1] *= a4.y; o[c][1][4 * g4 + 2] *= a4.z; o[c][1][4 * g4 + 3] *= a4.w; }
            }
        }
    };
    auto PV = [&](const int t) __attribute__((always_inline)) {
        if (MODE == 1 && t >= 4) { const int kpos0 = U.latpos0 + 64 * (t - 4); const int qw = U.qpos0 + wid * 32; if ((kpos0 + 63 < qw - U.window) || (kpos0 > qw + 31 + U.window)) return; }
        LAS const char* vp = lds + L_V + (t & 1) * VBUF + ((lane >> 4) & 1) * 32 + (lane & 3) * 8 + (4 * hi + ((lane & 15) >> 2)) * 64;
        s16x4 vlo[8], vhi[8];
#pragma unroll
        for (int i = 0; i < 8; ++i) { vlo[i] = vtr(vp + (i >> 2) * 4096 + (i & 3) * 1024); vhi[i] = vtr(vp + (i >> 2) * 4096 + (i & 3) * 1024 + 512); }
        __builtin_amdgcn_sched_barrier(0);
        bf16x8 pa[4];
        {
            float rs[4] = {0.f, 0.f, 0.f, 0.f};
#pragma unroll
            for (int r = 0; r < 16; ++r) { ps0[r] = __builtin_amdgcn_exp2f(ps0[r]); ps1[r] = __builtin_amdgcn_exp2f(ps1[r]); rs[r & 1] += ps0[r]; rs[2 + (r & 1)] += ps1[r]; }
            lrow[0] += xhalf_sum((rs[0] + rs[1]) + (rs[2] + rs[3]));
            typedef float f32x2_t __attribute__((ext_vector_type(2))); typedef __bf16 bf16x2_t __attribute__((ext_vector_type(2)));
#define ATT_PK(a, b) __builtin_bit_cast(unsigned, __builtin_convertvector((f32x2_t){a, b}, bf16x2_t))
            const u32x4 w0 = (u32x4){ATT_PK(ps0[0], ps0[1]), ATT_PK(ps0[2], ps0[3]), ATT_PK(ps0[4], ps0[5]), ATT_PK(ps0[6], ps0[7])};
            const u32x4 w1 = (u32x4){ATT_PK(ps0[8], ps0[9]), ATT_PK(ps0[10], ps0[11]), ATT_PK(ps0[12], ps0[13]), ATT_PK(ps0[14], ps0[15])};
            const u32x4 w2 = (u32x4){ATT_PK(ps1[0], ps1[1]), ATT_PK(ps1[2], ps1[3]), ATT_PK(ps1[4], ps1[5]), ATT_PK(ps1[6], ps1[7])};
            const u32x4 w3 = (u32x4){ATT_PK(ps1[8], ps1[9]), ATT_PK(ps1[10], ps1[11]), ATT_PK(ps1[12], ps1[13]), ATT_PK(ps1[14], ps1[15])};
#undef ATT_PK
            pa[0] = __builtin_bit_cast(bf16x8, w0); pa[1] = __builtin_bit_cast(bf16x8, w1); pa[2] = __builtin_bit_cast(bf16x8, w2); pa[3] = __builtin_bit_cast(bf16x8, w3);
        }
        __builtin_amdgcn_sched_barrier(0);
#pragma unroll
        for (int d0 = 0; d0 < 2; ++d0)
#pragma unroll
            for (int ks = 0; ks < 4; ++ks) {
                const int i = d0 * 4 + ks;
                const bf16x8 vb = (bf16x8){vlo[i][0], vlo[i][1], vlo[i][2], vlo[i][3], vhi[i][0], vhi[i][1], vhi[i][2], vhi[i][3]};
                o[0][d0] = __builtin_amdgcn_mfma_f32_32x32x16_bf16(pa[ks], vb, o[0][d0], 0, 0, 0);
            }
    };
#ifndef ATT_SKEW
#define ATT_SKEW 0
#endif
#if ATT_SKEW
    ATT_LOAD(0); ATT_WRITE(0);
    if (grp == 1 && NT > 1) ATT_LOAD(1);
    __syncthreads();
    if (grp == 0) {
#pragma unroll 1
        for (int t = 0; t < NT; ++t) {
            { STAMP_BEGIN(); if (t + 1 < NT) ATT_LOAD(t + 1);
            QS(t); STAMP_END(16); }
            { STAMP_BEGIN(); ATT_BAR(); STAMP_END(15); }
            { STAMP_BEGIN(); PV(t); STAMP_END(17); }
            { STAMP_BEGIN(); if (t + 1 < NT) ATT_WRITE((t + 1) & 1); STAMP_END(18); }
            { STAMP_BEGIN(); ATT_BAR(); STAMP_END(15); }
        }
        ATT_BAR();
    } else {
        ATT_BAR();
#pragma unroll 1
        for (int t = 0; t < NT; ++t) {
            QS(t);
            if (t + 1 < NT) ATT_WRITE((t + 1) & 1);
            ATT_BAR();
            if (t + 2 < NT) ATT_LOAD(t + 2);
            PV(t);
            ATT_BAR();
        }
    }
#else
    (void)grp;
    ATT_LOAD(0); ATT_WRITE(0);
    __syncthreads();
#pragma unroll 1
    for (int t = 0; t < NT; ++t) {
        if (t + 1 < NT) ATT_LOAD(t + 1);
        QS(t);
        PV(t);
        if (t + 1 < NT) ATT_WRITE((t + 1) & 1);
        ATT_BAR();
    }
#endif
#undef ATT_ROW0
#undef ATT_LOAD
#undef ATT_WRITE
    float fac = (MODE == 1) ? 1.f / (lrow[0] + __builtin_amdgcn_exp2f(U.sink2 - mrow[0])) : 1.f / lrow[0];
    if (MODE == 2 && U.pass == 2) fac *= -U.lam;
    if (hi == 0) wsf[r32] = fac;
    LAS float* stg = (LAS float*)(lds + L_OST + wid * OST_W);
#pragma unroll
    for (int g4 = 0; g4 < 4; ++g4) {
        const pg8::f32x4 f0 = *(LAS const pg8::f32x4*)(wsf + 8 * g4 + 4 * hi);
        const float ff0[4] = {f0.x, f0.y, f0.z, f0.w};
#pragma unroll
        for (int j = 0; j < 4; ++j) { const int r = 4 * g4 + j, orow = crow(r, hi);
#pragma unroll
            for (int d0 = 0; d0 < 2; ++d0) { float v = o[0][d0][r] * ff0[j]; if (MODE == 2 && U.pass == 2) v += stg[orow * 68 + d0 * 32 + r32]; stg[orow * 68 + d0 * 32 + r32] = v; } }
    }
    if (MODE == 2 && U.pass == 1) { __syncthreads(); return; }
    { const int row = lane >> 1, half = lane & 1; float v[32];
#pragma unroll
      for (int k = 0; k < 8; ++k) { const pg8::f32x4 x = *(LAS const pg8::f32x4*)(stg + row * 68 + half * 32 + 4 * k); v[4 * k] = x.x; v[4 * k + 1] = x.y; v[4 * k + 2] = x.z; v[4 * k + 3] = x.w; }
      if (MODE == 2) { float ss = 0.f;
#pragma unroll
          for (int k = 0; k < 32; ++k) ss += v[k] * v[k];
          ss += xshfl<1>(ss);
          const float rstd = rsqrtf(ss * (1.f / 64) + EPS) * U.postmul;
#pragma unroll
          for (int k = 0; k < 32; ++k) v[k] = v[k] * rstd * U.subln[half * 32 + k]; }
      bf16_t* op = U.O + (size_t)(U.qrow0 + wid * 32 + row) * 1024 + half * 32;
#pragma unroll
      for (int k = 0; k < 4; ++k) { u32x4 w; w.x = pg8::cvt_pk_bf16(v[8 * k], v[8 * k + 1]); w.y = pg8::cvt_pk_bf16(v[8 * k + 2], v[8 * k + 3]); w.z = pg8::cvt_pk_bf16(v[8 * k + 4], v[8 * k + 5]); w.w = pg8::cvt_pk_bf16(v[8 * k + 6], v[8 * k + 7]);
          *(u32x4*)(op + 8 * k) = w; } }
    __syncthreads();
}
#undef ATT_BAR

#define ATT_BAR() asm volatile("s_waitcnt lgkmcnt(0)\n\ts_barrier" ::: "memory")
template <int NSTEP  , int MODE>
__device__ __forceinline__ void attn_unit_p(const Unit& U, LAS char* lds) {
    constexpr int NCH = 2 * NSTEP, NG = 2 * NSTEP, IPG = 48 / NG;
    static_assert(48 % NG == 0, "work items per gap");
    constexpr float THR = 8.f;
    const int tid = opaque_tid(U.wv), lane = tid & 63, r32 = lane & 31, hi = lane >> 5; const int wid = U.wv;
    LAS float* wsf = (LAS float*)(lds + L_WS) + wid * 64;
    const int wv = U.wv; volatile LAS unsigned* MISC = U.misc; (void)wv; (void)MISC;
    bf16x8 qf[NSTEP];
    const int wsub = (MODE == 1 && U.two) ? (wid & 3) : wid, whd = (MODE == 1 && U.two) ? (wid >> 2) : 0;
    { const bf16_t* qp = U.Q + whd * 64 + (size_t)(U.qrow0 + wsub * 32 + r32) * U.qpitch + hi * 8;
#pragma unroll
      for (int d0 = 0; d0 < NSTEP; ++d0) qf[d0] = *(const bf16x8*)(qp + d0 * 16); }
    constexpr bool USE_LACC = (ATT_DEFER != 0) && (NSTEP < ATT_LACC_MAX);
    float mrow = 0.f, lrow = 0.f; f32x16 o0 = f32x16{}, o1 = f32x16{}, negm = f32x16{}, pA0, pA1, pB0 = f32x16{}, pB1 = f32x16{}, lacc = f32x16{};
    const bf16x8 ones = (bf16x8){0x3f80, 0x3f80, 0x3f80, 0x3f80, 0x3f80, 0x3f80, 0x3f80, 0x3f80};
    const int NT = 4 + U.nlat;
    constexpr int KPT = (NCH * 64 + NTHREADS - 1) / NTHREADS;
    constexpr bool DEEP = (ATT_DEFER != 0) && (NSTEP < ATT_DEEP_MAX);
    u32x4 kreg[KPT], vreg, kreg2[DEEP ? KPT : 1], vreg2;
#define ATP_TILE(t) ((((t) < 4) ? U.ctxrow0 + 64 * (t) : U.latrow0 + 64 * ((t) - 4)) >> 6)
#define ATP_LOADK(t, KR) do { const bf16_t* kt_ = U.K + (size_t)(ATP_TILE(t) * U.knhs + U.khs) * (NCH * 512); \
        _Pragma("unroll") for (int i_ = 0; i_ < KPT; ++i_) { const int pi_ = (tid + NTHREADS * i_) % (NCH * 64); KR[i_] = *(const u32x4*)(kt_ + pi_ * 8); } } while (0)
#define ATP_LOADV(t, VR) do { VR = *(const u32x4*)(U.V + (size_t)(ATP_TILE(t) * U.vnhs + U.vhs) * 4096 + tid * 8); } while (0)
#define ATP_WRITEK(buf, KR) do { _Pragma("unroll") for (int i_ = 0; i_ < KPT; ++i_) { const int pi_ = tid + NTHREADS * i_; if (pi_ < NCH * 64) *(LAS u32x4*)(lds + L_K + (buf) * KBUF + pi_ * 16) = KR[i_]; } } while (0)
#define ATP_WRITEV(buf, VR) do { *(LAS u32x4*)(lds + L_V + (buf) * VBUF + tid * 16) = VR; } while (0)
    const int qpos = U.qpos0 + wsub * 32 + r32;
    typedef float f32x2_t __attribute__((ext_vector_type(2))); typedef __bf16 bf16x2_t __attribute__((ext_vector_type(2)));
#define ATP_PK(a, b) __builtin_bit_cast(unsigned, __builtin_convertvector((f32x2_t){a, b}, bf16x2_t))
#define ATP_EXP(x) asm volatile("v_exp_f32_e32 %0, %0" : "+v"(x))
#define ATP_ADD(acc, x) asm volatile("v_add_f32_e32 %0, %1, %0" : "+v"(acc) : "v"(x))
    auto MASK = [&](f32x16& p0, f32x16& p1, const int t) __attribute__((always_inline)) {
        if (MODE == 1 && t >= 4) { const int kpos0 = U.latpos0 + 64 * (t - 4);
            const int qw0 = U.qpos0 + wsub * 32;
            if (kpos0 + 63 - qw0 <= U.window && qw0 + 31 - kpos0 <= U.window) return;
            const unsigned ub = (unsigned)(kpos0 - qpos + U.window + 4 * hi), w2 = 2u * (unsigned)U.window;
#pragma unroll
            for (int r = 0; r < 16; ++r) { const unsigned c = (unsigned)((r & 3) + 8 * (r >> 2));
                if (ub + c > w2) p0[r] = NEG_BIG;
                if (ub + c + 32u > w2) p1[r] = NEG_BIG; } } };
    auto DECIDE = [&](f32x16& p0, f32x16& p1, const float mx, const bool first) __attribute__((always_inline)) {
        if (first) { mrow = mx;
#pragma unroll
            for (int r = 0; r < 16; ++r) { p0[r] -= mx; p1[r] -= mx; negm[r] = -mx; }
        } else if (__builtin_expect(__any(mx > THR), 0)) {
            const float dl = fmaxf(mx, 0.f); mrow += dl;
#pragma unroll
            for (int r = 0; r < 16; ++r) { p0[r] -= dl; p1[r] -= dl; negm[r] = -mrow; }
            const float alpha = __builtin_amdgcn_exp2f(-dl); lrow *= alpha;
            if (hi == 0) wsf[r32] = alpha;
#pragma unroll
            for (int g4 = 0; g4 < 4; ++g4) { const pg8::f32x4 a4 = *(LAS const pg8::f32x4*)(wsf + 8 * g4 + 4 * hi);
                o0[4 * g4 + 0] *= a4.x; o0[4 * g4 + 1] *= a4.y; o0[4 * g4 + 2] *= a4.z; o0[4 * g4 + 3] *= a4.w;
                o1[4 * g4 + 0] *= a4.x; o1[4 * g4 + 1] *= a4.y; o1[4 * g4 + 2] *= a4.z; o1[4 * g4 + 3] *= a4.w;
                if (USE_LACC) { lacc[4 * g4 + 0] *= a4.x; lacc[4 * g4 + 1] *= a4.y; lacc[4 * g4 + 2] *= a4.z; lacc[4 * g4 + 3] *= a4.w; } } } };
    const bool grpB = (ATT_STAGGER != 0) && (ATT_DEFER != 0) && (wid >= 4);
    const int lead = grpB ? 1 : 0;
    static_assert(!DEEP, "");
    {
        u32x4 k1reg[KPT], k0reg[KPT], v0reg;
        ATP_LOADK(0, k0reg); ATP_LOADV(0, v0reg); ATP_LOADK(1, k1reg);
        if (grpB) { ATP_LOADK(2, kreg); ATP_LOADV(1, vreg); }
        ATP_WRITEK(0, k0reg); ATP_WRITEV(0, v0reg); ATP_WRITEK(1, k1reg); }
    __syncthreads();
    { LAS const char* kb = lds + L_K + hi * 1024 + r32 * 16;
#pragma unroll
      for (int d0 = 0; d0 < NSTEP; ++d0) { const bf16x8 b0 = *(LAS const bf16x8*)(kb + 2 * d0 * 1024), b1 = *(LAS const bf16x8*)(kb + 2 * d0 * 1024 + 512);
          if (d0 == 0) { pA0 = __builtin_amdgcn_mfma_f32_32x32x16_bf16(b0, qf[0], negm, 0, 0, 0); pA1 = __builtin_amdgcn_mfma_f32_32x32x16_bf16(b1, qf[0], negm, 0, 0, 0); }
          else { pA0 = __builtin_amdgcn_mfma_f32_32x32x16_bf16(b0, qf[d0], pA0, 0, 0, 0); pA1 = __builtin_amdgcn_mfma_f32_32x32x16_bf16(b1, qf[d0], pA1, 0, 0, 0); } }
      asm volatile("s_nop 15\n\ts_nop 7" : "+v"(pA0), "+v"(pA1));
      MASK(pA0, pA1, 0);
      float ma = max3f(pA0[0], pA0[1], pA1[0]), mb = max3f(pA0[2], pA0[3], pA1[1]); ma = max3f(ma, pA1[2], pA1[3]);
#pragma unroll
      for (int r = 4; r < 16; r += 4) { ma = max3f(ma, pA0[r], pA0[r + 1]); mb = max3f(mb, pA0[r + 2], pA0[r + 3]); ma = max3f(ma, pA1[r], pA1[r + 1]); mb = max3f(mb, pA1[r + 2], pA1[r + 3]); }
      DECIDE(pA0, pA1, xhalf_max(max2f(ma, mb)), true); }
    if (ATT_STAGGER && ATT_DEFER) {
        __syncthreads();
        if (grpB) { ATP_WRITEK(0, kreg); ATP_WRITEV(1, vreg); }
    }
#if ATT_DEFER
    u32x4 pp0 = (u32x4){0u, 0u, 0u, 0u}, pp1 = pp0, pp2 = pp0, pp3 = pp0;
    auto STEP = [&](f32x16& C0, f32x16& C1, f32x16& N0, f32x16& N1, const int t, u32x4 (&kW)[KPT], u32x4& vW, u32x4 (&kL)[DEEP ? KPT : 1], u32x4& vL) __attribute__((always_inline)) {
        constexpr int NF = NG + 8, NM = NF + (USE_LACC ? 4 : 0);
        const bool hn = (t + 1 < NT);
        if (DEEP) { ATP_LOADK(min(t + 3, NT - 1), kL); ATP_LOADV(min(t + 2, NT - 1), vL); }
        else { if (t + 2 + lead < NT) ATP_LOADK(t + 2 + lead, kW); if (t + 1 + lead < NT) ATP_LOADV(t + 1 + lead, vW); }
        const int vbp = (t == 0) ? 0 : (t - 1) & 3;
        LAS const char* kb = lds + L_K + ((t + 1) & 1) * KBUF + hi * 1024 + r32 * 16;
        LAS const char* vp = lds + L_V + vbp * VBUF + ((lane >> 4) & 1) * 32 + (lane & 3) * 8 + (4 * hi + ((lane & 15) >> 2)) * 64;
        unsigned pw[16]; float rs0 = 0.f, rs1 = 0.f, ma = 0.f, mb = 0.f;
        bf16x8 fr[NF];
#define ATP_LOADF(i) do { if ((i) < NG) fr[(i)] = *(LAS const bf16x8*)(kb + (2 * ((i) >> 1)) * 1024 + ((i) & 1) * 512); \
            else { const int j_ = (i) - NG; const s16x4 lo_ = vtr(vp + (j_ & 1) * 4096 + (j_ >> 1) * 1024), hi_ = vtr(vp + (j_ & 1) * 4096 + (j_ >> 1) * 1024 + 512); \
                   fr[(i)] = (bf16x8){lo_[0], lo_[1], lo_[2], lo_[3], hi_[0], hi_[1], hi_[2], hi_[3]}; } } while (0)
        constexpr int PF = (NSTEP == 2) ? 3 : 2;
        constexpr int PER = USE_LACC ? 3 : 2;
        ATP_LOADF(0); if (PF > 1) ATP_LOADF(1); if (PF > 2) ATP_LOADF(2);
#pragma unroll
        for (int idx = 0; idx < NM; ++idx) {
            const int m = idx - NG, kk = (m >= 0) ? m / PER : 0, sub = (m >= 0) ? m % PER : 0;
            const int f = (idx < NG) ? idx : ((sub < 2) ? NG + 2 * kk + sub : -1);
            if (f >= 0 && f + PF < NF) ATP_LOADF(f + PF);
            if (idx < NG) {
                if (idx == 0) N0 = __builtin_amdgcn_mfma_f32_32x32x16_bf16(fr[idx], qf[0], negm, 0, 0, 0);
                else if (idx == 1) N1 = __builtin_amdgcn_mfma_f32_32x32x16_bf16(fr[idx], qf[0], negm, 0, 0, 0);
                else if ((idx & 1) == 0) N0 = __builtin_amdgcn_mfma_f32_32x32x16_bf16(fr[idx], qf[idx >> 1], N0, 0, 0, 0);
                else N1 = __builtin_amdgcn_mfma_f32_32x32x16_bf16(fr[idx], qf[idx >> 1], N1, 0, 0, 0);
            } else {
                const u32x4 pq = (kk == 0) ? pp0 : (kk == 1) ? pp1 : (kk == 2) ? pp2 : pp3;
                if (sub == 0) o0 = __builtin_amdgcn_mfma_f32_32x32x16_bf16(__builtin_bit_cast(bf16x8, pq), fr[f >= 0 ? f : 0], o0, 0, 0, 0);
                else if (sub == 1) o1 = __builtin_amdgcn_mfma_f32_32x32x16_bf16(__builtin_bit_cast(bf16x8, pq), fr[f >= 0 ? f : 0], o1, 0, 0, 0);
                else lacc = __builtin_amdgcn_mfma_f32_32x32x16_bf16(__builtin_bit_cast(bf16x8, pq), ones, lacc, 0, 0, 0);
                if (m == 2) { asm volatile("" : "+v"(N0), "+v"(N1)); MASK(N0, N1, t + 1);
                              ma = max3f(N0[0], N0[1], N1[0]); mb = max3f(N0[2], N0[3], N1[1]); ma = max3f(ma, N1[2], N1[3]); }
                else if (m >= 3 && m < 6) { const int r = 4 * (m - 2); ma = max3f(ma, N0[r], N0[r + 1]); mb = max3f(mb, N0[r + 2], N0[r + 3]); ma = max3f(ma, N1[r], N1[r + 1]); mb = max3f(mb, N1[r + 2], N1[r + 3]); }
            }
#pragma unroll
            for (int it = idx * 48 / NM; it < (idx + 1) * 48 / NM; ++it) {
                if (it < 16) { ATP_EXP(C0[it]); if (!USE_LACC && it > 0) { if (it & 1) ATP_ADD(rs0, C0[it - 1]); else ATP_ADD(rs1, C0[it - 1]); } }
                else if (it < 32) { ATP_EXP(C1[it - 16]); if (!USE_LACC) { if (it == 16) ATP_ADD(rs1, C0[15]); else if (it & 1) ATP_ADD(rs0, C1[it - 17]); else ATP_ADD(rs1, C1[it - 17]); } }
                else { const int k = it - 32; if (!USE_LACC && k == 0) ATP_ADD(rs1, C1[15]);
                       pw[k] = (k < 8) ? ATP_PK(C0[2 * k], C0[2 * k + 1]) : ATP_PK(C1[2 * (k - 8)], C1[2 * (k - 8) + 1]); }
            }
            __builtin_amdgcn_sched_barrier(0);
            if (ATT_STAGGER && idx == ((NG - 1 > NM / 2 - 1) ? NG - 1 : NM / 2 - 1)) { if (grpB) asm volatile("s_barrier" ::: "memory"); __builtin_amdgcn_sched_barrier(0); }
        }
#undef ATP_LOADF
        if (!USE_LACC) lrow += xhalf_sum(rs0 + rs1);
        if (hn) {
            const float mx = xhalf_max(max2f(ma, mb));
            if (__builtin_expect(__any(mx > THR), 0)) {
                const float al = __builtin_amdgcn_exp2f(-fmaxf(mx, 0.f));
#pragma unroll
                for (int k = 0; k < 16; ++k) { const float lo_ = __uint_as_float(pw[k] << 16) * al, hi_ = __uint_as_float(pw[k] & 0xffff0000u) * al; pw[k] = ATP_PK(lo_, hi_); }
            }
            DECIDE(N0, N1, mx, false);
        }
        pp0 = (u32x4){pw[0], pw[1], pw[2], pw[3]}; pp1 = (u32x4){pw[4], pw[5], pw[6], pw[7]}; pp2 = (u32x4){pw[8], pw[9], pw[10], pw[11]}; pp3 = (u32x4){pw[12], pw[13], pw[14], pw[15]};
        if (t + 2 + lead < NT) ATP_WRITEK((t + lead) & 1, kW);
        if (t + 1 + lead < NT) ATP_WRITEV((t + 1 + lead) & 3, vW);
        if (!grpB) ATT_BAR();
    };
#else
    auto STEP = [&](f32x16& C0, f32x16& C1, f32x16& N0, f32x16& N1, const int t) __attribute__((always_inline)) {
        const bool hn = (t + 1 < NT);
        if (t + 2 < NT) ATP_LOADK(t + 2, kreg);
        if (hn) ATP_LOADV(t + 1, vreg);
        LAS const char* kb = lds + L_K + ((t + 1) & 1) * KBUF + hi * 1024 + r32 * 16;
        LAS const char* vp = lds + L_V + (t & 1) * VBUF + ((lane >> 4) & 1) * 32 + (lane & 3) * 8 + (4 * hi + ((lane & 15) >> 2)) * 64;
        unsigned pw[16]; float rs0 = 0.f, rs1 = 0.f;
        bf16x8 kcur = *(LAS const bf16x8*)(kb);
#pragma unroll
        for (int g = 0; g < NG; ++g) {
            bf16x8 knext = kcur;
            if (g + 1 < NG) knext = *(LAS const bf16x8*)(kb + (2 * ((g + 1) >> 1)) * 1024 + ((g + 1) & 1) * 512);
            if (g == 0) N0 = __builtin_amdgcn_mfma_f32_32x32x16_bf16(kcur, qf[0], negm, 0, 0, 0);
            else if (g == 1) N1 = __builtin_amdgcn_mfma_f32_32x32x16_bf16(kcur, qf[0], negm, 0, 0, 0);
            else if ((g & 1) == 0) N0 = __builtin_amdgcn_mfma_f32_32x32x16_bf16(kcur, qf[g >> 1], N0, 0, 0, 0);
            else N1 = __builtin_amdgcn_mfma_f32_32x32x16_bf16(kcur, qf[g >> 1], N1, 0, 0, 0);
#pragma unroll
            for (int it = g * IPG; it < (g + 1) * IPG; ++it) {
                if (it < 16) { C0[it] = __builtin_amdgcn_exp2f(C0[it]); rs0 += C0[it]; }
                else if (it < 32) { C1[it - 16] = __builtin_amdgcn_exp2f(C1[it - 16]); rs1 += C1[it - 16]; }
                else { const int k = it - 32; pw[k] = (k < 8) ? ATP_PK(C0[2 * k], C0[2 * k + 1]) : ATP_PK(C1[2 * (k - 8)], C1[2 * (k - 8) + 1]); }
            }
            kcur = knext;
            __builtin_amdgcn_sched_barrier(0);
        }
        lrow += xhalf_sum(rs0 + rs1);
        const bf16x8 pa0 = __builtin_bit_cast(bf16x8, (u32x4){pw[0], pw[1], pw[2], pw[3]}), pa1 = __builtin_bit_cast(bf16x8, (u32x4){pw[4], pw[5], pw[6], pw[7]}),
                     pa2 = __builtin_bit_cast(bf16x8, (u32x4){pw[8], pw[9], pw[10], pw[11]}), pa3 = __builtin_bit_cast(bf16x8, (u32x4){pw[12], pw[13], pw[14], pw[15]});
        asm volatile("s_nop 15\n\ts_nop 7" : "+v"(N0), "+v"(N1)); MASK(N0, N1, t + 1);
        float ma = 0.f, mb = 0.f;
        s16x4 vlo = vtr(vp), vhi = vtr(vp + 512);
#pragma unroll
        for (int j = 0; j < 8; ++j) {
            s16x4 nlo = vlo, nhi = vhi;
            if (j + 1 < 8) { nlo = vtr(vp + ((j + 1) >> 2) * 4096 + ((j + 1) & 3) * 1024); nhi = vtr(vp + ((j + 1) >> 2) * 4096 + ((j + 1) & 3) * 1024 + 512); }
            const bf16x8 vb = (bf16x8){vlo[0], vlo[1], vlo[2], vlo[3], vhi[0], vhi[1], vhi[2], vhi[3]};
            const bf16x8 pa = ((j & 3) == 0) ? pa0 : ((j & 3) == 1) ? pa1 : ((j & 3) == 2) ? pa2 : pa3;
            if (j < 4) o0 = __builtin_amdgcn_mfma_f32_32x32x16_bf16(pa, vb, o0, 0, 0, 0); else o1 = __builtin_amdgcn_mfma_f32_32x32x16_bf16(pa, vb, o1, 0, 0, 0);
            if (j == 0) { ma = max3f(N0[0], N0[1], N1[0]); mb = max3f(N0[2], N0[3], N1[1]); ma = max3f(ma, N1[2], N1[3]); }
            else if (j < 4) { const int r = 4 * j; ma = max3f(ma, N0[r], N0[r + 1]); mb = max3f(mb, N0[r + 2], N0[r + 3]); ma = max3f(ma, N1[r], N1[r + 1]); mb = max3f(mb, N1[r + 2], N1[r + 3]); }
            vlo = nlo; vhi = nhi;
            __builtin_amdgcn_sched_barrier(0);
        }
        if (hn) DECIDE(N0, N1, xhalf_max(max2f(ma, mb)), false);
        if (t + 2 < NT) ATP_WRITEK(t & 1, kreg);
        if (hn) ATP_WRITEV((t + 1) & 1, vreg);
        ATT_BAR();
    };
#endif
#pragma unroll 1
#if ATT_DEFER
    for (int t = 0; t < NT; t += 2) {
        if constexpr (DEEP) { STEP(pA0, pA1, pB0, pB1, t, kreg, vreg, kreg2, vreg2); STEP(pB0, pB1, pA0, pA1, t + 1, kreg2, vreg2, kreg, vreg); }
        else { STEP(pA0, pA1, pB0, pB1, t, kreg, vreg, kreg2, vreg2); STEP(pB0, pB1, pA0, pA1, t + 1, kreg, vreg, kreg2, vreg2); } }
#else
    for (int t = 0; t < NT; t += 2) { STEP(pA0, pA1, pB0, pB1, t); STEP(pB0, pB1, pA0, pA1, t + 1); }
#endif
#if ATT_DEFER
    {
        LAS const char* vp = lds + L_V + ((NT - 1) & 3) * VBUF + ((lane >> 4) & 1) * 32 + (lane & 3) * 8 + (4 * hi + ((lane & 15) >> 2)) * 64;
        s16x4 vlo[8], vhi[8];
#pragma unroll
        for (int i = 0; i < 8; ++i) { vlo[i] = vtr(vp + (i >> 2) * 4096 + (i & 3) * 1024); vhi[i] = vtr(vp + (i >> 2) * 4096 + (i & 3) * 1024 + 512); }
#pragma unroll
        for (int j = 0; j < 8; ++j) {
            const bf16x8 vb = (bf16x8){vlo[j][0], vlo[j][1], vlo[j][2], vlo[j][3], vhi[j][0], vhi[j][1], vhi[j][2], vhi[j][3]};
            const u32x4 pq = ((j & 3) == 0) ? pp0 : ((j & 3) == 1) ? pp1 : ((j & 3) == 2) ? pp2 : pp3;
            if (j < 4) o0 = __builtin_amdgcn_mfma_f32_32x32x16_bf16(__builtin_bit_cast(bf16x8, pq), vb, o0, 0, 0, 0);
            else o1 = __builtin_amdgcn_mfma_f32_32x32x16_bf16(__builtin_bit_cast(bf16x8, pq), vb, o1, 0, 0, 0);
        }
        if (USE_LACC) { lacc = __builtin_amdgcn_mfma_f32_32x32x16_bf16(__builtin_bit_cast(bf16x8, pp0), ones, lacc, 0, 0, 0); lacc = __builtin_amdgcn_mfma_f32_32x32x16_bf16(__builtin_bit_cast(bf16x8, pp1), ones, lacc, 0, 0, 0);
                        lacc = __builtin_amdgcn_mfma_f32_32x32x16_bf16(__builtin_bit_cast(bf16x8, pp2), ones, lacc, 0, 0, 0); lacc = __builtin_amdgcn_mfma_f32_32x32x16_bf16(__builtin_bit_cast(bf16x8, pp3), ones, lacc, 0, 0, 0); }
    }
#endif
#undef ATP_TILE
#undef ATP_LOADK
#undef ATP_LOADV
#undef ATP_WRITEK
#undef ATP_WRITEV
#undef ATP_PK
#undef ATP_EXP
#undef ATP_ADD
    const int tid_e = opaque_tid(U.wv), lane_e = tid_e & 63, r32_e = lane_e & 31, hi_e = lane_e >> 5;
    LAS float* wsf_e = (LAS float*)(lds + L_WS) + wid * 64;
    float fac = USE_LACC ? ((MODE == 1) ? __builtin_amdgcn_exp2f((whd ? U.sink2b : U.sink2) - mrow) : 0.f) : ((MODE == 1) ? 1.f / (lrow + __builtin_amdgcn_exp2f((whd ? U.sink2b : U.sink2) - mrow)) : 1.f / lrow);
    if (!USE_LACC && MODE == 2 && U.pass == 2) fac *= -U.lam;
    if (!USE_LACC || MODE == 1) { if (hi_e == 0) wsf_e[r32_e] = fac; }
    LAS float* stg = (LAS float*)(lds + L_OST + wid * OST_W);
#pragma unroll
    for (int g4 = 0; g4 < 4; ++g4) {
        pg8::f32x4 f0 = (pg8::f32x4){0.f, 0.f, 0.f, 0.f};
        if (!USE_LACC || MODE == 1) f0 = *(LAS const pg8::f32x4*)(wsf_e + 8 * g4 + 4 * hi_e);
        float ff0[4] = {f0.x, f0.y, f0.z, f0.w};
        if (USE_LACC) {
#pragma unroll
            for (int j = 0; j < 4; ++j) { ff0[j] = 1.f / (lacc[4 * g4 + j] + ff0[j]); if (MODE == 2 && U.pass == 2) ff0[j] *= -U.lam; } }
#pragma unroll
        for (int j = 0; j < 4; ++j) { const int r = 4 * g4 + j, orow = crow(r, hi_e);
            float v0 = o0[r] * ff0[j], v1 = o1[r] * ff0[j];
            if (MODE == 2 && U.pass == 2) { v0 += stg[orow * 68 + r32_e]; v1 += stg[orow * 68 + 32 + r32_e]; }
            stg[orow * 68 + r32_e] = v0; stg[orow * 68 + 32 + r32_e] = v1; }
    }
    if (MODE == 2 && U.pass == 1) { __syncthreads(); return; }
    { const int row = lane_e >> 1, half = lane_e & 1; float v[32];
#pragma unroll
      for (int k = 0; k < 8; ++k) { const pg8::f32x4 x = *(LAS const pg8::f32x4*)(stg + row * 68 + half * 32 + 4 * k); v[4 * k] = x.x; v[4 * k + 1] = x.y; v[4 * k + 2] = x.z; v[4 * k + 3] = x.w; }
      if (MODE == 2) { float ss = 0.f;
#pragma unroll
          for (int k = 0; k < 32; ++k) ss += v[k] * v[k];
          ss += xshfl<1>(ss);
          const float rstd = rsqrtf(ss * (1.f / 64) + EPS) * U.postmul;
#pragma unroll
          for (int k = 0; k < 32; ++k) v[k] = v[k] * rstd * U.subln[half * 32 + k]; }
      bf16_t* op = U.O + whd * 64 + (size_t)(U.qrow0 + wsub * 32 + row) * 1024 + half * 32;
#pragma unroll
      for (int k = 0; k < 4; ++k) { u32x4 w; w.x = pg8::cvt_pk_bf16(v[8 * k], v[8 * k + 1]); w.y = pg8::cvt_pk_bf16(v[8 * k + 2], v[8 * k + 3]); w.z = pg8::cvt_pk_bf16(v[8 * k + 4], v[8 * k + 5]); w.w = pg8::cvt_pk_bf16(v[8 * k + 6], v[8 * k + 7]);
          *(u32x4*)(op + 8 * k) = w; } }
    __syncthreads();
}
#undef ATT_BAR
}

__device__ __forceinline__ void phase_attn(const Ctx& C, int layer, LAS char* lds, volatile LAS unsigned* MISC) {
    const int wv = C.wv; (void)wv;
    const int G = gridDim.x, bx = blockIdx.x;
    const int vcu = (G % 8 == 0) ? (bx % 8) * (G / 8) + bx / 8 : bx;
    float lam;
    {
        const float* dl = C.dlam + (size_t)layer * 128; const int l32 = lane_id() & 31;
        const float a = dl[l32], b = dl[32 + l32], c = dl[64 + l32], d = dl[96 + l32];
        float s1 = a * b, s2 = c * d;
        s1 += xshfl<16>(s1); s2 += xshfl<16>(s2); s1 += xshfl<8>(s1); s2 += xshfl<8>(s2); s1 += xshfl<4>(s1); s2 += xshfl<4>(s2);
        s1 += xshfl<2>(s1); s2 += xshfl<2>(s2); s1 += xshfl<1>(s1); s2 += xshfl<1>(s2);
        lam = expf(s1) - expf(s2) + lam_init_of(layer); }
    const bool has_ctx_q = layer < DEPTH - 1;
    const int NLAT = BATCH * 4 * (SEQ / 256);
    const int NCTXU = has_ctx_q ? BATCH * 4 : 0;
    const int ntot = 3 * NLAT + 3 * NCTXU;
#pragma unroll 1
    for (int uidx = vcu; uidx < ntot; uidx += G) {
        int kind, b, h, qb; bool cq;
        if (uidx < 3 * NLAT) { kind = uidx / NLAT; const int r = uidx % NLAT; b = r / 32; h = (r / 8) & 3; qb = r & 7; cq = false; }
        else { const int r2 = uidx - 3 * NLAT; kind = r2 / NCTXU; const int r = r2 % NCTXU; b = r >> 2; h = r & 3; qb = 0; cq = true; }
        STAMP_BEGIN();
        att::Unit U;
        U.qrow0 = cq ? TL + b * CTXL : b * SEQ + qb * 256; U.qpos0 = cq ? 0 : qb * 256; U.ctxrow0 = TL + b * CTXL;
        U.latrow0 = b * SEQ; U.latpos0 = 0; U.nlat = cq ? 0 : SEQ / 64; U.window = -1; U.sink2 = 0.f; U.two = 0; U.sink2b = 0.f; U.lam = 0.f; U.postmul = 1.f; U.subln = nullptr; U.pass = 0; U.wv = C.wv; U.misc = MISC;
        if (kind == 0) {
            U.V = C.VC; U.vhs = h; U.vnhs = 4; U.qpitch = 256; U.K = C.KC; U.knhs = 8; U.O = C.O + 512 + h * 64;
            U.lam = lam; U.postmul = 1.f - lam_init_of(layer); U.subln = C.subln + layer * 64;
            U.Q = C.QC + h * 64; U.khs = 2 * h; U.pass = 1;
            if (ATT_PIPE) att::attn_unit_p<2, 2>(U, lds); else att::attn_unit<2, 2>(U, lds);
            U.Q = C.QC + h * 64 + 32; U.khs = 2 * h + 1; U.pass = 2;
            if (ATT_PIPE) att::attn_unit_p<2, 2>(U, lds); else att::attn_unit<2, 2>(U, lds); STAMP_END(12);
        } else if (kind == 1) {
            U.Q = C.QA + h * 96; U.K = C.KA; U.khs = h; U.knhs = 4; U.V = C.VA; U.vhs = h; U.vnhs = 4; U.qpitch = 384; U.O = C.O + h * 64;
            if (ATT_PIPE) att::attn_unit_p<6, 0>(U, lds); else att::attn_unit<6, 0>(U, lds); STAMP_END(13);
        } else {
            int kvh = h >> 1, h0 = h;
            if (!cq && ATT_PIPE && SWA_TWOHEAD) {
                const int r = uidx % NLAT, q128 = r & 15; kvh = (r >> 4) & 1; h0 = 2 * kvh;
                U.two = 1; U.sink2b = C.sink[layer * 4 + h0 + 1] * LOG2E;
                U.qrow0 = b * SEQ + q128 * 128; U.qpos0 = q128 * 128; U.window = 128;
                const int p0 = max(q128 * 128 - 128, 0), p1 = min(q128 * 128 + 128 + 128, SEQ); U.latpos0 = p0; U.latrow0 = b * SEQ + p0; U.nlat = (p1 - p0) / 64;
            } else if (!cq) { U.window = 128; const int p0 = max(qb * 256 - 128, 0), p1 = min(qb * 256 + 256 + 128, SEQ); U.latpos0 = p0; U.latrow0 = b * SEQ + p0; U.nlat = (p1 - p0) / 64; }
            U.Q = C.QB + h0 * 64; U.K = C.KB; U.khs = kvh; U.knhs = 2; U.V = C.VB; U.vhs = kvh; U.vnhs = 2; U.qpitch = 256; U.O = C.O + 256 + h0 * 64;
            U.sink2 = C.sink[layer * 4 + h0] * LOG2E;
            if (ATT_PIPE) att::attn_unit_p<4, 1>(U, lds); else att::attn_unit<4, 1>(U, lds); STAMP_END(14);
        }
    }
    {
        STAMP_BEGIN();
        const int tid = opaque_tid(C.wv);
        const int nrows = has_ctx_q ? T : TL;
        for (int idx = blockIdx.x * NTHREADS + tid; idx < nrows * 32; idx += gridDim.x * NTHREADS) {
            const int r = idx >> 5, ch = idx & 31, g = ch >> 3;
            const bool isctx = r >= TL; const int t = isctx ? (r - TL) % CTXL : r % SEQ;
            const int w = 2 << g, half = w >> 1, L = isctx ? CTXL : SEQ;
            const int lo = max(t - half, 0), hi = min(t - half + w, L);
            const bf16_t* base = C.U + (size_t)(r - t) * 256 + ch * 8;
            float acc[8];
#pragma unroll
            for (int j = 0; j < 8; ++j) acc[j] = 0.f;
            const uint4 sv = *(const uint4*)(base + (size_t)t * 256); const unsigned swv[4] = {sv.x, sv.y, sv.z, sv.w};
            {   const int k0 = 0;
                uint4 v[16];
#pragma unroll
                for (int k = 0; k < 16; ++k) { const int p = min(lo + k0 + k, hi - 1); v[k] = *(const uint4*)(base + (size_t)p * 256); }
#pragma unroll
                for (int k = 0; k < 16; ++k) { const float m = (lo + k0 + k < hi) ? 1.f : 0.f; const unsigned wv[4] = {v[k].x, v[k].y, v[k].z, v[k].w};
#pragma unroll
                    for (int j = 0; j < 4; ++j) { acc[2 * j] += m * __uint_as_float(wv[j] << 16); acc[2 * j + 1] += m * __uint_as_float(wv[j] & 0xffff0000u); } }
            }
            const float inv = 1.f / (float)(hi - lo);
            uint4 o; unsigned ow[4];
#pragma unroll
            for (int j = 0; j < 4; ++j) ow[j] = pg8::cvt_pk_bf16(acc[2 * j] * inv - __uint_as_float(swv[j] << 16), acc[2 * j + 1] * inv - __uint_as_float(swv[j] & 0xffff0000u));
            o.x = ow[0]; o.y = ow[1]; o.z = ow[2]; o.w = ow[3];
            *(uint4*)(C.O + (size_t)r * D + 768 + ch * 8) = o;
        }
        STAMP_END(11);
    }
}

struct SchedRows {
    int G, c, nM, nN; const char* A; const char* W; unsigned lda2  ; size_t wtile  ;
    __device__ __forceinline__ bool next(int i, pg8::GUnit& u) const { int pm, pn; if (!pg8::static_tile(i, G, c, nM, nN, pm, pn)) return false;
        u.pm = pm; u.pn = pn; u.A = A; u.B = W + (size_t)pn * wtile; u.B2 = u.B; u.x0 = 0; u.x1 = 256; return true; }
    __device__ __forceinline__ unsigned arow(const pg8::GUnit& u, int row) const { return (unsigned)(u.pm * 256 + row) * lda2; }
};
struct EpiRowsSS {
    static constexpr bool PERM = true;
    bf16_t* OUT; float* SS;
    __device__ __forceinline__ void operator()(const pg8::f32x4 (&acc)[2][2][4][2], const pg8::GUnit& u, int wr, int wc, int fr, int fq) const {
        const int row0 = u.pm * 256 + wr * 64 + fr;
#pragma unroll
        for (int ai = 0; ai < 2; ++ai)
#pragma unroll
            for (int m = 0; m < 4; ++m) {
                const int row = row0 + ai * 128 + m * 16; float p = 0.f;
#pragma unroll
                for (int bj = 0; bj < 2; ++bj) {
                    const pg8::f32x4 v0 = acc[ai][bj][m][0], v1 = acc[ai][bj][m][1];
                    p += ((v0[0] * v0[0] + v0[1] * v0[1]) + (v0[2] * v0[2] + v0[3] * v0[3])) + ((v1[0] * v1[0] + v1[1] * v1[1]) + (v1[2] * v1[2] + v1[3] * v1[3]));
                    pg8::u32x4 w; w.x = pg8::cvt_pk_bf16(v0[0], v0[1]); w.y = pg8::cvt_pk_bf16(v0[2], v0[3]); w.z = pg8::cvt_pk_bf16(v1[0], v1[1]); w.w = pg8::cvt_pk_bf16(v1[2], v1[3]);
                    *(pg8::u32x4*)(OUT + (size_t)row * 1024 + u.pn * 256 + bj * 128 + wc * 32 + 8 * fq) = w;
                }
                p += xshfl<16>(p); p += xshfl<32>(p);
                if (fq == 0) SS[(size_t)row * 16 + u.pn * 4 + wc] = p;
            }
    }
};

__device__ __forceinline__ float sum16(const float* p) { const float4 a = *(const float4*)p, b = *(const float4*)(p + 4), c = *(const float4*)(p + 8), d = *(const float4*)(p + 12);
    return (((a.x + a.y) + (a.z + a.w)) + ((b.x + b.y) + (b.z + b.w))) + (((c.x + c.y) + (c.z + c.w)) + ((d.x + d.y) + (d.z + d.w))); }
struct ThinIn { float4 x[4]; uint2 o[4]; float4 ss[4]; };
__device__ __forceinline__ float ss16(const ThinIn& R) { return (((R.ss[0].x + R.ss[0].y) + (R.ss[0].z + R.ss[0].w)) + ((R.ss[1].x + R.ss[1].y) + (R.ss[1].z + R.ss[1].w))) + (((R.ss[2].x + R.ss[2].y) + (R.ss[2].z + R.ss[2].w)) + ((R.ss[3].x + R.ss[3].y) + (R.ss[3].z + R.ss[3].w))); }
__device__ __forceinline__ int modrow_of(int r) { return (r >= TL) ? 16 : r / SEQ; }
template <bool XBF> __device__ __forceinline__ void router_load(ThinIn& R, const Ctx& C, int layer, int r, int lane) {
    const uint2* oxr = (const uint2*)(C.OX + (size_t)r * D);
    if (!XBF) { const float4* xr = (const float4*)xrow_in(C, 0, r);
#pragma unroll
        for (int j = 0; j < 4; ++j) R.x[j] = xr[lane + 64 * j];
    } else {
        const uint2* xr = (const uint2*)((const bf16_t*)C.out + (size_t)r * D);
#pragma unroll
        for (int j = 0; j < 4; ++j) { const uint2 xw = xr[lane + 64 * j];
            R.x[j] = make_float4(__uint_as_float(xw.x << 16), __uint_as_float(xw.x & 0xffff0000u), __uint_as_float(xw.y << 16), __uint_as_float(xw.y & 0xffff0000u)); }
    }
#pragma unroll
    for (int j = 0; j < 4; ++j) { R.o[j] = oxr[lane + 64 * j]; R.ss[j] = *(const float4*)(C.SS1 + (size_t)r * 16 + 4 * j); }
}
__device__ __forceinline__ void router_row_a(const ThinIn& R, const Ctx& C, int layer, int r, int lane, const float* G1, const float* G2, const float* MODS, float4 (&xa)[4]) {
    const float rstd1 = rsqrtf(ss16(R) * (1.f / D) + EPS);
    uint2* xo = (uint2*)(C.HX + (size_t)r * D);
    float ss = 0.f;
#pragma unroll
    for (int j = 0; j < 4; ++j) { const int ci = lane + 64 * j; const uint2 ow = R.o[j]; const float4 g = *(const float4*)(G1 + 4 * ci), gt = *(const float4*)(MODS + 4 * ci), xv = R.x[j];
        xa[j].x = xv.x + gt.x * (__uint_as_float(ow.x << 16) * rstd1 * g.x); xa[j].y = xv.y + gt.y * (__uint_as_float(ow.x & 0xffff0000u) * rstd1 * g.y);
        xa[j].z = xv.z + gt.z * (__uint_as_float(ow.y << 16) * rstd1 * g.z); xa[j].w = xv.w + gt.w * (__uint_as_float(ow.y & 0xffff0000u) * rstd1 * g.w);
        { uint2 w1; w1.x = pg8::cvt_pk_bf16(xa[j].x, xa[j].y); w1.y = pg8::cvt_pk_bf16(xa[j].z, xa[j].w); xo[ci] = w1; }
        ss += (xa[j].x * xa[j].x + xa[j].y * xa[j].y) + (xa[j].z * xa[j].z + xa[j].w * xa[j].w); }
    const float rstd2 = rsqrtf(wave_sum(ss) * (1.f / D) + EPS);
    uint2* hmr = (uint2*)(C.HM + (size_t)r * D);
#pragma unroll
    for (int j = 0; j < 4; ++j) { const int ci = lane + 64 * j; const float4 g = *(const float4*)(G2 + 4 * ci), sh = *(const float4*)(MODS + 1024 + 4 * ci), sc = *(const float4*)(MODS + 2048 + 4 * ci);
        xa[j].x = (xa[j].x * rstd2 * g.x) * (1.f + sc.x) + sh.x; xa[j].y = (xa[j].y * rstd2 * g.y) * (1.f + sc.y) + sh.y;
        xa[j].z = (xa[j].z * rstd2 * g.z) * (1.f + sc.z) + sh.z; xa[j].w = (xa[j].w * rstd2 * g.w) * (1.f + sc.w) + sh.w;
        uint2 w; w.x = pg8::cvt_pk_bf16(xa[j].x, xa[j].y); w.y = pg8::cvt_pk_bf16(xa[j].z, xa[j].w); hmr[ci] = w; }
}
__device__ __forceinline__ float reduce20(float (&lp)[32], int lane) {
#define RSTEP(W) { const bool up = (lane & W) != 0; _Pragma("unroll") for (int i = 0; i < W; ++i) { const float send = up ? lp[i] : lp[i + W]; const float keep = up ? lp[i + W] : lp[i]; lp[i] = keep + xshfl<W>(send); } }
    RSTEP(16) RSTEP(8) RSTEP(4) RSTEP(2) RSTEP(1)
#undef RSTEP
    return lp[0] + xshfl<32>(lp[0]);
}
__device__ __forceinline__ void router_select(float tot, const Ctx& C, int layer, int r, int lane, int* lcnt, const float* BL  ) {
    const float totb = tot + BL[lane & 31];
    float lg[20];
#pragma unroll
    for (int q = 0; q < 20; ++q) lg[q] = __builtin_bit_cast(float, __builtin_amdgcn_readlane(__builtin_bit_cast(int, totb), q));
    int gsel = 0; float gmax = lg[0];
#pragma unroll
    for (int i = 1; i < 4; ++i) if (lg[i] > gmax) { gmax = lg[i]; gsel = i; }
    float gs = 0.f;
#pragma unroll
    for (int i = 0; i < 4; ++i) gs += __expf(lg[i] - gmax);
    const float pg = 1.f / gs;
    float el[4];
#pragma unroll
    for (int i = 0; i < 4; ++i) el[i] = (gsel == 0) ? lg[4 + i] : (gsel == 1) ? lg[8 + i] : (gsel == 2) ? lg[12 + i] : lg[16 + i];
    int i1 = 0; float v1 = el[0];
#pragma unroll
    for (int i = 1; i < 4; ++i) if (el[i] > v1) { v1 = el[i]; i1 = i; }
    int i2 = -1; float v2 = -INFINITY;
#pragma unroll
    for (int i = 0; i < 4; ++i) if (i != i1 && el[i] > v2) { v2 = el[i]; i2 = i; }
    const float e2 = __expf(v2 - v1); const float w1 = pg / (1.f + e2), w2 = pg * e2 / (1.f + e2);
    const int elo = min(i1, i2), ehi = max(i1, i2);
    const int pair = (elo == 0) ? (ehi - 1) : (elo == 1) ? (ehi + 1) : 5;
    const int cls = gsel * 6 + pair;
    if (lane == 0) {
        const int slot = atomicAdd(lcnt + cls, 1);
        if (slot < LIST_CAP) C.LIST[((size_t)blockIdx.x * 24 + cls) * LIST_CAP + slot] = r;
        *(float2*)(C.TOKW + (size_t)r * 2) = make_float2(i1 < i2 ? w1 : w2, i1 < i2 ? w2 : w1);
    }
}
template <bool XBF> __device__ __forceinline__ void phase_router(const Ctx& C, int layer, float* lds) {
    const int tid = opaque_tid(C.wv), lane = tid & 63, wave = tid >> 6;
    float* RW = lds;
    int* lcnt = (int*)(lds + 20 * 1024);
    float* G1 = lds + 20 * 1024 + 32; float* G2 = G1 + 1024; float* MODS = G2 + 1024;
    float* BL = MODS + 2 * 3072;
    const int nrows = (layer == DEPTH - 1) ? TL : T;
    const int rpw = (nrows + gridDim.x * NWAVES - 1) / (gridDim.x * NWAVES);
    int bidx_ = blockIdx.x; asm volatile("" : "+s"(bidx_));
    const int wg_r0 = bidx_ * NWAVES * rpw, wg_r1 = min(wg_r0 + NWAVES * rpw, nrows);
    const int mrA = modrow_of(min(wg_r0, nrows - 1)), mrB = modrow_of(max(wg_r1 - 1, 0));
    if (tid < 24) lcnt[tid] = 0;
    if (tid >= 64 && tid < 96) { const int q = tid - 64; const float* gb = C.r_gb + layer * 4; const float* eb = C.r_eb + layer * 16; BL[q] = (q < 4) ? gb[q] : (q < 20) ? eb[q - 4] : 0.f; }
    {
        const float4* gw4 = (const float4*)(C.r_gw + (size_t)layer * D * 4); const float4* ew4 = (const float4*)(C.r_ew + (size_t)layer * D * 16);
        float4 g[2], e[8], m[3];
#pragma unroll
        for (int j = 0; j < 2; ++j) g[j] = gw4[tid + NTHREADS * j];
#pragma unroll
        for (int j = 0; j < 8; ++j) e[j] = ew4[tid + NTHREADS * j];
        const float4 gg = ((const float4*)(C.norm_g + ((size_t)layer * 4 + ((tid < 256) ? 1 : 2)) * D))[tid & 255];
#pragma unroll
        for (int j = 0; j < 3; ++j) { const int i4 = tid + NTHREADS * j, which = (i4 >= 768) ? 1 : 0, rem4 = i4 - 768 * which;
            m[j] = ((const float4*)(C.mod + ((size_t)layer * 17 + (which ? mrB : mrA)) * (NMOD * D) + 2 * D))[rem4]; }
#pragma unroll
        for (int j = 0; j < 2; ++j) { const int k = tid + NTHREADS * j; RW[k] = g[j].x; RW[1024 + k] = g[j].y; RW[2048 + k] = g[j].z; RW[3072 + k] = g[j].w; }
#pragma unroll
        for (int j = 0; j < 8; ++j) { const int i4 = tid + NTHREADS * j, k = i4 >> 2, q0 = 4 + 4 * (i4 & 3);
            RW[q0 * 1024 + k] = e[j].x; RW[(q0 + 1) * 1024 + k] = e[j].y; RW[(q0 + 2) * 1024 + k] = e[j].z; RW[(q0 + 3) * 1024 + k] = e[j].w; }
        ((float4*)((tid < 256) ? G1 : G2))[tid & 255] = gg;
#pragma unroll
        for (int j = 0; j < 3; ++j) ((float4*)MODS)[tid + NTHREADS * j] = m[j];
    }
    __syncthreads();
    const int r0 = wg_r0 + wave * rpw, r1 = min(r0 + rpw, nrows);
    if (r0 < r1) {
        ThinIn A, B;
        router_load<XBF>(A, C, layer, r0, lane); router_load<XBF>(B, C, layer, min(r0 + 1, r1 - 1), lane);
#pragma unroll 1
        for (int r = r0; r < r1; r += 2) {
            const int rb = min(r + 1, r1 - 1); const bool two = r + 1 < r1;
            float4 xa[4], xb[4];
            router_row_a(A, C, layer, r, lane, G1, G2, MODS + ((modrow_of(r) == mrA) ? 0 : 3072), xa);
            router_load<XBF>(A, C, layer, min(r + 2, r1 - 1), lane);
            router_row_a(B, C, layer, rb, lane, G1, G2, MODS + ((modrow_of(rb) == mrA) ? 0 : 3072), xb);
            router_load<XBF>(B, C, layer, min(r + 3, r1 - 1), lane);
            float la[32], lb[32];
            {
                typedef float f32x2_t __attribute__((ext_vector_type(2)));
                f32x2_t xp[4][4];
#pragma unroll
                for (int j = 0; j < 4; ++j) { xp[j][0] = (f32x2_t){xa[j].x, xb[j].x}; xp[j][1] = (f32x2_t){xa[j].y, xb[j].y}; xp[j][2] = (f32x2_t){xa[j].z, xb[j].z}; xp[j][3] = (f32x2_t){xa[j].w, xb[j].w}; }
#pragma unroll
                for (int q = 0; q < 20; ++q) { f32x2_t p0 = (f32x2_t){0.f, 0.f}, p1 = p0;
#pragma unroll
                    for (int j = 0; j < 4; ++j) { const float4 w = *(const float4*)(RW + q * 1024 + 4 * (lane + 64 * j));
                        p0 = __builtin_elementwise_fma(xp[j][0], (f32x2_t){w.x, w.x}, p0); p1 = __builtin_elementwise_fma(xp[j][1], (f32x2_t){w.y, w.y}, p1);
                        p0 = __builtin_elementwise_fma(xp[j][2], (f32x2_t){w.z, w.z}, p0); p1 = __builtin_elementwise_fma(xp[j][3], (f32x2_t){w.w, w.w}, p1); }
                    const f32x2_t p = p0 + p1; la[q] = p.x; lb[q] = p.y; }
            }
#pragma unroll
            for (int q = 20; q < 32; ++q) { la[q] = 0.f; lb[q] = 0.f; }
            const float ta = reduce20(la, lane), tb = reduce20(lb, lane);
            router_select(ta, C, layer, r, lane, lcnt, BL);
            if (two) router_select(tb, C, layer, rb, lane, lcnt, BL);
        }
    }
    __syncthreads();
    if (tid < 24) C.CNTW[((size_t)layer * 24 + tid) * 256 + blockIdx.x] = lcnt[tid];
}

constexpr int MOE_LDS = 131072, MOE_MAXU = 8;
__device__ __forceinline__ bool moe_unit(int i, int G, int c, int npn, int ntiles, int& tile, int& pn) {
    if (npn == 8 && (G & 7) == 0 && G >= 64) {
        const int x = c & 7, j = c >> 3, per = G >> 3;
        const int slot = i * per + j;
        const int q = (slot >> 5) * 8 + x;
        tile = q * 4 + (slot & 3); pn = (slot >> 2) & 7;
        const int nquads = (ntiles + 3) >> 2;
        if (q >= nquads) return false;
        return tile < ntiles;
    }
    const long L = (long)i * G + c; if (L >= (long)ntiles * npn) return false;
    tile = (int)(L / npn); pn = (int)(L % npn); return true;
}
__device__ __forceinline__ bool moe_fewer_units(int G, int c, int npn, int ntiles) {
    int me = 0, mx = 0;
#pragma unroll 1
    for (int i = 0; i < MOE_MAXU; ++i) { int t_, p_; if (moe_unit(i, G, c, npn, ntiles, t_, p_)) ++me; if (moe_unit(i, G, 0, npn, ntiles, t_, p_)) ++mx; }
    return me < mx;
}
struct MoeSched {
    int G, c, npn, layer, mode  ; const char *A, *W; LAS const int* meta  ; LAS const int* tab  ;
    __device__ __forceinline__ bool next(int i, pg8::GUnit& u) const {
        const int ntiles = meta[32 + 24]; if (i >= MOE_MAXU) return false;
        int tile, pn; if (!moe_unit(i, G, c, npn, ntiles, tile, pn)) return false;
        const int ln_ = lane_id(); const int pv_ = meta[32 + min(ln_, 24)];
        const int cls = __popcll(__ballot(ln_ < 24 && tile >= pv_)) - 1;
        const int tin = tile - meta[32 + cls], cnt = meta[cls];
        const int g = cls / 6, pr = cls % 6; const int elo = (pr < 3) ? 0 : (pr < 5) ? 1 : 2, ehi = (pr < 3) ? pr + 1 : (pr < 5) ? pr - 1 : 3;
        u.pm = tile; u.pn = pn; u.x0 = i; u.x1 = min(256, cnt - tin * 256); u.A = A;
        if (mode == 0) { const int e = g * 4 + ((pn < 4) ? elo : ehi); u.B = W + (((size_t)layer * 16 + e) * 1024 + (size_t)(pn & 3) * 256) * 1024 * 2; u.B2 = u.B; }
        else { u.B = W + (((size_t)layer * 16 + g * 4 + elo) * 1024 + (size_t)pn * 256) * 512 * 2; u.B2 = W + (((size_t)layer * 16 + g * 4 + ehi) * 1024 + (size_t)pn * 256) * 512 * 2; }
        return true;
    }
    __device__ __forceinline__ unsigned arow(const pg8::GUnit& u, int row) const { return (mode == 0) ? (unsigned)tab[u.x0 * 256 + row] * 2048u : (unsigned)(u.pm * 256 + row) * 2048u; }
};
__device__ __forceinline__ void moe_setup(const Ctx& C, int layer, int npn, LAS int* meta, LAS int* tab, LAS char* scratch  ) {
    const int tid = opaque_tid(C.wv), G = gridDim.x;
    LAS int* cnt = (LAS int*)scratch;
    LAS int* pw = cnt + 24 * 256;
    LAS int* bs = pw + 24 * 257;
    {   const int4* srcp = (const int4*)(C.CNTW + (size_t)layer * 24 * 256);
        int4 v[3];
#pragma unroll
        for (int j = 0; j < 3; ++j) v[j] = srcp[tid + NTHREADS * j];
#pragma unroll
        for (int j = 0; j < 3; ++j) { const int q = tid + NTHREADS * j, w0 = (4 * q) & 255;
            if (w0 + 0 >= G) v[j].x = 0; if (w0 + 1 >= G) v[j].y = 0; if (w0 + 2 >= G) v[j].z = 0; if (w0 + 3 >= G) v[j].w = 0;
            cnt[4 * q] = v[j].x; cnt[4 * q + 1] = v[j].y; cnt[4 * q + 2] = v[j].z; cnt[4 * q + 3] = v[j].w; } }
    __syncthreads();
    const int c = tid >> 4, b = tid & 15;
    if (tid < 384) { int acc = 0;
#pragma unroll
        for (int w = 0; w < 16; ++w) acc += cnt[c * 256 + b * 16 + w];
        bs[tid] = acc; }
    __syncthreads();
    if (tid < 384) { int base = 0;
        for (int k = 0; k < b; ++k) base += bs[c * 16 + k];
#pragma unroll
        for (int w = 0; w < 16; ++w) { pw[c * 257 + b * 16 + w] = base; base += cnt[c * 256 + b * 16 + w]; }
        if (b == 15) { pw[c * 257 + 256] = base; meta[c] = base; } }
    __syncthreads();
    if (tid == 0) { int acc = 0; for (int k = 0; k < 24; ++k) { meta[32 + k] = acc; acc += (meta[k] + 255) >> 8; } meta[32 + 24] = acc; }
    __syncthreads();
    const int ntiles = meta[32 + 24];
    const int s = tid & 255;
    int tpre[24];
#pragma unroll
    for (int kk = 0; kk < 24; ++kk) tpre[kk] = meta[32 + kk];
    const int* gp[MOE_MAXU / 2]; bool ok[MOE_MAXU / 2];
#pragma unroll
    for (int k = 0; k < MOE_MAXU / 2; ++k) {
        const int i = (tid >> 8) + 2 * k; int tile = 0, pn_;
        ok[k] = moe_unit(i, G, blockIdx.x, npn, ntiles, tile, pn_);
        int cls = 0;
#pragma unroll
        for (int kk = 1; kk < 24; ++kk) cls += (tile >= tpre[kk]) ? 1 : 0;
        const int tin = tile - meta[32 + cls], cn = meta[cls];
        int slot = tin * 256 + s; if (slot >= cn) slot = 0;
        LAS const int* pc = pw + cls * 257;
        int lo = 0, hi = 256;
#pragma unroll 1
        while (hi - lo > 1) { const int mid = (lo + hi) >> 1; if (pc[mid] <= slot) lo = mid; else hi = mid; }
        gp[k] = C.LIST + ((size_t)lo * 24 + cls) * LIST_CAP + (slot - pc[lo]);
        if (!ok[k]) gp[k] = C.LIST;
    }
    int tv[MOE_MAXU / 2];
#pragma unroll
    for (int k = 0; k < MOE_MAXU / 2; ++k) tv[k] = *gp[k];
#pragma unroll
    for (int k = 0; k < MOE_MAXU / 2; ++k) if (ok[k]) tab[((tid >> 8) + 2 * k) * 256 + s] = tv[k];
    __syncthreads();
}
__device__ __forceinline__ float silu_fast(float v) { return v * __builtin_amdgcn_rcpf(1.f + __expf(-v)); }
struct EpiMoeUp {
    static constexpr bool PERM = true;
    bf16_t* ACT; const float* TOKW; LAS const int* tab;
    __device__ __forceinline__ void operator()(const pg8::f32x4 (&acc)[2][2][4][2], const pg8::GUnit& u, int wr, int wc, int fr, int fq) const {
        const int hi = (u.pn >= 4) ? 1 : 0;
        float w8[2][4];
#pragma unroll
        for (int ai = 0; ai < 2; ++ai)
#pragma unroll
            for (int m = 0; m < 4; ++m) { const int rt = ai * 128 + wr * 64 + m * 16 + fr; const int token = tab[u.x0 * 256 + rt]; w8[ai][m] = TOKW[(size_t)token * 2 + hi]; }
#pragma unroll
        for (int ai = 0; ai < 2; ++ai)
#pragma unroll
            for (int mp = 0; mp < 2; ++mp)
#pragma unroll
                for (int bj = 0; bj < 2; ++bj) {
                    pg8::u32x2 o[2];
#pragma unroll
                    for (int s = 0; s < 2; ++s) { const int m = 2 * mp + s; const float w = w8[ai][m];
                        const pg8::f32x4 gt = acc[ai][bj][m][0], up = acc[ai][bj][m][1];
                        o[s].x = pg8::cvt_pk_bf16(silu_fast(gt[0]) * up[0] * w, silu_fast(gt[1]) * up[1] * w); o[s].y = pg8::cvt_pk_bf16(silu_fast(gt[2]) * up[2] * w, silu_fast(gt[3]) * up[3] * w); }
                    const auto sx = __builtin_amdgcn_permlane16_swap(o[0].x, o[1].x, false, false);
                    const auto sy = __builtin_amdgcn_permlane16_swap(o[0].y, o[1].y, false, false);
                    const pg8::u32x4 wv = (pg8::u32x4){sx[0], sy[0], sx[1], sy[1]};
                    const int rt = ai * 128 + wr * 64 + (2 * mp + (fq & 1)) * 16 + fr;
                    if (rt < u.x1) *(pg8::u32x4*)(ACT + (size_t)(u.pm * 256 + rt) * 1024 + hi * 512 + (u.pn & 3) * 128 + 4 * (16 * bj + 4 * wc + (fq & ~1))) = wv;
                }
    }
};
struct EpiMoeDown {
    static constexpr bool PERM = true;
    bf16_t* FX; float* SS; LAS const int* tab;
    __device__ __forceinline__ void operator()(const pg8::f32x4 (&acc)[2][2][4][2], const pg8::GUnit& u, int wr, int wc, int fr, int fq) const {
        int tok8[2][4];
#pragma unroll
        for (int ai = 0; ai < 2; ++ai)
#pragma unroll
            for (int m = 0; m < 4; ++m) tok8[ai][m] = tab[u.x0 * 256 + ai * 128 + wr * 64 + m * 16 + fr];
#pragma unroll
        for (int ai = 0; ai < 2; ++ai)
#pragma unroll
            for (int m = 0; m < 4; ++m) {
                const int rt = ai * 128 + wr * 64 + m * 16 + fr; const bool ok = rt < u.x1;
                const int token = tok8[ai][m]; float p = 0.f;
#pragma unroll
                for (int bj = 0; bj < 2; ++bj) {
                    const pg8::f32x4 v0 = acc[ai][bj][m][0], v1 = acc[ai][bj][m][1];
                    p += ((v0[0] * v0[0] + v0[1] * v0[1]) + (v0[2] * v0[2] + v0[3] * v0[3])) + ((v1[0] * v1[0] + v1[1] * v1[1]) + (v1[2] * v1[2] + v1[3] * v1[3]));
                    pg8::u32x4 w; w.x = pg8::cvt_pk_bf16(v0[0], v0[1]); w.y = pg8::cvt_pk_bf16(v0[2], v0[3]); w.z = pg8::cvt_pk_bf16(v1[0], v1[1]); w.w = pg8::cvt_pk_bf16(v1[2], v1[3]);
                    if (ok) *(pg8::u32x4*)(FX + (size_t)token * 1024 + u.pn * 256 + bj * 128 + wc * 32 + 8 * fq) = w;
                }
                p += xshfl<16>(p); p += xshfl<32>(p);
                if (ok && fq == 0) SS[(size_t)token * 16 + u.pn * 4 + wc] = p;
            }
    }
};

__device__ __forceinline__ void final_load(ThinIn& R, const Ctx& C, int r, int lane) {
    const uint2* xr = (const uint2*)(C.HX + (size_t)r * D); const uint2* fxr = (const uint2*)(C.FX + (size_t)r * D);
#pragma unroll
    for (int j = 0; j < 4; ++j) { const uint2 xw = xr[lane + 64 * j];
        R.x[j] = make_float4(__uint_as_float(xw.x << 16), __uint_as_float(xw.x & 0xffff0000u), __uint_as_float(xw.y << 16), __uint_as_float(xw.y & 0xffff0000u));
        R.o[j] = fxr[lane + 64 * j]; R.ss[j] = *(const float4*)(C.SS2 + (size_t)r * 16 + 4 * j); }
}
__device__ __forceinline__ void final_row(const ThinIn& R, const Ctx& C, int r, int lane, bool nextln, const float* G3, const float* G0N, const float* MODS  ) {
    const float rstd = rsqrtf(ss16(R) * (1.f / D) + EPS);
    float4* xo = (float4*)xrow_out(C, r);
    float4 xv[4]; float ss = 0.f;
#pragma unroll
    for (int j = 0; j < 4; ++j) { const int ci = lane + 64 * j; const uint2 fw = R.o[j]; const float4 g = *(const float4*)(G3 + 4 * ci), gt = *(const float4*)(MODS + 4 * ci); xv[j] = R.x[j];
        xv[j].x += gt.x * (__uint_as_float(fw.x << 16) * rstd * g.x); xv[j].y += gt.y * (__uint_as_float(fw.x & 0xffff0000u) * rstd * g.y);
        xv[j].z += gt.z * (__uint_as_float(fw.y << 16) * rstd * g.z); xv[j].w += gt.w * (__uint_as_float(fw.y & 0xffff0000u) * rstd * g.w);
        if (!nextln) xo[ci] = xv[j];
        else if (r < TL) { uint2 w2; w2.x = pg8::cvt_pk_bf16(xv[j].x, xv[j].y); w2.y = pg8::cvt_pk_bf16(xv[j].z, xv[j].w); ((uint2*)((bf16_t*)C.out + (size_t)r * D))[ci] = w2; }
        ss += (xv[j].x * xv[j].x + xv[j].y * xv[j].y) + (xv[j].z * xv[j].z + xv[j].w * xv[j].w); }
    if (nextln) {
        const float rs2 = rsqrtf(wave_sum(ss) * (1.f / D) + EPS);
        uint2* o = (uint2*)(C.HX + (size_t)r * D);
#pragma unroll
        for (int j = 0; j < 4; ++j) { const int ci = lane + 64 * j; const float4 g = *(const float4*)(G0N + 4 * ci), sh = *(const float4*)(MODS + 1024 + 4 * ci), sc = *(const float4*)(MODS + 2048 + 4 * ci);
            uint2 w; w.x = pg8::cvt_pk_bf16((xv[j].x * rs2 * g.x) * (1.f + sc.x) + sh.x, (xv[j].y * rs2 * g.y) * (1.f + sc.y) + sh.y);
            w.y = pg8::cvt_pk_bf16((xv[j].z * rs2 * g.z) * (1.f + sc.z) + sh.z, (xv[j].w * rs2 * g.w) * (1.f + sc.w) + sh.w);
            o[ci] = w; }
    }
}
__device__ __forceinline__ void phase_final(const Ctx& C, int layer, float* lds) {
    const int tid = opaque_tid(C.wv), lane = tid & 63, wave = tid >> 6;
    const bool nextln = layer < DEPTH - 1;
    float* G3 = lds; float* G0N = G3 + 1024; float* MODS = G0N + 1024;
    const int nrows = (layer == DEPTH - 1) ? TL : T;
    const int rpw = (nrows + gridDim.x * NWAVES - 1) / (gridDim.x * NWAVES);
    int bidx_ = blockIdx.x; asm volatile("" : "+s"(bidx_));
    const int wg_r0 = bidx_ * NWAVES * rpw, wg_r1 = min(wg_r0 + NWAVES * rpw, nrows);
    const int mrA = modrow_of(min(wg_r0, nrows - 1)), mrB = modrow_of(max(wg_r1 - 1, 0));
    const int ln = nextln ? layer + 1 : layer;
    {
        const float4 gg = ((const float4*)(C.norm_g + ((tid < 256) ? ((size_t)layer * 4 + 3) : ((size_t)ln * 4 + 0)) * D))[tid & 255];
        float4 m[3];
#pragma unroll
        for (int j = 0; j < 3; ++j) { const int i4 = tid + NTHREADS * j, which = (i4 >= 768) ? 1 : 0, rem4 = i4 - 768 * which, mr = which ? mrB : mrA;
            m[j] = (rem4 < 256) ? ((const float4*)(C.mod + ((size_t)layer * 17 + mr) * (NMOD * D) + 5 * D))[rem4] : ((const float4*)(C.mod + ((size_t)ln * 17 + mr) * (NMOD * D)))[rem4 - 256]; }
        ((float4*)((tid < 256) ? G3 : G0N))[tid & 255] = gg;
#pragma unroll
        for (int j = 0; j < 3; ++j) ((float4*)MODS)[tid + NTHREADS * j] = m[j];
    }
    __syncthreads();
    const int r0 = wg_r0 + wave * rpw, r1 = min(r0 + rpw, nrows);
    if (r0 < r1) {
        ThinIn A, B;
        final_load(A, C, r0, lane);
#pragma unroll 1
        for (int r = r0; r < r1; r += 2) {
            const int rb = min(r + 1, r1 - 1);
            final_load(B, C, rb, lane);
            final_row(A, C, r, lane, nextln, G3, G0N, MODS + ((modrow_of(r) == mrA) ? 0 : 3072));
            final_load(A, C, min(r + 2, r1 - 1), lane);
            final_row(B, C, rb, lane, nextln, G3, G0N, MODS + ((modrow_of(rb) == mrA) ? 0 : 3072));
        }
    }
}

__device__ __forceinline__ Ctx make_ctx(const Args& a, int wv) {
    Ctx C; C.wv = wv;
    C.x = a.in[0]; C.c = a.in[1]; C.ctx = a.in[2]; C.c_ctx = a.in[3]; C.ada_w = a.in[4]; C.ada_b = a.in[5]; C.norm_g = a.in[6]; C.w_in = a.in[7];
    C.q_gain = a.in[8]; C.kv_gain = a.in[9]; C.w_uq = a.in[10]; C.w_ukv = a.in[11]; C.sink = a.in[12]; C.dlam = a.in[13]; C.subln = a.in[14];
    C.pool_w = a.in[15]; C.pool_scale = a.in[16]; C.w_out = a.in[17]; C.r_gw = a.in[18]; C.r_gb = a.in[19]; C.r_ew = a.in[20]; C.r_eb = a.in[21];
    C.w_gu = a.in[22]; C.w_down = a.in[23]; C.out = a.out; C.ws = a.ws;
    C.mod = (float*)(a.ws + WS_MOD); C.hctx = (float*)(a.ws + WS_HCTX);
    unsigned char* q = a.ws + WS_QKV;
    C.QA = (bf16_t*)(q + QA_OFF); C.KA = (bf16_t*)(q + KA_OFF); C.VA = (bf16_t*)(q + VA_OFF); C.QB = (bf16_t*)(q + QB_OFF); C.KB = (bf16_t*)(q + KB_OFF);
    C.VB = (bf16_t*)(q + VB_OFF); C.QC = (bf16_t*)(q + QC_OFF); C.KC = (bf16_t*)(q + KC_OFF); C.VC = (bf16_t*)(q + VC_OFF); C.U = (bf16_t*)(q + U_OFF);
    C.O = (bf16_t*)(a.ws + WS_O);
    C.WIN = (bf16_t*)(a.ws + WS_WIN); C.WOUT = (bf16_t*)(a.ws + WS_WOUT); C.WUQ = (bf16_t*)(a.ws + WS_WUQ); C.WUKV = (bf16_t*)(a.ws + WS_WUKV);
    C.WGU = (bf16_t*)(a.ws + WS_WGU); C.WDN = (bf16_t*)(a.ws + WS_WDN); C.HX = (bf16_t*)(a.ws + WS_HX); C.CQ = (bf16_t*)(a.ws + WS_CQ); C.CKVR = (bf16_t*)(a.ws + WS_CKVR);
    C.SSQ = (float*)(a.ws + WS_SSQ); C.SSK = (float*)(a.ws + WS_SSK);
    C.OX = (bf16_t*)(a.ws + WS_OX); C.ACT = (bf16_t*)(a.ws + WS_ACT); C.HM = (bf16_t*)(a.ws + WS_HM); C.FX = (bf16_t*)(a.ws + WS_FX);
    C.SS1 = (float*)(a.ws + WS_SS1); C.SS2 = (float*)(a.ws + WS_SS2); C.TOKW = (float*)(a.ws + WS_TOKW); C.LIST = (int*)(a.ws + WS_LIST); C.CNTW = (int*)(a.ws + WS_CNTW);
    return C;
}
constexpr int PH_PER_LAYER = 9;
constexpr int N_PHASES = 1 + PH_PER_LAYER * DEPTH;
__global__ void __launch_bounds__(NTHREADS, 2) fwd(Args a) {
    extern __shared__ __attribute__((aligned(16))) unsigned char lds_raw[];
    float* lds = (float*)lds_raw;
    LAS unsigned char* lds3 = (LAS unsigned char*)lds_raw;
    volatile LAS unsigned* MISC = (volatile LAS unsigned*)((LAS unsigned char*)lds_raw + LDS_MISC);
    const int wv = __builtin_amdgcn_readfirstlane(threadIdx.x >> 6);
    for (int u = threadIdx.x; u < (LDS_BYTES - LDS_MISC) / 4; u += NTHREADS) MISC[u] = 0u;
    __syncthreads();
    const bool one = (a.ph_hi - a.ph_lo) > 1;
    XcdBarrier bar; bar.bar = (unsigned*)(a.ws + WS_CTL) + 4096; bar.x = 0; bar.st = nullptr;
    if (one) bar = xcd_barrier_post((unsigned*)(a.ws + WS_CTL) + 4096, MISC + 8, wv);
    const int lo = a.ph_lo, hi = a.ph_hi;
    const int G = gridDim.x, bid = blockIdx.x;
#define IN(k) (lo <= (k) && (k) < hi)
#define SEAM(k) do { if (IN(k) && IN((k) + 1)) { STAMP_BEGIN(); xcd_barrier(bar, wv); STAMP_END(10); STAMP_END(((k) == 0) ? 49 : 40 + (((k) + 8) % 9)); } } while (0)
    if (IN(0)) REPEAT(REP_PRO) { REP_SYNC(); STAMP_BEGIN(); const Ctx C = make_ctx(a, wv); phase_mod(C, lds); __syncthreads(); phase_convert(C, lds); STAMP_END(0); }
    SEAM(0);
#pragma unroll 1
    for (int layer = 0; layer < DEPTH; ++layer) {
        const int p = 1 + PH_PER_LAYER * layer;
        if (layer == 0) {
        if (IN(p)) REPEAT(REP_LN0) { REP_SYNC(); STAMP_BEGIN(); const Ctx C = make_ctx(a, wv); phase_ln0(C, layer); STAMP_END(1); }
        SEAM(p);
        }
        if (IN(p + 1)) REPEAT(REP_INP) {
            REP_SYNC(); STAMP_BEGIN(); const Ctx C = make_ctx(a, wv);
            SchedInProj S{G, bid, layer, (const char*)C.HX, (const char*)(C.WIN + (size_t)layer * 2048 * 1024)};
            stage_rope_table(lds3, wv);
            EpiInProj E{C.CQ, C.CKVR, C.KA, C.QB, C.KB, C.VB, C.QC, C.KC, C.VC, C.U, C.SSQ, C.SSK, (LAS const float*)(lds3 + ROPE_LDS)};
            pg8::gemm_phase<0>(lds3, wv, 1024, 1024, 16, S, E); STAMP_END(2);
            if (layer == 0 && G == 256 && (bid >> 3) >= 16) static_convert(C, lds, 0, CV_S1, ((bid >> 3) - 16) * 8 + (bid & 7), 128);
        }
        SEAM(p + 1);
        if (IN(p + 2)) REPEAT(REP_MLA) {
            REP_SYNC(); STAMP_BEGIN(); const Ctx C = make_ctx(a, wv);
            const int nQ = ((layer == DEPTH - 1) ? TL : T) / 256 * 2;
            SchedMlaUp S{G, bid, nQ, nQ + T / 256 * 2, (const char*)C.CQ, (const char*)C.CKVR, (const char*)(C.WUQ + (size_t)layer * 512 * 256), (const char*)(C.WUKV + (size_t)layer * 512 * 256)};
            stage_rope_table(lds3, wv);
            EpiMlaUp E{C.QA, C.KA, C.VA, C.SSQ, C.SSK, (LAS const float*)(lds3 + ROPE_LDS)};
            pg8::gemm_phase<1>(lds3, wv, 256, 256, 4, S, E); STAMP_END(3);
        }
        SEAM(p + 2);
        if (IN(p + 3)) REPEAT(REP_ATT) { REP_SYNC(); STAMP_BEGIN(); const Ctx C = make_ctx(a, wv); phase_attn(C, layer, (LAS char*)lds3, MISC); STAMP_END(4); }
        SEAM(p + 3);
        if (IN(p + 4)) REPEAT(REP_OUT) {
            REP_SYNC(); STAMP_BEGIN(); const Ctx C = make_ctx(a, wv);
            SchedRows S{G, bid, ((layer == DEPTH - 1) ? TL : T) / 256, 4, (const char*)C.O, (const char*)(C.WOUT + (size_t)layer * 1024 * 1024), 2048u, (size_t)256 * 1024 * 2};
            EpiRowsSS E{C.OX, C.SS1};
            pg8::gemm_phase<2>(lds3, wv, 1024, 1024, 16, S, E); STAMP_END(5);
            if (layer == 0 && G == 256 && bid >= 64) static_convert(C, lds, CV_S1, CV_S2, bid - 64, 192);
        }
        SEAM(p + 4);
        if (IN(p + 5)) { STAMP_BEGIN(); const Ctx C = make_ctx(a, wv); if (layer == 0) phase_router<false>(C, layer, lds); else phase_router<true>(C, layer, lds); STAMP_END(6); }
        SEAM(p + 5);
        if (IN(p + 6)) REPEAT(REP_MUP) {
            REP_SYNC(); STAMP_BEGIN(); const Ctx C = make_ctx(a, wv);
            LAS int* meta = (LAS int*)(lds3 + MOE_LDS); LAS int* tab = (LAS int*)(lds3 + MOE_LDS + 4096);
            moe_setup(C, layer, 8, meta, tab, (LAS char*)lds3); STAMP_END(30);
            MoeSched S{G, bid, 8, layer, 0, (const char*)C.HM, (const char*)C.WGU, meta, tab};
            EpiMoeUp E{C.ACT, C.TOKW, tab};
            pg8::gemm_phase<3>(lds3, wv, 1024, 1024, 16, S, E); STAMP_END(7);
            if (layer == 0 && BG_MUP > 0 && moe_fewer_units(G, bid, 8, meta[32 + 24])) bg_convert(C, lds, MISC, BG_MUP);
        }
        SEAM(p + 6);
        if (IN(p + 7)) REPEAT(REP_MDN) {
            REP_SYNC(); STAMP_BEGIN(); const Ctx C = make_ctx(a, wv);
            LAS int* meta = (LAS int*)(lds3 + MOE_LDS); LAS int* tab = (LAS int*)(lds3 + MOE_LDS + 4096);
            moe_setup(C, layer, 4, meta, tab, (LAS char*)lds3); STAMP_END(30);
            MoeSched S{G, bid, 4, layer, 1, (const char*)C.ACT, (const char*)C.WDN, meta, tab};
            EpiMoeDown E{C.FX, C.SS2, tab};
            pg8::gemm_phase<4>(lds3, wv, 1024, 512, 8, S, E); STAMP_END(8);
            if (layer == 0 && BG_MDN > 0 && moe_fewer_units(G, bid, 4, meta[32 + 24])) bg_convert(C, lds, MISC, BG_MDN);
        }
        SEAM(p + 7);
        if (IN(p + 8)) { STAMP_BEGIN(); const Ctx C = make_ctx(a, wv); if (layer == 0) static_convert(C, lds, (G == 256) ? CV_S2 : 0, CV_TOTAL, bid, G); phase_final(C, layer, lds); STAMP_END(9); }
        SEAM(p + 8);
    }
#undef IN
#undef SEAM
#if PROBE_SEL >= 0
    if (blockIdx.x == 0 && wv == 0 && lane_id() == 0) { const unsigned long long te = wall_clock64(), pa_ = *(volatile LAS unsigned long long*)(MISC + 16); while (wall_clock64() - te < pa_ * PROBE_MULT) __builtin_amdgcn_s_sleep(8); }
#endif
}

extern "C" void kernel_launch(void* const* d_in, const int* in_sizes, int n_in, void* d_out, int out_size, void* d_ws, size_t ws_size, hipStream_t stream) {
    static int grid = 0;
    if (grid == 0) {
        if (n_in != 24 || out_size != TL * D || ws_size < WS_END) { fprintf(stderr, "kernel_launch: unexpected shapes (n_in %d out %d ws %zu)\n", n_in, out_size, ws_size); grid = -1; return; }
        int dev = 0, cus = 0;
        if (hipGetDevice(&dev) != hipSuccess || hipDeviceGetAttribute(&cus, hipDeviceAttributeMultiprocessorCount, dev) != hipSuccess) { grid = -1; return; }
        if (hipFuncSetAttribute((const void*)fwd, hipFuncAttributeMaxDynamicSharedMemorySize, LDS_BYTES) != hipSuccess) { fprintf(stderr, "kernel_launch: hipFuncSetAttribute failed\n"); grid = -1; return; }
        int per_cu = 0;
        if (hipOccupancyMaxActiveBlocksPerMultiprocessor(&per_cu, (const void*)fwd, NTHREADS, LDS_BYTES) != hipSuccess || per_cu < 1) { fprintf(stderr, "kernel_launch: occupancy query says %d\n", per_cu); }
        (void)hipGetLastError();
        grid = cus;
    }
    if (grid < 0) return;
    (void)hipMemsetAsync((char*)d_ws + WS_CTL, 0, CTL_BYTES, stream);
    Args a{};
    for (int i = 0; i < 24; ++i) a.in[i] = (const float*)d_in[i];
    a.out = (float*)d_out; a.ws = (unsigned char*)d_ws;
#if N_LAUNCH_MODE == 1
    a.ph_lo = 0; a.ph_hi = N_PHASES;
    hipLaunchKernelGGL(fwd, dim3(grid), dim3(NTHREADS), LDS_BYTES, stream, a);
#else
    for (int p = 0; p < N_PHASES; ++p) { a.ph_lo = p; a.ph_hi = p + 1; hipLaunchKernelGGL(fwd, dim3(grid), dim3(NTHREADS), LDS_BYTES, stream, a); }
#endif
}
```
